# Optimizing an MI355X kernel written in HIP

```python
import jax, jax.numpy as jnp
from jax import lax
import numpy as np

D_MODEL = 1024
BATCH = 16
SEQ = 2048
DEPTH = 2

CHUNK = 64
N_MIXERS = 2
ROPE_THETA = 500000.0
EPS = 1e-6

A_HEADS = 16
A_KV_HEADS = 4
A_HEAD_DIM = 64
A_ROT = A_HEAD_DIM // 4
IDX_HEADS = 8
IDX_DIM = 64
IDX_ROT = IDX_DIM // 4
IDX_TOPK_MAX = 256
IDX_WEIGHT_SCALE = (IDX_HEADS ** -0.5) * (IDX_DIM ** -0.5)
A_QBLK = CHUNK
A_IN = A_HEADS * A_HEAD_DIM + 2 * A_KV_HEADS * A_HEAD_DIM + IDX_HEADS * IDX_DIM + IDX_DIM + IDX_HEADS

B_HEADS = 16
B_NOPE = 64
B_ROPE = 32
B_V = 64
B_Q_LORA = 384
B_KV_LORA = 256
B_QBLK = 128
B_IN = B_Q_LORA + B_KV_LORA + B_ROPE

D_FF = 4 * D_MODEL

N_A = (DEPTH + 1) // 2
N_B = DEPTH // 2

kernel_name = 'chunk_causal_dsa_mla_hybrid'


def rms_norm(x, g):
    xf = x.astype(jnp.float32)
    y = xf * lax.rsqrt(jnp.mean(xf * xf, axis=-1, keepdims=True) + EPS)
    return (y * g.astype(jnp.float32)).astype(x.dtype)


def rope_angles(positions, rot_dim):
    inv = ROPE_THETA ** (-jnp.arange(0, rot_dim, 2, dtype=jnp.float32) / rot_dim)
    ang = positions.astype(jnp.float32)[..., None] * inv
    return jnp.cos(ang), jnp.sin(ang)


def apply_rope(x, cos, sin):
    half = x.shape[-1] // 2
    x1 = x[..., :half].astype(jnp.float32)
    x2 = x[..., half:].astype(jnp.float32)
    c = cos[:, :, None, :]
    s = sin[:, :, None, :]
    return jnp.concatenate([x1 * c - x2 * s, x2 * c + x1 * s], axis=-1).astype(x.dtype)


def partial_rope(x, cos, sin, rot):
    return jnp.concatenate([apply_rope(x[..., :rot], cos, sin), x[..., rot:]], axis=-1)


def dsa_mixer(h, w_in, w_out, cos_a, sin_a, cos_i, sin_i):
    bsz, seq, _ = h.shape
    f32 = jnp.float32
    n_q = A_HEADS * A_HEAD_DIM
    n_kv = A_KV_HEADS * A_HEAD_DIM
    n_qi = IDX_HEADS * IDX_DIM
    cuts = [n_q, n_q + n_kv, n_q + 2 * n_kv, n_q + 2 * n_kv + n_qi, n_q + 2 * n_kv + n_qi + IDX_DIM]
    proj = h @ w_in
    q, k, v, qi, ki, wi = jnp.split(proj, cuts, axis=-1)
    q = partial_rope(q.reshape(bsz, seq, A_HEADS, A_HEAD_DIM), cos_a, sin_a, A_ROT)
    k = partial_rope(k.reshape(bsz, seq, A_KV_HEADS, A_HEAD_DIM), cos_a, sin_a, A_ROT)
    v = v.reshape(bsz, seq, A_KV_HEADS, A_HEAD_DIM)
    qi = partial_rope(qi.reshape(bsz, seq, IDX_HEADS, IDX_DIM), cos_i, sin_i, IDX_ROT)
    ki = partial_rope(ki[:, :, None, :], cos_i, sin_i, IDX_ROT)[:, :, 0, :]
    wi = wi.astype(f32) * IDX_WEIGHT_SCALE

    top_k = min(IDX_TOPK_MAX, seq // 4)
    group = A_HEADS // A_KV_HEADS
    scale = A_HEAD_DIM ** -0.5
    key_pos = jnp.arange(seq)

    def block(i):
        start = i * A_QBLK
        qb = lax.dynamic_slice_in_dim(q, start, A_QBLK, axis=1)
        qib = lax.dynamic_slice_in_dim(qi, start, A_QBLK, axis=1)
        wib = lax.dynamic_slice_in_dim(wi, start, A_QBLK, axis=1)
        q_pos = start + jnp.arange(A_QBLK)
        chunk_end = (q_pos // CHUNK + 1) * CHUNK
        logits = jnp.einsum('bthd,bsd->bths', qib, ki, preferred_element_type=f32)
        score = jnp.einsum('bths,bth->bts', jax.nn.relu(logits), wib)
        visible = key_pos[None, :] < chunk_end[:, None]
        score = jnp.where(visible[None], score, -jnp.inf)
        _, sel = lax.top_k(score, top_k)
        sel_ok = sel < chunk_end[None, :, None]
        flat = sel.reshape(bsz, A_QBLK * top_k)[:, :, None, None]
        kg = jnp.take_along_axis(k, flat, axis=1).reshape(bsz, A_QBLK, top_k, A_KV_HEADS, A_HEAD_DIM)
        vg = jnp.take_along_axis(v, flat, axis=1).reshape(bsz, A_QBLK, top_k, A_KV_HEADS, A_HEAD_DIM)
        qg = qb.reshape(bsz, A_QBLK, A_KV_HEADS, group, A_HEAD_DIM)
        s = jnp.einsum('btgrd,btkgd->btgrk', qg, kg, preferred_element_type=f32) * scale
        s = jnp.where(sel_ok[:, :, None, None, :], s, -jnp.inf)
        p = jax.nn.softmax(s, axis=-1)
        o = jnp.einsum('btgrk,btkgd->btgrd', p.astype(vg.dtype), vg, preferred_element_type=f32)
        return o.reshape(bsz, A_QBLK, A_HEADS * A_HEAD_DIM).astype(h.dtype)

    o = lax.map(block, jnp.arange(seq // A_QBLK))
    o = jnp.moveaxis(o, 0, 1).reshape(bsz, seq, A_HEADS * A_HEAD_DIM)
    return o @ w_out


def mla_mixer(h, w_in, q_norm, kv_norm, w_q_up, w_kv_up, w_out, cos_b, sin_b):
    bsz, seq, _ = h.shape
    f32 = jnp.float32
    proj = h @ w_in
    cq, ckv, kr = jnp.split(proj, [B_Q_LORA, B_Q_LORA + B_KV_LORA], axis=-1)
    cq = rms_norm(cq, q_norm)
    ckv = rms_norm(ckv, kv_norm)
    qf = (cq @ w_q_up).reshape(bsz, seq, B_HEADS, B_NOPE + B_ROPE)
    q_nope, q_rope = qf[..., :B_NOPE], apply_rope(qf[..., B_NOPE:], cos_b, sin_b)
    kr = apply_rope(kr[:, :, None, :], cos_b, sin_b)[:, :, 0, :]
    kv = (ckv @ w_kv_up).reshape(bsz, seq, B_HEADS, B_NOPE + B_V)
    k_nope, v = kv[..., :B_NOPE], kv[..., B_NOPE:]
    scale = (B_NOPE + B_ROPE) ** -0.5
    key_pos = jnp.arange(seq)

    def block(i):
        start = i * B_QBLK
        qn = lax.dynamic_slice_in_dim(q_nope, start, B_QBLK, axis=1)
        qr = lax.dynamic_slice_in_dim(q_rope, start, B_QBLK, axis=1)
        s = (jnp.einsum('bthd,bshd->bhts', qn, k_nope, preferred_element_type=f32)
             + jnp.einsum('bthd,bsd->bhts', qr, kr, preferred_element_type=f32)) * scale
        q_pos = start + jnp.arange(B_QBLK)
        chunk_end = (q_pos // CHUNK + 1) * CHUNK
        mask = key_pos[None, :] < chunk_end[:, None]
        s = jnp.where(mask[None, None], s, -jnp.inf)
        p = jax.nn.softmax(s, axis=-1)
        o = jnp.einsum('bhts,bshd->bthd', p.astype(v.dtype), v, preferred_element_type=f32)
        return o.reshape(bsz, B_QBLK, B_HEADS * B_V).astype(h.dtype)

    o = lax.map(block, jnp.arange(seq // B_QBLK))
    o = jnp.moveaxis(o, 0, 1).reshape(bsz, seq, B_HEADS * B_V)
    return o @ w_out


def squared_relu_mlp(h, w_up, w_down):
    a = jax.nn.relu(h @ w_up)
    return (a * a) @ w_down


def setup_inputs(seed: int = 0) -> dict:
    key = jax.random.key(seed)
    ks = jax.random.split(key, 20)
    f32 = jnp.float32

    def nrm(k, shape, fan_in):
        return jax.random.normal(k, shape, f32) * (fan_in ** -0.5)

    def gain(k, shape):
        return 1.0 + 0.02 * jax.random.normal(k, shape, f32)

    x = jax.random.normal(ks[0], (BATCH, SEQ, D_MODEL), f32)
    starts = jax.random.randint(ks[1], (BATCH, 1), 0, 64, dtype=jnp.int32) * CHUNK
    positions = (starts + jnp.arange(SEQ, dtype=jnp.int32)[None, :]).astype(jnp.int32)
    return {
        'x': x,
        'positions': positions,
        'attn_norm': gain(ks[2], (DEPTH, D_MODEL)),
        'mlp_norm': gain(ks[3], (DEPTH, D_MODEL)),
        'a_w_in': nrm(ks[4], (N_A, D_MODEL, A_IN), D_MODEL),
        'a_w_out': nrm(ks[5], (N_A, A_HEADS * A_HEAD_DIM, D_MODEL), A_HEADS * A_HEAD_DIM),
        'b_w_in': nrm(ks[6], (N_B, D_MODEL, B_IN), D_MODEL),
        'b_q_norm': gain(ks[7], (N_B, B_Q_LORA)),
        'b_kv_norm': gain(ks[8], (N_B, B_KV_LORA)),
        'b_w_q_up': nrm(ks[9], (N_B, B_Q_LORA, B_HEADS * (B_NOPE + B_ROPE)), B_Q_LORA),
        'b_w_kv_up': nrm(ks[10], (N_B, B_KV_LORA, B_HEADS * (B_NOPE + B_V)), B_KV_LORA),
        'b_w_out': nrm(ks[11], (N_B, B_HEADS * B_V, D_MODEL), B_HEADS * B_V),
        'mlp_w_up': nrm(ks[12], (DEPTH, D_MODEL, D_FF), D_MODEL),
        'mlp_w_down': nrm(ks[13], (DEPTH, D_FF, D_MODEL), D_FF),
        'final_norm': gain(ks[14], (D_MODEL,)),
    }


def reference(x, positions, attn_norm, mlp_norm, a_w_in, a_w_out, b_w_in, b_q_norm, b_kv_norm,
              b_w_q_up, b_w_kv_up, b_w_out, mlp_w_up, mlp_w_down, final_norm):
    cos_a, sin_a = rope_angles(positions, A_ROT)
    cos_i, sin_i = rope_angles(positions, IDX_ROT)
    cos_b, sin_b = rope_angles(positions, B_ROPE)
    for i in range(DEPTH):
        h = rms_norm(x, attn_norm[i])
        j = i // N_MIXERS
        if i % N_MIXERS == 0:
            x = x + dsa_mixer(h, a_w_in[j], a_w_out[j], cos_a, sin_a, cos_i, sin_i)
        else:
            x = x + mla_mixer(h, b_w_in[j], b_q_norm[j], b_kv_norm[j], b_w_q_up[j],
                              b_w_kv_up[j], b_w_out[j], cos_b, sin_b)
        h = rms_norm(x, mlp_norm[i])
        x = x + squared_relu_mlp(h, mlp_w_up[i], mlp_w_down[i])
    return rms_norm(x, final_norm)
```

```cpp
#include <hip/hip_runtime.h>
#include <cstdio>
#include <cstdint>
#include <cmath>
namespace pg8 {
#define PG8_LAS __attribute__((address_space(3)))
typedef unsigned short bf16_t;
typedef short bf16x8 __attribute__((ext_vector_type(8)));
typedef float f32x4 __attribute__((ext_vector_type(4)));
typedef unsigned u32x4 __attribute__((ext_vector_type(4)));
constexpr int BM = 256, BK = 64, HALF = 128, HTB = HALF * BK * 2  , STAGE_BYTES = 8 * HTB, NXCD = 8, WGM = 8;

__host__ __device__ __forceinline__ int lds_byte(int r, int c) { const int st = (r >> 4) * 2 + (c >> 5), rr = r & 15, cc = c & 31, ob = rr * 64 + cc * 2; return st * 1024 + (ob ^ (((ob >> 9) & 1) << 5)); }
__host__ __device__ __forceinline__ void stage_rc(int b, int& R, int& C) { const int st = b / 1024, sb = b % 1024, swz = sb ^ (((sb >> 9) & 1) << 5); R = (st >> 1) * 16 + swz / 64; C = (st & 1) * 32 + (swz % 64) / 2; }
__host__ __device__ __forceinline__ int perm32(int rho) { const int n = rho >> 4, i = rho & 15; return 8 * (i >> 2) + 4 * n + (i & 3); }

struct Unit { int pm, pn; };
struct Gemm { const bf16_t* A; const bf16_t* Bt; int M, N, K, lda, ldb; };

struct StaticOrder {
    int nM, nN, nwg, G, c;
    __host__ __device__ void init(int M, int N, int G_, int c_) { nM = M / BM; nN = N / BM; nwg = nM * nN; G = G_; c = c_; }
    __host__ __device__ bool next(int i, Unit& u) const {
        const long L = (long)i * G + c; if (L >= nwg) return false;
        int wgid = (int)L; { const int q = nwg / NXCD, r = nwg % NXCD, xcd = wgid % NXCD, off = wgid / NXCD; wgid = (xcd < r ? xcd * (q + 1) : r * (q + 1) + (xcd - r) * q) + off; }
        const int nig = WGM * nN, gid = wgid / nig, fm = gid * WGM, gsz = (nM - fm) < WGM ? (nM - fm) : WGM;
        u.pm = fm + ((wgid % nig) % gsz); u.pn = (wgid % nig) / gsz; return true;
    }
    __device__ __forceinline__ void a_ready(const Unit&) const {}
    __device__ __forceinline__ void done(const Unit&) const {}
};

__device__ __forceinline__ unsigned cvt_pk_bf16(float lo, float hi) { unsigned r; asm volatile("v_cvt_pk_bf16_f32 %0, %1, %2" : "=v"(r) : "v"(lo), "v"(hi)); return r; }
typedef _Float16 f16x8_t __attribute__((ext_vector_type(8)));
typedef _Float16 f16x2_t __attribute__((ext_vector_type(2)));
template <bool F16> __device__ __forceinline__ f32x4 mma16(bf16x8 a, bf16x8 b, f32x4 c) {
    if constexpr (F16) return __builtin_amdgcn_mfma_f32_16x16x32_f16(__builtin_bit_cast(f16x8_t, a), __builtin_bit_cast(f16x8_t, b), c, 0, 0, 0);
    else return __builtin_amdgcn_mfma_f32_16x16x32_bf16(a, b, c, 0, 0, 0);
}
__device__ __forceinline__ unsigned cvt_pk_f16(float lo, float hi) { f16x2_t t = {(_Float16)lo, (_Float16)hi}; return __builtin_bit_cast(unsigned, t); }
__device__ __forceinline__ u32x4 pack8_bf16(f32x4 a, f32x4 b) { u32x4 w; w.x = cvt_pk_bf16(a[0], a[1]); w.y = cvt_pk_bf16(a[2], a[3]); w.z = cvt_pk_bf16(b[0], b[1]); w.w = cvt_pk_bf16(b[2], b[3]); return w; }
__device__ __forceinline__ u32x4 pack8_f16(f32x4 a, f32x4 b) { u32x4 w; w.x = cvt_pk_f16(a[0], a[1]); w.y = cvt_pk_f16(a[2], a[3]); w.z = cvt_pk_f16(b[0], b[1]); w.w = cvt_pk_f16(b[2], b[3]); return w; }
typedef unsigned u32x2 __attribute__((ext_vector_type(2)));
__device__ __forceinline__ u32x2 pack4_bf16(f32x4 a) { u32x2 w; w.x = cvt_pk_bf16(a[0], a[1]); w.y = cvt_pk_bf16(a[2], a[3]); return w; }
__device__ __forceinline__ f32x4 shfl4(f32x4 v, int x) { f32x4 r; r[0] = __shfl_xor(v[0], x); r[1] = __shfl_xor(v[1], x); r[2] = __shfl_xor(v[2], x); r[3] = __shfl_xor(v[3], x); return r; }
__device__ __forceinline__ float sum4(f32x4 v) { return (v[0] + v[1]) + (v[2] + v[3]); }
__device__ __forceinline__ float dot4(f32x4 v) { return (v[0] * v[0] + v[1] * v[1]) + (v[2] * v[2] + v[3] * v[3]); }
constexpr float RMS_EPS = 1e-6f;
__device__ __forceinline__ float rstd_from(const float* p, int n4, float inv_cnt) {
    float s = 0.f;
#pragma unroll 4
    for (int i = 0; i < n4; ++i) s += sum4(((const f32x4*)p)[i]);
    return __builtin_amdgcn_rsqf(s * inv_cnt + RMS_EPS);
}

struct EpiDsaIn {
    static constexpr bool PERM = true, AFTER_DRAIN = false;
    bf16_t* PA; float* WI; const float* SS; const float* cosA; const float* sinA; float wscale;
    __device__ __forceinline__ void operator()(const f32x4 (&acc)[2][2][4][2], const Unit& u, int wr, int wc, int fr, int fq) const {
#pragma unroll
        for (int ai = 0; ai < 2; ++ai)
#pragma unroll
            for (int m = 0; m < 4; ++m) {
                const int row = u.pm * BM + ai * HALF + wr * 64 + m * 16 + fr;
                asm volatile("" ::: "memory");
                const float rs = rstd_from(SS + (size_t)row * 16, 4, 1.0f / 1024.0f);
                const f32x4 c0 = *(const f32x4*)(cosA + (size_t)row * 8), c1 = *(const f32x4*)(cosA + (size_t)row * 8 + 4);
                const f32x4 s0 = *(const f32x4*)(sinA + (size_t)row * 8), s1 = *(const f32x4*)(sinA + (size_t)row * 8 + 4);
#pragma unroll
                for (int bj = 0; bj < 2; ++bj) {
                    const int cb = u.pn * BM + bj * HALF + wc * 32;
                    const int col8 = cb + 8 * fq;
                    f32x4 v0 = acc[ai][bj][m][0] * rs, v1 = acc[ai][bj][m][1] * rs;
                    const bool ropeg = ((cb & 63) == 0) && (cb < 1280 || (cb >= 1536 && cb < 2112));
                    if (ropeg) {
                        const f32x4 p0 = shfl4(v0, 16), p1 = shfl4(v1, 16);
                        if (fq == 0) { v0 = v0 * c0 - p0 * s0; v1 = v1 * c1 - p1 * s1; }
                        else if (fq == 1) { v0 = v0 * c0 + p0 * s0; v1 = v1 * c1 + p1 * s1; }
                    }
                    if (cb < 2112) *(u32x4*)(PA + (size_t)row * 2304 + col8) = pack8_f16(v0, v1);
                    else if (cb == 2112 && fq == 0) { *(f32x4*)(WI + (size_t)row * 8) = v0 * wscale; *(f32x4*)(WI + (size_t)row * 8 + 4) = v1 * wscale; }
                }
            }
    }
};
struct EpiResid {
    static constexpr bool PERM = true, AFTER_DRAIN = false;
    const float* base; float* out; bf16_t* XB; float* SS;
    __device__ __forceinline__ void operator()(const f32x4 (&acc)[2][2][4][2], const Unit& u, int wr, int wc, int fr, int fq) const {
#pragma unroll
        for (int ai = 0; ai < 2; ++ai)
#pragma unroll
            for (int m = 0; m < 4; ++m) {
                const int row = u.pm * BM + ai * HALF + wr * 64 + m * 16 + fr;
                float ssq = 0.f;
#pragma unroll
                for (int bj = 0; bj < 2; ++bj) {
                    const int col8 = u.pn * BM + bj * HALF + wc * 32 + 8 * fq;
                    const float* bp = base + (size_t)row * 1024 + col8;
                    const f32x4 v0 = acc[ai][bj][m][0] + *(const f32x4*)bp, v1 = acc[ai][bj][m][1] + *(const f32x4*)(bp + 4);
                    float* op = out + (size_t)row * 1024 + col8;
                    *(f32x4*)op = v0; *(f32x4*)(op + 4) = v1;
                    if (XB) *(u32x4*)(XB + (size_t)row * 1024 + col8) = pack8_bf16(v0, v1);
                    ssq += dot4(v0) + dot4(v1);
                }
                ssq += __shfl_xor(ssq, 16); ssq += __shfl_xor(ssq, 32);
                if (fq == 0) SS[(size_t)row * 16 + u.pn * 4 + wc] = ssq;
            }
    }
};
struct EpiMlpUp {
    static constexpr bool PERM = true, AFTER_DRAIN = false;
    bf16_t* H; const float* SS;
    __device__ __forceinline__ void operator()(const f32x4 (&acc)[2][2][4][2], const Unit& u, int wr, int wc, int fr, int fq) const {
#pragma unroll
        for (int ai = 0; ai < 2; ++ai)
#pragma unroll
            for (int m = 0; m < 4; ++m) {
                const int row = u.pm * BM + ai * HALF + wr * 64 + m * 16 + fr;
                const float rs = rstd_from(SS + (size_t)row * 16, 4, 1.0f / 1024.0f);
#pragma unroll
                for (int bj = 0; bj < 2; ++bj) {
                    const int col8 = u.pn * BM + bj * HALF + wc * 32 + 8 * fq;
                    f32x4 v0 = acc[ai][bj][m][0] * rs, v1 = acc[ai][bj][m][1] * rs;
                    const f32x4 z = {0.f, 0.f, 0.f, 0.f};
                    v0 = __builtin_elementwise_max(v0, z); v1 = __builtin_elementwise_max(v1, z);
                    *(u32x4*)(H + (size_t)row * 4096 + col8) = pack8_bf16(v0 * v0, v1 * v1);
                }
            }
    }
};
struct EpiMlaIn {
    static constexpr bool PERM = false, AFTER_DRAIN = false;
    bf16_t* CB; float* SSB; const float* SS; const float* cosB; const float* sinB;
    __device__ __forceinline__ void operator()(const f32x4 (&acc)[2][2][4][2], const Unit& u, int wr, int wc, int fr, int fq) const {
#pragma unroll
        for (int ai = 0; ai < 2; ++ai)
#pragma unroll
            for (int m = 0; m < 4; ++m) {
                const int row = u.pm * BM + ai * HALF + wr * 64 + m * 16 + fr;
                const float rs = rstd_from(SS + (size_t)row * 16, 4, 1.0f / 1024.0f);
#pragma unroll
                for (int bj = 0; bj < 2; ++bj) {
                    const int cb = u.pn * BM + bj * HALF + wc * 32;
                    f32x4 v0 = acc[ai][bj][m][0] * rs, v1 = acc[ai][bj][m][1] * rs;
                    if (cb == 640) {
                        const f32x4 c = *(const f32x4*)(cosB + (size_t)row * 16 + 4 * fq), s = *(const f32x4*)(sinB + (size_t)row * 16 + 4 * fq);
                        const f32x4 o0 = v0 * c - v1 * s, o1 = v1 * c + v0 * s; v0 = o0; v1 = o1;
                    }
                    if (cb < 672) { bf16_t* p = CB + (size_t)row * 768 + cb + 4 * fq; *(u32x2*)p = pack4_bf16(v0); *(u32x2*)(p + 16) = pack4_bf16(v1); }
                    if (cb < 640) {
                        float ssq = dot4(v0) + dot4(v1);
                        ssq += __shfl_xor(ssq, 16); ssq += __shfl_xor(ssq, 32);
                        if (fq == 0) SSB[(size_t)row * 24 + (cb >> 5)] = ssq;
                    }
                }
            }
    }
};
struct EpiQUp {
    static constexpr bool PERM = false, AFTER_DRAIN = false;
    bf16_t* QB; const float* SSB; const float* cosB; const float* sinB; float qscale;
    __device__ __forceinline__ void operator()(const f32x4 (&acc)[2][2][4][2], const Unit& u, int wr, int wc, int fr, int fq) const {
#pragma unroll
        for (int ai = 0; ai < 2; ++ai)
#pragma unroll
            for (int m = 0; m < 4; ++m) {
                const int row = u.pm * BM + ai * HALF + wr * 64 + m * 16 + fr;
                asm volatile("" ::: "memory");
                const float rs = rstd_from(SSB + (size_t)row * 24, 3, 1.0f / 384.0f) * qscale;
                const f32x4 c = *(const f32x4*)(cosB + (size_t)row * 16 + 4 * fq), s = *(const f32x4*)(sinB + (size_t)row * 16 + 4 * fq);
#pragma unroll
                for (int bj = 0; bj < 2; ++bj) {
                    const int cb = u.pn * BM + bj * HALF + wc * 32;
                    f32x4 v0 = acc[ai][bj][m][0] * rs, v1 = acc[ai][bj][m][1] * rs;
                    if (((cb >> 5) % 3) == 2) { const f32x4 o0 = v0 * c - v1 * s, o1 = v1 * c + v0 * s; v0 = o0; v1 = o1; }
                    bf16_t* p = QB + (size_t)row * 1536 + cb + 4 * fq; *(u32x2*)p = pack4_bf16(v0); *(u32x2*)(p + 16) = pack4_bf16(v1);
                }
            }
    }
};
struct EpiKvUp {
    static constexpr bool PERM = true, AFTER_DRAIN = false;
    bf16_t* KVB; const float* SSB;
    __device__ __forceinline__ void operator()(const f32x4 (&acc)[2][2][4][2], const Unit& u, int wr, int wc, int fr, int fq) const {
#pragma unroll
        for (int ai = 0; ai < 2; ++ai)
#pragma unroll
            for (int m = 0; m < 4; ++m) {
                const int row = u.pm * BM + ai * HALF + wr * 64 + m * 16 + fr;
                const float rs = rstd_from(SSB + (size_t)row * 24 + 12, 2, 1.0f / 256.0f);
#pragma unroll
                for (int bj = 0; bj < 2; ++bj) {
                    const int col8 = u.pn * BM + bj * HALF + wc * 32 + 8 * fq;
                    *(u32x4*)(KVB + (size_t)row * 2048 + col8) = pack8_bf16(acc[ai][bj][m][0] * rs, acc[ai][bj][m][1] * rs);
                }
            }
    }
};
template <class Epi, class Sched, bool ALIGN_EPI = false, bool SP2 = false, bool F16 = false>
__device__ __forceinline__ void gemm_phase(PG8_LAS unsigned char* lds, const Gemm g, const Sched& S, const Epi& E) {
    const int tid = threadIdx.x, wid = __builtin_amdgcn_readfirstlane(tid >> 6), lane = tid & 63, wr = wid >> 2, wc = wid & 3, fr = lane & 15, fq = lane >> 4;
    const int K = g.K, nt = K / BK;
    unsigned voffA[2], voffB[2];
#pragma unroll
    for (int i = 0; i < 2; ++i) { int R, C; stage_rc(tid * 16 + i * 8192, R, C); const int Rb = Epi::PERM ? ((R & ~31) + perm32(R & 31)) : R;
        voffA[i] = (unsigned)(R * g.lda + C) * 2u; voffB[i] = (unsigned)(Rb * g.ldb + C) * 2u; }
    const size_t kstep = (size_t)(BK * 2);
    const size_t hstepA = (size_t)HALF * g.lda * 2, hstepB = (size_t)HALF * g.ldb * 2;
    const size_t tstepA = 2 * hstepA, tstepB = 2 * hstepB;
    const unsigned ldsw = (unsigned)wid * 1024u;
    const int aoff = lds_byte(wr * 64 + fr, fq * 8), boff = lds_byte(wc * 32 + fr, fq * 8);
#define PG8_SA(b, h) (((b) * 2 + (h)) * HTB)
#define PG8_SB(b, h) ((4 + (b) * 2 + (h)) * HTB)
#define PG8_STAGE(bufoff, gbase, voff) do { _Pragma("unroll") for (int _i = 0; _i < 2; ++_i) \
        __builtin_amdgcn_global_load_lds((const unsigned*)((const char*)(gbase) + (voff)[_i]), (PG8_LAS unsigned*)(lds + (bufoff) + ldsw + _i * 8192), 16, 0, 0); } while (0)
#define PG8_LDA(dst, b, h) do { _Pragma("unroll") for (int m = 0; m < 4; ++m) _Pragma("unroll") for (int k = 0; k < 2; ++k) dst[m][k] = *(const PG8_LAS bf16x8*)(lds + PG8_SA(b, h) + aoff + m * 2048 + k * 1024); } while (0)
#define PG8_LDB(dst, b, h) do { _Pragma("unroll") for (int n = 0; n < 2; ++n) _Pragma("unroll") for (int k = 0; k < 2; ++k) dst[n][k] = *(const PG8_LAS bf16x8*)(lds + PG8_SB(b, h) + boff + n * 2048 + k * 1024); } while (0)
#define PG8_MMA(ai, bj, At, Bt) do { __builtin_amdgcn_s_setprio(1); _Pragma("unroll") for (int m = 0; m < 4; ++m) _Pragma("unroll") for (int n = 0; n < 2; ++n) _Pragma("unroll") for (int k = 0; k < 2; ++k) \
        acc[ai][bj][m][n] = mma16<F16>(Bt[n][k], At[m][k], acc[ai][bj][m][n]); __builtin_amdgcn_s_setprio(0); } while (0)
#define PG8_WAIT_V(n) asm volatile("s_waitcnt vmcnt(" #n ")" ::: "memory")
#define PG8_WAIT_L(n) asm volatile("s_waitcnt lgkmcnt(" #n ")" ::: "memory")
#define PG8_BAR __builtin_amdgcn_s_barrier()
#define PG8_SCHED __builtin_amdgcn_sched_barrier(0)
    Unit cur, nxt; int ui = 0;
    if (!S.next(0, cur)) return;
    f32x4 acc[2][2][4][2];
#pragma unroll
    for (int a = 0; a < 2; ++a)
#pragma unroll
        for (int b = 0; b < 2; ++b)
#pragma unroll
            for (int m = 0; m < 4; ++m)
#pragma unroll
                for (int n = 0; n < 2; ++n) acc[a][b][m][n] = (f32x4){0.f, 0.f, 0.f, 0.f};
    bf16x8 At[4][2], B0[2][2], B1[2][2];
    const char* cA = (const char*)g.A + (size_t)cur.pm * tstepA; const char* cB = (const char*)g.Bt + (size_t)cur.pn * tstepB;
    S.a_ready(cur);
    if constexpr (SP2) {
        PG8_STAGE(PG8_SB(0, 0), cB, voffB); PG8_STAGE(PG8_SB(0, 1), cB + hstepB, voffB); PG8_STAGE(PG8_SA(0, 0), cA, voffA); PG8_STAGE(PG8_SA(0, 1), cA + hstepA, voffA);
        if (wr == 1) PG8_BAR;
        PG8_WAIT_V(2); PG8_BAR;
        PG8_STAGE(PG8_SB(1, 0), cB + kstep, voffB); PG8_STAGE(PG8_SA(1, 0), cA + kstep, voffA); PG8_STAGE(PG8_SB(1, 1), cB + hstepB + kstep, voffB);
        PG8_WAIT_V(6); PG8_BAR;
    } else {
        PG8_STAGE(PG8_SB(0, 0), cB, voffB); PG8_STAGE(PG8_SA(0, 0), cA, voffA); PG8_STAGE(PG8_SB(0, 1), cB + hstepB, voffB); PG8_STAGE(PG8_SA(0, 1), cA + hstepA, voffA);
        if (wr == 1) PG8_BAR;
        PG8_WAIT_V(4); PG8_BAR;
        PG8_STAGE(PG8_SB(1, 0), cB + kstep, voffB); PG8_STAGE(PG8_SA(1, 0), cA + kstep, voffA); PG8_STAGE(PG8_SB(1, 1), cB + hstepB + kstep, voffB);
        PG8_WAIT_V(6); PG8_BAR;
    }
    for (;;) {
        const bool has_next = S.next(ui + 1, nxt);
        const char* nA = has_next ? (const char*)g.A + (size_t)nxt.pm * tstepA : cA; const char* nB = has_next ? (const char*)g.Bt + (size_t)nxt.pn * tstepB : cB;
#pragma nounroll
        for (int t = 0; t < nt; t += 2) {
            const bool last = (t == nt - 2);
            const char* a1 = cA + (size_t)(t + 1) * kstep;
            const char* a2 = last ? nA : cA + (size_t)(t + 2) * kstep; const char* b2 = last ? nB : cB + (size_t)(t + 2) * kstep;
            const char* a3 = a2 + kstep; const char* b3 = b2 + kstep;
            if (last && has_next) S.a_ready(nxt);
            if constexpr (SP2) {
            PG8_LDB(B0, 0, 0); PG8_LDB(B1, 0, 1); PG8_SCHED; PG8_LDA(At, 0, 0); PG8_STAGE(PG8_SA(1, 1), a1 + hstepA, voffA);
            PG8_WAIT_V(8); PG8_WAIT_L(0); PG8_BAR; PG8_MMA(0, 0, At, B0); PG8_MMA(0, 1, At, B1); PG8_BAR; PG8_SCHED;
            PG8_LDA(At, 0, 1); PG8_STAGE(PG8_SB(0, 0), b2, voffB); PG8_STAGE(PG8_SB(0, 1), b2 + hstepB, voffB); PG8_STAGE(PG8_SA(0, 0), a2, voffA);
            PG8_WAIT_V(8); PG8_WAIT_L(0); PG8_BAR; PG8_MMA(1, 0, At, B0); PG8_MMA(1, 1, At, B1); PG8_BAR; PG8_SCHED;
            PG8_LDB(B0, 1, 0); PG8_LDB(B1, 1, 1); PG8_SCHED; PG8_LDA(At, 1, 0); PG8_STAGE(PG8_SA(0, 1), a2 + hstepA, voffA);
            PG8_WAIT_V(8); PG8_WAIT_L(0); PG8_BAR; PG8_MMA(0, 0, At, B0); PG8_MMA(0, 1, At, B1); PG8_BAR; PG8_SCHED;
            PG8_LDA(At, 1, 1); PG8_STAGE(PG8_SB(1, 0), b3, voffB); PG8_STAGE(PG8_SB(1, 1), b3 + hstepB, voffB); PG8_STAGE(PG8_SA(1, 0), a3, voffA);
            PG8_WAIT_V(8); PG8_WAIT_L(0); PG8_BAR; PG8_MMA(1, 0, At, B0); PG8_MMA(1, 1, At, B1); PG8_BAR; PG8_SCHED;
            } else {
            PG8_LDB(B0, 0, 0); PG8_SCHED; PG8_LDA(At, 0, 0); PG8_STAGE(PG8_SA(1, 1), a1 + hstepA, voffA);
            PG8_WAIT_L(8); PG8_BAR; PG8_WAIT_L(0); PG8_MMA(0, 0, At, B0); PG8_BAR; PG8_SCHED;
            PG8_LDB(B1, 0, 1); PG8_STAGE(PG8_SB(0, 0), b2, voffB);
            PG8_BAR; PG8_WAIT_L(0); PG8_MMA(0, 1, At, B1); PG8_BAR;
            PG8_LDA(At, 0, 1); PG8_STAGE(PG8_SA(0, 0), a2, voffA);
            PG8_BAR; PG8_WAIT_L(0); PG8_MMA(1, 0, At, B0); PG8_BAR; PG8_SCHED;
            PG8_STAGE(PG8_SB(0, 1), b2 + hstepB, voffB);
            PG8_WAIT_V(6); PG8_BAR; PG8_MMA(1, 1, At, B1); PG8_BAR;
            PG8_LDB(B0, 1, 0); PG8_SCHED; PG8_LDA(At, 1, 0); PG8_STAGE(PG8_SA(0, 1), a2 + hstepA, voffA);
            PG8_WAIT_L(8); PG8_BAR; PG8_WAIT_L(0); PG8_MMA(0, 0, At, B0); PG8_BAR; PG8_SCHED;
            PG8_LDB(B1, 1, 1); PG8_STAGE(PG8_SB(1, 0), b3, voffB);
            PG8_BAR; PG8_WAIT_L(0); PG8_MMA(0, 1, At, B1); PG8_BAR;
            PG8_LDA(At, 1, 1); PG8_STAGE(PG8_SA(1, 0), a3, voffA);
            PG8_BAR; PG8_WAIT_L(0); PG8_MMA(1, 0, At, B0); PG8_BAR; PG8_SCHED;
            PG8_STAGE(PG8_SB(1, 1), b3 + hstepB, voffB);
            PG8_WAIT_V(6); PG8_BAR; PG8_MMA(1, 1, At, B1); PG8_BAR;
            }
        }
        if constexpr (ALIGN_EPI) { if (wr == 0) PG8_BAR; }
        if constexpr (!Epi::AFTER_DRAIN) { E(acc, cur, wr, wc, fr, fq); S.done(cur); }
        if (!has_next) break;
#pragma unroll
        for (int a = 0; a < 2; ++a)
#pragma unroll
            for (int b = 0; b < 2; ++b)
#pragma unroll
                for (int m = 0; m < 4; ++m)
#pragma unroll
                    for (int n = 0; n < 2; ++n) acc[a][b][m][n] = (f32x4){0.f, 0.f, 0.f, 0.f};
        cur = nxt; cA = nA; cB = nB; ++ui;
        if constexpr (ALIGN_EPI) { if (wr == 1) PG8_BAR; }
    }
    PG8_WAIT_V(0);
    if constexpr (!ALIGN_EPI) { if (wr == 0) PG8_BAR; }
    PG8_BAR;
    if constexpr (Epi::AFTER_DRAIN) { E.fused(acc, cur, wr, wc, fr, fq, lds, wid, lane); S.done(cur); }
#undef PG8_SA
#undef PG8_SB
#undef PG8_STAGE
#undef PG8_LDA
#undef PG8_LDB
#undef PG8_MMA
#undef PG8_WAIT_V
#undef PG8_WAIT_L
#undef PG8_BAR
#undef PG8_SCHED
}
}
constexpr int NWAVES = 8;
#ifndef MK_N_LAUNCHES
#define MK_N_LAUNCHES 13
#endif
constexpr int N_PHASES = 13;
constexpr int N_LAUNCHES = MK_N_LAUNCHES;
constexpr int BATCH = 16, SEQ = 2048, DM = 1024, M = BATCH * SEQ, FF = 4096;
constexpr int A_IN = 2120, A_INP = 2304, B_IN = 672, B_INP = 768, QUP = 1536, KVUP = 2048, QLORA = 384, KVLORA = 256;
constexpr size_t MiB = 1u << 20;
constexpr size_t WS_CTL = 0, CTL_ZERO_BYTES = 64 * 1024;
constexpr size_t WS_WAIN = 1 * MiB, WS_WAOUT = 6 * MiB, WS_WUP0 = 8 * MiB, WS_WUP1 = 16 * MiB, WS_WDN0 = 24 * MiB, WS_WDN1 = 32 * MiB;
constexpr size_t WS_WBIN = 40 * MiB, WS_WQUP = 42 * MiB, WS_WKVUP = 44 * MiB, WS_WBOUT = 46 * MiB;
constexpr size_t WS_COSA = 48 * MiB, WS_SINA = 49 * MiB, WS_COSB = 50 * MiB, WS_SINB = 52 * MiB;
constexpr size_t WS_SS = 54 * MiB, WS_SSB = 56 * MiB, WS_WI = 59 * MiB;
constexpr size_t WS_XB = 64 * MiB;
constexpr size_t WS_BIG = 128 * MiB;
constexpr size_t WS_PA = WS_BIG, WS_OA = WS_BIG + 144 * MiB;
constexpr size_t WS_H = WS_BIG;
constexpr size_t WS_CB = WS_BIG, WS_QB = WS_BIG + 48 * MiB, WS_OB = WS_BIG + 144 * MiB;
constexpr size_t WS_KVB = 384 * MiB, WS_END = 512 * MiB;
static_assert(WS_WAIN + (size_t)A_INP * DM * 2 <= WS_WAOUT && WS_WBIN + (size_t)B_INP * DM * 2 <= WS_WQUP && WS_WQUP + (size_t)QUP * QLORA * 2 <= WS_WKVUP && WS_WKVUP + (size_t)KVUP * KVLORA * 2 <= WS_WBOUT, "weights map");
static_assert(WS_SSB + (size_t)M * 24 * 4 <= WS_WI && WS_WI + (size_t)M * 8 * 4 <= WS_XB && WS_PA + (size_t)M * A_INP * 2 <= WS_OA && WS_OA + (size_t)M * DM * 2 <= WS_KVB && WS_QB + (size_t)M * QUP * 2 <= WS_OB, "activation map");
constexpr int CW_BAR = 1024;
constexpr int RING_BYTES = 131072, LDSCTL_OFF = RING_BYTES, MISC_OFF = LDSCTL_OFF + 320, LDS_BYTES = 147456;
constexpr float IDX_WSCALE = 0.044194173824159216f;
constexpr float QSCALE_B = 0.10206207261596577f * 1.4426950408889634f;

#define GAS __attribute__((address_space(1)))
#define LAS __attribute__((address_space(3)))
typedef unsigned short bf16;
typedef unsigned v4u __attribute__((ext_vector_type(4)));
typedef float f32x4 __attribute__((ext_vector_type(4)));
typedef short bf16x8 __attribute__((ext_vector_type(8)));
typedef GAS unsigned gu32;
typedef GAS unsigned long long gu64;
#define RLX_AGENT __ATOMIC_RELAXED, __HIP_MEMORY_SCOPE_AGENT
#define LDS_WAIT() asm volatile("s_waitcnt lgkmcnt(0)" ::: "memory")
#define VM_WAIT() asm volatile("s_waitcnt vmcnt(0)" ::: "memory")
__device__ __forceinline__ unsigned long long rt() { return __builtin_amdgcn_s_memrealtime(); }
__device__ __forceinline__ unsigned f2bf(float f) { unsigned u = __builtin_bit_cast(unsigned, f); return (u + 0x7fffu + ((u >> 16) & 1u)) >> 16; }
__device__ __forceinline__ unsigned pk2(float lo, float hi) { return f2bf(lo) | (f2bf(hi) << 16); }

#define XB_TMO      128
#define XB_XCNT(j)  (256  + 64 * (j))
#define XB_XSUB(j)  (1280 + 64 * (j))
#define XB_XGEN(j)  (2304 + 64 * (j))
#define XB_TOP      3328
#define XB_TOPGEN   3392
#define XCD_BAR_WORDS 3456
#define XB_SPIN_CAP (1u << 18)

__device__ __forceinline__ unsigned xb_ld(unsigned* p)              { return __hip_atomic_load(p, __ATOMIC_RELAXED, __HIP_MEMORY_SCOPE_AGENT); }
__device__ __forceinline__ unsigned xb_add(unsigned* p, unsigned v) { return __hip_atomic_fetch_add(p, v, __ATOMIC_RELAXED, __HIP_MEMORY_SCOPE_AGENT); }
__device__ __forceinline__ unsigned xb_xcc_id() { return (unsigned)__builtin_amdgcn_s_getreg((3 << 11) | 20) & 0xFu; }
#define XB_SPIN(cond, bar) do { unsigned _sp = 0; while (cond) { __builtin_amdgcn_s_sleep(1); \
    if ((++_sp & 255u) == 0u) { if (xb_ld(&(bar)[XB_TMO])) break; if (_sp > XB_SPIN_CAP) { atomicAdd(&(bar)[XB_TMO], 1u); break; } } } } while (0)

struct XcdBarrier {
    unsigned* bar; unsigned x;
    volatile LAS unsigned* st;
};

__device__ __forceinline__ XcdBarrier xcd_barrier_post(unsigned* bar, volatile LAS unsigned* st) {
    XcdBarrier b; b.bar = bar; b.x = xb_xcc_id(); b.st = st;
    if (threadIdx.x == 0) (void)xb_add(&bar[XB_XCNT(b.x)], 1u);
    return b;
}
__device__ __forceinline__ void xcd_barrier_complete(unsigned* bar, unsigned x, unsigned& nloc, unsigned& nx) {
    const unsigned G = gridDim.x * gridDim.y * gridDim.z;
    unsigned sum, cnt, mine, sp = 0u;
    for (;;) {
        sum = 0u; cnt = 0u; mine = 0u;
#pragma unroll
        for (unsigned j = 0; j < 16; ++j) { const unsigned c = xb_ld(&bar[XB_XCNT(j)]); sum += c; cnt += (c > 0u) ? 1u : 0u; mine = (j == x) ? c : mine; }
        if (sum == G) break;
        __builtin_amdgcn_s_sleep(1);
        if ((++sp & 255u) == 0u) { if (xb_ld(&bar[XB_TMO])) break; if (sp > XB_SPIN_CAP) { atomicAdd(&bar[XB_TMO], 1u); break; } }
    }
    nloc = mine > 0u ? mine : 1u; nx = cnt > 0u ? cnt : 1u;
}

__device__ __forceinline__ void xcd_barrier(const XcdBarrier& b) {
    asm volatile("s_waitcnt vmcnt(0)" ::: "memory");
    __syncthreads();
    if (threadIdx.x == 0) {
        unsigned* bar = b.bar;
        __builtin_amdgcn_s_waitcnt(0);
        unsigned nloc = b.st[0], nx = b.st[1];
        if (nloc == 0u) { xcd_barrier_complete(bar, b.x, nloc, nx); b.st[0] = nloc; b.st[1] = nx; }
        const unsigned old = xb_add(&bar[XB_XSUB(b.x)], 1u);
        const unsigned gen = old / nloc;
        if (old + 1u == (gen + 1u) * nloc) {
            __builtin_amdgcn_fence(__ATOMIC_RELEASE, "agent");
            asm volatile("s_waitcnt vmcnt(0)" ::: "memory");
            const unsigned og = xb_add(&bar[XB_TOP], 1u);
            const unsigned tg = og / nx;
            if (og + 1u == (tg + 1u) * nx) xb_add(&bar[XB_TOPGEN], 1u);
            else XB_SPIN(xb_ld(&bar[XB_TOPGEN]) == tg, bar);
            __builtin_amdgcn_fence(__ATOMIC_ACQUIRE, "agent");
            xb_add(&bar[XB_XGEN(b.x)], 1u);
            asm volatile("s_waitcnt vmcnt(0)" ::: "memory");
        } else {
            XB_SPIN(xb_ld(&bar[XB_XGEN(b.x)]) == gen, bar);
            __builtin_amdgcn_fence(__ATOMIC_ACQUIRE, "agent");
            asm volatile("s_waitcnt vmcnt(0)" ::: "memory");
        }
    }
    __syncthreads();
}
using pg8::u32x4; using pg8::u32x2;
struct Frame {
    LAS unsigned char* lds;
    volatile LAS unsigned* MISC;
    gu32* ctl;
    int tid, lane, wave, G;
};
__device__ __forceinline__ float wave_sum(float v) {
#pragma unroll
    for (int o = 1; o < 64; o <<= 1) v += __shfl_xor(v, o);
    return v;
}
typedef _Float16 half_t;
__device__ __forceinline__ unsigned short f2h(float f) { half_t h = (half_t)f; return __builtin_bit_cast(unsigned short, h); }
__device__ __forceinline__ float h2f(unsigned short u) { return (float)__builtin_bit_cast(half_t, u); }
__device__ __forceinline__ float bf2f(unsigned short u) { return __builtin_bit_cast(float, (unsigned)u << 16); }

template <bool F16>
__device__ __forceinline__ void p0_transpose_item(const float* W, int K, int N, const float* gain, bf16* WT, LAS float* scr, int item, int lane) {
    const int nblk = (N + 31) / 32, kb = item / nblk, nb = item % nblk, k0 = 64 * kb, n0 = 32 * nb;
#pragma unroll 8
    for (int i = 0; i < 32; ++i) { const int kk = 2 * i + (lane >> 5); const int n = n0 + (lane & 31);
        float v = (n < N) ? W[(size_t)(k0 + kk) * N + n] : 0.f; if (gain) v *= gain[k0 + kk]; scr[kk * 33 + (lane & 31)] = v; }
    LDS_WAIT(); asm volatile("" ::: "memory");
    const int c = lane & 7;
#pragma unroll
    for (int j = 0; j < 4; ++j) { const int n = (lane >> 3) + 8 * j; const LAS float* s = scr + (8 * c) * 33 + n;
        v4u o;
        if (F16) { o.x = (unsigned)f2h(s[0 * 33]) | ((unsigned)f2h(s[1 * 33]) << 16); o.y = (unsigned)f2h(s[2 * 33]) | ((unsigned)f2h(s[3 * 33]) << 16);
                   o.z = (unsigned)f2h(s[4 * 33]) | ((unsigned)f2h(s[5 * 33]) << 16); o.w = (unsigned)f2h(s[6 * 33]) | ((unsigned)f2h(s[7 * 33]) << 16); }
        else { o.x = pk2(s[0 * 33], s[1 * 33]); o.y = pk2(s[2 * 33], s[3 * 33]); o.z = pk2(s[4 * 33], s[5 * 33]); o.w = pk2(s[6 * 33], s[7 * 33]); }
        *(GAS v4u*)(WT + (size_t)(n0 + n) * K + k0 + 8 * c) = o; }
    LDS_WAIT(); asm volatile("" ::: "memory");
}
struct Args { const void* in[15]; float* out; unsigned char* ws; float inv_a[8]; float inv_b[16]; int ph_lo, ph_hi; };

__device__ __forceinline__ void p0_prologue(Frame& F, const Args& A) {
    unsigned char* ws = A.ws;
    LAS float* scr = (LAS float*)(F.lds + F.wave * 16384);
    const int gw = blockIdx.x * NWAVES + F.wave, NGW = F.G * NWAVES, lane = F.lane;
    const float* attn_norm = (const float*)A.in[2]; const float* mlp_norm = (const float*)A.in[3];
    constexpr int I_AIN = 16 * 67, I_AOUT = 16 * 32, I_UP = 16 * 128, I_DN = 64 * 32, I_BIN = 16 * 21, I_QUP = 6 * 48, I_KVUP = 4 * 64, I_BOUT = 16 * 32;
    constexpr int NITEMS = I_AIN + I_AOUT + 2 * I_UP + 2 * I_DN + I_BIN + I_QUP + I_KVUP + I_BOUT;
    for (int it = gw; it < NITEMS; it += NGW) {
        int r = it;
        if (r < I_AIN) { p0_transpose_item<true>((const float*)A.in[4], 1024, A_IN, attn_norm, (bf16*)(ws + WS_WAIN), scr, r, lane); continue; } r -= I_AIN;
        if (r < I_AOUT) { p0_transpose_item<false>((const float*)A.in[5], 1024, 1024, nullptr, (bf16*)(ws + WS_WAOUT), scr, r, lane); continue; } r -= I_AOUT;
        if (r < I_UP) { p0_transpose_item<false>((const float*)A.in[12], 1024, 4096, mlp_norm, (bf16*)(ws + WS_WUP0), scr, r, lane); continue; } r -= I_UP;
        if (r < I_UP) { p0_transpose_item<false>((const float*)A.in[12] + (size_t)1024 * 4096, 1024, 4096, mlp_norm + 1024, (bf16*)(ws + WS_WUP1), scr, r, lane); continue; } r -= I_UP;
        if (r < I_DN) { p0_transpose_item<false>((const float*)A.in[13], 4096, 1024, nullptr, (bf16*)(ws + WS_WDN0), scr, r, lane); continue; } r -= I_DN;
        if (r < I_DN) { p0_transpose_item<false>((const float*)A.in[13] + (size_t)4096 * 1024, 4096, 1024, nullptr, (bf16*)(ws + WS_WDN1), scr, r, lane); continue; } r -= I_DN;
        if (r < I_BIN) { p0_transpose_item<false>((const float*)A.in[6], 1024, B_IN, attn_norm + 1024, (bf16*)(ws + WS_WBIN), scr, r, lane); continue; } r -= I_BIN;
        if (r < I_QUP) { p0_transpose_item<false>((const float*)A.in[9], QLORA, QUP, (const float*)A.in[7], (bf16*)(ws + WS_WQUP), scr, r, lane); continue; } r -= I_QUP;
        if (r < I_KVUP) { p0_transpose_item<false>((const float*)A.in[10], KVLORA, KVUP, (const float*)A.in[8], (bf16*)(ws + WS_WKVUP), scr, r, lane); continue; } r -= I_KVUP;
        p0_transpose_item<false>((const float*)A.in[11], 1024, 1024, nullptr, (bf16*)(ws + WS_WBOUT), scr, r, lane);
    }
    {   const int gt = gw * 64 + lane, NT = NGW * 64;
        GAS v4u* z1 = (GAS v4u*)(ws + WS_WAIN + (size_t)2144 * 1024 * 2); const int n1 = (A_INP - 2144) * 1024 * 2 / 16;
        for (int i = gt; i < n1; i += NT) z1[i] = (v4u){0u, 0u, 0u, 0u};
        GAS v4u* z2 = (GAS v4u*)(ws + WS_WBIN + (size_t)B_IN * 1024 * 2); const int n2 = (B_INP - B_IN) * 1024 * 2 / 16;
        for (int i = gt; i < n2; i += NT) z2[i] = (v4u){0u, 0u, 0u, 0u};
        const int* pos = (const int*)A.in[1];
        float* cA = (float*)(ws + WS_COSA); float* sA = (float*)(ws + WS_SINA); float* cB = (float*)(ws + WS_COSB); float* sB = (float*)(ws + WS_SINB);
        for (int i = gt; i < M * 8; i += NT) { const float ang = (float)pos[i >> 3] * A.inv_a[i & 7]; double rev = (double)ang * 0.15915494309189535; rev -= __builtin_rint(rev); const float fr = (float)rev;
            cA[i] = __builtin_amdgcn_cosf(fr); sA[i] = __builtin_amdgcn_sinf(fr); }
        for (int i = gt; i < M * 16; i += NT) { const float ang = (float)pos[i >> 4] * A.inv_b[i & 15]; double rev = (double)ang * 0.15915494309189535; rev -= __builtin_rint(rev); const float fr = (float)rev;
            cB[i] = __builtin_amdgcn_cosf(fr); sB[i] = __builtin_amdgcn_sinf(fr); }
    }
    const float* x = (const float*)A.in[0]; bf16* XB = (bf16*)(ws + WS_XB); float* SS = (float*)(ws + WS_SS);
    for (int m = gw; m < M; m += NGW) {
        const GAS f32x4* xr = (const GAS f32x4*)(x + (size_t)m * DM) + lane; f32x4 v[4]; float s = 0.f;
#pragma unroll
        for (int j = 0; j < 4; ++j) { v[j] = xr[64 * j]; s += (v[j].x * v[j].x + v[j].y * v[j].y) + (v[j].z * v[j].z + v[j].w * v[j].w); }
        s = wave_sum(s);
        GAS unsigned long long* o8 = (GAS unsigned long long*)(XB + (size_t)m * DM) + lane;
#pragma unroll
        for (int j = 0; j < 4; ++j) o8[64 * j] = (unsigned long long)((unsigned)f2h(v[j].x) | ((unsigned)f2h(v[j].y) << 16)) | ((unsigned long long)((unsigned)f2h(v[j].z) | ((unsigned)f2h(v[j].w) << 16)) << 32);
        if (lane < 16) SS[(size_t)m * 16 + lane] = (lane == 0) ? s : 0.f;
    }
}
__device__ __forceinline__ void p12_final_norm(Frame& F, const Args& A) {
    const int gw = blockIdx.x * NWAVES + F.wave, NGW = F.G * NWAVES, lane = F.lane;
    const float* g = (const float*)A.in[14]; const float* SS = (const float*)(A.ws + WS_SS);
    f32x4 gv[4];
#pragma unroll
    for (int j = 0; j < 4; ++j) gv[j] = ((const GAS f32x4*)g)[lane + 64 * j];
    for (int m = gw; m < M; m += NGW) {
        const float rs = pg8::rstd_from(SS + (size_t)m * 16, 4, 1.0f / 1024.0f);
        GAS f32x4* xr = (GAS f32x4*)(A.out + (size_t)m * DM) + lane;
#pragma unroll
        for (int j = 0; j < 4; ++j) { f32x4 v = xr[64 * j]; xr[64 * j] = v * rs * gv[j]; }
    }
}
__device__ __forceinline__ int block_sum_i(int v, volatile LAS unsigned* red, int wid, int lane) {
#pragma unroll
    for (int o = 32; o >= 1; o >>= 1) v += __shfl_xor(v, o);
    __syncthreads();
    if (lane == 0) red[wid] = (unsigned)v;
    __syncthreads();
    int t = 0;
#pragma unroll
    for (int w = 0; w < NWAVES; ++w) t += (int)red[w];
    return t;
}
__device__ __forceinline__ void dsa_naive_phase(Frame& F, const Args& A) {
    const bf16* PA = (const bf16*)(A.ws + WS_PA); const float* WI = (const float*)(A.ws + WS_WI); bf16* OA = (bf16*)(A.ws + WS_OA);
    LAS float* qi_s = (LAS float*)F.lds;
    LAS float* w_s = qi_s + 512;
    LAS unsigned* key_s = (LAS unsigned*)(w_s + 16);
    LAS int* sel_s = (LAS int*)(key_s + 2048);
    LAS float* q_s = (LAS float*)(sel_s + 256);
    LAS float* p_s = q_s + 1024;
    volatile LAS unsigned* red_s = (volatile LAS unsigned*)(p_s + 4096);
    const int tid = F.tid, lane = F.lane, wid = F.wave;
    for (int q = blockIdx.x; q < M; q += F.G) {
        const int b = q >> 11, t = q & 2047, NK = ((t >> 6) + 1) << 6;
        const bf16* prow = PA + (size_t)q * A_INP;
        __syncthreads();
        qi_s[tid] = h2f(prow[1536 + tid]);
        q_s[tid] = h2f(prow[tid]); q_s[tid + 512] = h2f(prow[tid + 512]);
        if (tid < 8) w_s[tid] = WI[(size_t)q * 8 + tid];
        __syncthreads();
        int nsel;
        if (NK <= 256) { nsel = NK; if (tid < NK) sel_s[tid] = tid; }
        else {
            for (int s = tid; s < NK; s += 512) {
                const v4u* kp = (const v4u*)(PA + ((size_t)(b * SEQ + s)) * A_INP + 2048);
                float kk[64];
#pragma unroll
                for (int c = 0; c < 8; ++c) { const v4u w = kp[c];
                    kk[8 * c + 0] = h2f((unsigned short)(w.x & 0xffff)); kk[8 * c + 1] = h2f((unsigned short)(w.x >> 16)); kk[8 * c + 2] = h2f((unsigned short)(w.y & 0xffff)); kk[8 * c + 3] = h2f((unsigned short)(w.y >> 16));
                    kk[8 * c + 4] = h2f((unsigned short)(w.z & 0xffff)); kk[8 * c + 5] = h2f((unsigned short)(w.z >> 16)); kk[8 * c + 6] = h2f((unsigned short)(w.w & 0xffff)); kk[8 * c + 7] = h2f((unsigned short)(w.w >> 16)); }
                float acc = 0.f;
#pragma unroll 1
                for (int h = 0; h < 8; ++h) { float dot = 0.f;
#pragma unroll
                    for (int d = 0; d < 64; ++d) dot = fmaf(qi_s[h * 64 + d], kk[d], dot);
                    acc = fmaf(w_s[h], fmaxf(dot, 0.f), acc); }
                const unsigned u = __builtin_bit_cast(unsigned, acc);
                key_s[s] = (u & 0x80000000u) ? ~u : (u | 0x80000000u);
            }
            __syncthreads();
            unsigned prefix = 0u;
            for (int bit = 31; bit >= 0; --bit) {
                const unsigned cand = prefix | (1u << bit); int c = 0;
                for (int s = tid; s < NK; s += 512) c += (key_s[s] >= cand) ? 1 : 0;
                c = block_sum_i(c, red_s, wid, lane);
                if (c >= 256) prefix = cand;
            }
            const unsigned T = prefix;
            int cg = 0, ce = 0;
            for (int s = tid; s < NK; s += 512) { const unsigned k = key_s[s]; cg += (k > T) ? 1 : 0; ce += (k == T) ? 1 : 0; }
            cg = block_sum_i(cg, red_s, wid, lane); ce = block_sum_i(ce, red_s, wid, lane);
            const int need_eq = 256 - cg;
            int tie_cut = NK;
            if (ce > need_eq) {
                __syncthreads();
                if (tid == 0) { int cnt = 0, cut = NK; for (int s = 0; s < NK; ++s) if (key_s[s] == T) { if (++cnt == need_eq) { cut = s + 1; break; } } red_s[8] = (unsigned)cut; }
                __syncthreads();
                tie_cut = (int)red_s[8];
            }
            int running = 0;
            for (int base = 0; base < NK; base += 512) {
                const int s = base + tid; bool flag = false;
                if (s < NK) { const unsigned k = key_s[s]; flag = (k > T) || (k == T && s < tie_cut); }
                const unsigned long long mask = __ballot(flag);
                const int rank = __popcll(mask & ((1ull << lane) - 1ull));
                __syncthreads();
                if (lane == 0) red_s[wid] = (unsigned)__popcll(mask);
                __syncthreads();
                int off = running, tot = 0;
#pragma unroll
                for (int w = 0; w < NWAVES; ++w) { const int cw = (int)red_s[w]; if (w < wid) off += cw; tot += cw; }
                if (flag) sel_s[off + rank] = s;
                running += tot;
            }
            nsel = running;
        }
        __syncthreads();
        const int hh = tid >> 5, l32 = tid & 31, g = hh >> 2;
        float lmax = -INFINITY;
        for (int j = l32; j < nsel; j += 32) {
            const int s = sel_s[j]; const v4u* kp = (const v4u*)(PA + ((size_t)(b * SEQ + s)) * A_INP + 1024 + g * 64);
            float dot = 0.f;
#pragma unroll
            for (int c = 0; c < 8; ++c) { const v4u w = kp[c]; const LAS float* qq = q_s + hh * 64 + 8 * c;
                dot = fmaf(qq[0], h2f((unsigned short)(w.x & 0xffff)), dot); dot = fmaf(qq[1], h2f((unsigned short)(w.x >> 16)), dot); dot = fmaf(qq[2], h2f((unsigned short)(w.y & 0xffff)), dot); dot = fmaf(qq[3], h2f((unsigned short)(w.y >> 16)), dot);
                dot = fmaf(qq[4], h2f((unsigned short)(w.z & 0xffff)), dot); dot = fmaf(qq[5], h2f((unsigned short)(w.z >> 16)), dot); dot = fmaf(qq[6], h2f((unsigned short)(w.w & 0xffff)), dot); dot = fmaf(qq[7], h2f((unsigned short)(w.w >> 16)), dot); }
            const float lg = dot * 0.125f; p_s[hh * 256 + j] = lg; lmax = fmaxf(lmax, lg);
        }
#pragma unroll
        for (int o = 16; o >= 1; o >>= 1) lmax = fmaxf(lmax, __shfl_xor(lmax, o));
        float lsum = 0.f;
        for (int j = l32; j < nsel; j += 32) { const float e = __expf(p_s[hh * 256 + j] - lmax); p_s[hh * 256 + j] = e; lsum += e; }
#pragma unroll
        for (int o = 16; o >= 1; o >>= 1) lsum += __shfl_xor(lsum, o);
        __syncthreads();
        const float inv = 1.0f / lsum;
        float a0 = 0.f, a1 = 0.f;
        for (int j = 0; j < nsel; ++j) { const float p = p_s[hh * 256 + j]; const bf16* vp = PA + ((size_t)(b * SEQ + sel_s[j])) * A_INP + 1280 + g * 64 + l32;
            a0 = fmaf(p, h2f(vp[0]), a0); a1 = fmaf(p, h2f(vp[32]), a1); }
        OA[(size_t)q * DM + hh * 64 + l32] = (bf16)f2bf(a0 * inv); OA[(size_t)q * DM + hh * 64 + l32 + 32] = (bf16)f2bf(a1 * inv);
    }
}

namespace mla {
typedef float f32x16 __attribute__((ext_vector_type(16)));
typedef short s16x4 __attribute__((ext_vector_type(4)));
constexpr int KP = 208;
constexpr int LDS_K = 0, LDS_V = 64 * KP, LDS_END = LDS_V + 8192;
__device__ __forceinline__ float xmax32(float m) { auto rr = __builtin_amdgcn_permlane32_swap(__float_as_uint(m), __float_as_uint(m), false, false); return fmaxf(__uint_as_float(rr[0]), __uint_as_float(rr[1])); }
__device__ __forceinline__ void attn_unit(LAS unsigned char* lds, const bf16* QB, const bf16* KVB, const bf16* CB, bf16* OB, int b, int h, int qb) {
    const int tid = threadIdx.x, lane = tid & 63, r32 = lane & 31, hi = lane >> 5; const int wid = __builtin_amdgcn_readfirstlane(tid >> 6);
    const int c0 = qb * 4, cw = c0 + (wid >> 1), ntile = c0 + 4;
    const size_t row0 = (size_t)b * SEQ;
    const bf16* qp = QB + (row0 + (size_t)qb * 256 + wid * 32 + r32) * QUP + h * 96 + hi * 8;
    bf16x8 qf[6];
#pragma unroll
    for (int ks = 0; ks < 6; ++ks) qf[ks] = *(const bf16x8*)(qp + ks * 16);
    f32x16 o0 = {}, o1 = {}; float mrun = -INFINITY, lrun = 0.f;
    const unsigned vb = (unsigned)(uintptr_t)(lds + LDS_V) + ((lane >> 4) & 1) * 32 + (lane & 3) * 8 + (4 * hi + ((lane & 15) >> 2)) * 64;
    for (int kt = 0; kt < ntile; ++kt) {
        __syncthreads();
        for (int c = tid; c < 768; c += 512) { const int key = c / 12, ci = c % 12; const size_t krow = row0 + (size_t)kt * 64 + key;
            const bf16* src = (ci < 8) ? (KVB + krow * KVUP + h * 128 + ci * 8) : (CB + krow * B_INP + 640 + (ci - 8) * 8);
            *(LAS v4u*)(lds + LDS_K + key * KP + ci * 16) = *(const v4u*)src; }
        { const int key = tid >> 3, c8 = tid & 7; const bf16* src = KVB + (row0 + (size_t)kt * 64 + key) * KVUP + h * 128 + 64 + c8 * 8;
          *(LAS v4u*)(lds + LDS_V + (c8 >> 2) * 4096 + (key >> 3) * 512 + (key & 7) * 64 + (c8 & 3) * 16) = *(const v4u*)src; }
        __syncthreads();
        if (kt <= cw) {
            f32x16 p0 = {}, p1 = {};
#pragma unroll
            for (int ks = 0; ks < 6; ++ks) {
                const bf16x8 k0 = *(const LAS bf16x8*)(lds + LDS_K + r32 * KP + ks * 32 + hi * 16);
                const bf16x8 k1 = *(const LAS bf16x8*)(lds + LDS_K + (32 + r32) * KP + ks * 32 + hi * 16);
                p0 = __builtin_amdgcn_mfma_f32_32x32x16_bf16(k0, qf[ks], p0, 0, 0, 0);
                p1 = __builtin_amdgcn_mfma_f32_32x32x16_bf16(k1, qf[ks], p1, 0, 0, 0);
            }
            float mx = fmaxf(p0[0], p1[0]);
#pragma unroll
            for (int r = 1; r < 16; ++r) mx = fmaxf(mx, fmaxf(p0[r], p1[r]));
            mx = xmax32(mx);
            const float mn = fmaxf(mrun, mx), alpha = __builtin_amdgcn_exp2f(mrun - mn); mrun = mn;
            float ls = 0.f;
#pragma unroll
            for (int r = 0; r < 16; ++r) { p0[r] = __builtin_amdgcn_exp2f(p0[r] - mn); p1[r] = __builtin_amdgcn_exp2f(p1[r] - mn); ls += p0[r] + p1[r]; }
            lrun = lrun * alpha + ls;
#pragma unroll
            for (int r = 0; r < 16; ++r) { o0[r] *= alpha; o1[r] *= alpha; }
            bf16x8 pa[4];
#pragma unroll
            for (int s = 0; s < 2; ++s) {
                u32x4 w0, w1;
                w0.x = pg8::cvt_pk_bf16(p0[8 * s + 0], p0[8 * s + 1]); w0.y = pg8::cvt_pk_bf16(p0[8 * s + 2], p0[8 * s + 3]); w0.z = pg8::cvt_pk_bf16(p0[8 * s + 4], p0[8 * s + 5]); w0.w = pg8::cvt_pk_bf16(p0[8 * s + 6], p0[8 * s + 7]);
                w1.x = pg8::cvt_pk_bf16(p1[8 * s + 0], p1[8 * s + 1]); w1.y = pg8::cvt_pk_bf16(p1[8 * s + 2], p1[8 * s + 3]); w1.z = pg8::cvt_pk_bf16(p1[8 * s + 4], p1[8 * s + 5]); w1.w = pg8::cvt_pk_bf16(p1[8 * s + 6], p1[8 * s + 7]);
                pa[s] = __builtin_bit_cast(bf16x8, w0); pa[2 + s] = __builtin_bit_cast(bf16x8, w1);
            }
#pragma unroll
            for (int d0 = 0; d0 < 2; ++d0) {
                s16x4 lo[4], hi4[4];
#pragma unroll
                for (int ks = 0; ks < 4; ++ks) {
                    asm volatile("ds_read_b64_tr_b16 %0,%1 offset:%c2" : "=&v"(lo[ks]) : "v"(vb), "i"(d0 * 4096 + ks * 1024) : "memory");
                    asm volatile("ds_read_b64_tr_b16 %0,%1 offset:%c2" : "=&v"(hi4[ks]) : "v"(vb), "i"(d0 * 4096 + ks * 1024 + 512) : "memory"); }
                asm volatile("s_waitcnt lgkmcnt(0)" ::: "memory"); __builtin_amdgcn_sched_barrier(0);
#define MLA_PK(k) (bf16x8){lo[k][0], lo[k][1], lo[k][2], lo[k][3], hi4[k][0], hi4[k][1], hi4[k][2], hi4[k][3]}
                if (d0 == 0) { o0 = __builtin_amdgcn_mfma_f32_32x32x16_bf16(MLA_PK(0), pa[0], o0, 0, 0, 0); o0 = __builtin_amdgcn_mfma_f32_32x32x16_bf16(MLA_PK(1), pa[1], o0, 0, 0, 0);
                               o0 = __builtin_amdgcn_mfma_f32_32x32x16_bf16(MLA_PK(2), pa[2], o0, 0, 0, 0); o0 = __builtin_amdgcn_mfma_f32_32x32x16_bf16(MLA_PK(3), pa[3], o0, 0, 0, 0); }
                else         { o1 = __builtin_amdgcn_mfma_f32_32x32x16_bf16(MLA_PK(0), pa[0], o1, 0, 0, 0); o1 = __builtin_amdgcn_mfma_f32_32x32x16_bf16(MLA_PK(1), pa[1], o1, 0, 0, 0);
                               o1 = __builtin_amdgcn_mfma_f32_32x32x16_bf16(MLA_PK(2), pa[2], o1, 0, 0, 0); o1 = __builtin_amdgcn_mfma_f32_32x32x16_bf16(MLA_PK(3), pa[3], o1, 0, 0, 0); }
#undef MLA_PK
            }
        }
    }
    lrun += __shfl_xor(lrun, 32);
    const float inv = 1.0f / lrun;
    bf16* op = OB + (row0 + (size_t)qb * 256 + wid * 32 + r32) * DM + h * 64 + 4 * hi;
#pragma unroll
    for (int g = 0; g < 4; ++g) {
        u32x2 w; w.x = pg8::cvt_pk_bf16(o0[4 * g] * inv, o0[4 * g + 1] * inv); w.y = pg8::cvt_pk_bf16(o0[4 * g + 2] * inv, o0[4 * g + 3] * inv); *(u32x2*)(op + 8 * g) = w;
        u32x2 z; z.x = pg8::cvt_pk_bf16(o1[4 * g] * inv, o1[4 * g + 1] * inv); z.y = pg8::cvt_pk_bf16(o1[4 * g + 2] * inv, o1[4 * g + 3] * inv); *(u32x2*)(op + 32 + 8 * g) = z;
    }
}
__device__ __forceinline__ void attn_phase(Frame& F, const Args& A) {
    const bf16* QB = (const bf16*)(A.ws + WS_QB); const bf16* KVB = (const bf16*)(A.ws + WS_KVB); const bf16* CB = (const bf16*)(A.ws + WS_CB); bf16* OB = (bf16*)(A.ws + WS_OB);
    for (int u = blockIdx.x; u < BATCH * 16 * 8; u += F.G) { const int bh = u & 255, qb = u >> 8; attn_unit(F.lds, QB, KVB, CB, OB, bh >> 4, bh & 15, qb); }
}
}
__global__ void __launch_bounds__(NWAVES * 64, 2) mk_fwd(Args args) {
    extern __shared__ __attribute__((aligned(16))) unsigned char lds_raw[];
    Frame F;
    F.lds = (LAS unsigned char*)lds_raw;
    F.MISC = (volatile LAS unsigned*)(F.lds + MISC_OFF);
    F.tid = threadIdx.x; F.lane = F.tid & 63; F.wave = __builtin_amdgcn_readfirstlane(F.tid >> 6);
    F.G = gridDim.x;
    unsigned char* ws = args.ws;
    F.ctl = (gu32*)(ws + WS_CTL);
    for (int u = F.tid; u < (LDS_BYTES - LDSCTL_OFF) / 4; u += NWAVES * 64) ((LAS unsigned*)(F.lds + LDSCTL_OFF))[u] = 0u;
    __syncthreads();
    XcdBarrier bar; bar.bar = (unsigned*)(F.ctl + CW_BAR); bar.x = 0; bar.st = nullptr;
    if (N_LAUNCHES == 1) bar = xcd_barrier_post((unsigned*)(F.ctl + CW_BAR), F.MISC + 8);
#define GRID_BAR() do { if (N_LAUNCHES == 1) xcd_barrier(bar); } while (0)
    const int lo = args.ph_lo, hi = args.ph_hi;
#ifndef PHMASK
#define PHMASK 0x1fff
#endif
#define IN(k) (((PHMASK >> (k)) & 1) && lo <= (k) && (k) < hi)
    bf16* const XB = (bf16*)(ws + WS_XB); float* const SS = (float*)(ws + WS_SS); float* const SSB = (float*)(ws + WS_SSB);
    const float* const cosA = (const float*)(ws + WS_COSA); const float* const sinA = (const float*)(ws + WS_SINA);
    const float* const cosB = (const float*)(ws + WS_COSB); const float* const sinB = (const float*)(ws + WS_SINB);
    const int bid = (int)blockIdx.x;

    if (IN(0)) { p0_prologue(F, args); GRID_BAR(); }
    if (IN(1)) {
        pg8::Gemm g{XB, (const bf16*)(ws + WS_WAIN), M, A_INP, DM, DM, DM}; pg8::StaticOrder S; S.init(M, A_INP, F.G, bid);
        pg8::EpiDsaIn E{(bf16*)(ws + WS_PA), (float*)(ws + WS_WI), SS, cosA, sinA, IDX_WSCALE};
        pg8::gemm_phase<pg8::EpiDsaIn, pg8::StaticOrder, true, true, true>(F.lds, g, S, E);
        GRID_BAR();
    }
    if (IN(2)) { dsa_naive_phase(F, args); GRID_BAR(); }
    if (IN(3)) {
        pg8::Gemm g{(const bf16*)(ws + WS_OA), (const bf16*)(ws + WS_WAOUT), M, DM, DM, DM, DM}; pg8::StaticOrder S; S.init(M, DM, F.G, bid);
        pg8::EpiResid E{(const float*)args.in[0], args.out, XB, SS};
        pg8::gemm_phase<pg8::EpiResid, pg8::StaticOrder, true, true, false>(F.lds, g, S, E);
        GRID_BAR();
    }
    if (IN(4)) {
        pg8::Gemm g{XB, (const bf16*)(ws + WS_WUP0), M, FF, DM, DM, DM}; pg8::StaticOrder S; S.init(M, FF, F.G, bid);
        pg8::EpiMlpUp E{(bf16*)(ws + WS_H), SS};
        pg8::gemm_phase<pg8::EpiMlpUp, pg8::StaticOrder, true, true, false>(F.lds, g, S, E);
        GRID_BAR();
    }
    if (IN(5)) {
        pg8::Gemm g{(const bf16*)(ws + WS_H), (const bf16*)(ws + WS_WDN0), M, DM, FF, FF, FF}; pg8::StaticOrder S; S.init(M, DM, F.G, bid);
        pg8::EpiResid E{args.out, args.out, XB, SS};
        pg8::gemm_phase<pg8::EpiResid, pg8::StaticOrder, true, true, false>(F.lds, g, S, E);
        GRID_BAR();
    }
    if (IN(6)) {
        pg8::Gemm g{XB, (const bf16*)(ws + WS_WBIN), M, B_INP, DM, DM, DM}; pg8::StaticOrder S; S.init(M, B_INP, F.G, bid);
        pg8::EpiMlaIn E{(bf16*)(ws + WS_CB), SSB, SS, cosB, sinB};
        pg8::gemm_phase<pg8::EpiMlaIn, pg8::StaticOrder, true, true, false>(F.lds, g, S, E);
        GRID_BAR();
    }
    if (IN(7)) {
#ifndef NO_QUP
        { pg8::Gemm g{(const bf16*)(ws + WS_CB), (const bf16*)(ws + WS_WQUP), M, QUP, QLORA, B_INP, QLORA}; pg8::StaticOrder S; S.init(M, QUP, F.G, bid);
          pg8::EpiQUp E{(bf16*)(ws + WS_QB), SSB, cosB, sinB, QSCALE_B};
          pg8::gemm_phase<pg8::EpiQUp, pg8::StaticOrder, true, true, false>(F.lds, g, S, E); }
#endif
#ifndef NO_KVUP
        { pg8::Gemm g{(const bf16*)(ws + WS_CB) + QLORA, (const bf16*)(ws + WS_WKVUP), M, KVUP, KVLORA, B_INP, KVLORA}; pg8::StaticOrder S; S.init(M, KVUP, F.G, bid);
          pg8::EpiKvUp E{(bf16*)(ws + WS_KVB), SSB};
          pg8::gemm_phase<pg8::EpiKvUp, pg8::StaticOrder, true, true, false>(F.lds, g, S, E); }
#endif
        GRID_BAR();
    }
    if (IN(8)) { mla::attn_phase(F, args); GRID_BAR(); }
    if (IN(9)) {
        pg8::Gemm g{(const bf16*)(ws + WS_OB), (const bf16*)(ws + WS_WBOUT), M, DM, DM, DM, DM}; pg8::StaticOrder S; S.init(M, DM, F.G, bid);
        pg8::EpiResid E{args.out, args.out, XB, SS};
        pg8::gemm_phase<pg8::EpiResid, pg8::StaticOrder, true, true, false>(F.lds, g, S, E);
        GRID_BAR();
    }
    if (IN(10)) {
        pg8::Gemm g{XB, (const bf16*)(ws + WS_WUP1), M, FF, DM, DM, DM}; pg8::StaticOrder S; S.init(M, FF, F.G, bid);
        pg8::EpiMlpUp E{(bf16*)(ws + WS_H), SS};
        pg8::gemm_phase<pg8::EpiMlpUp, pg8::StaticOrder, true, true, false>(F.lds, g, S, E);
        GRID_BAR();
    }
    if (IN(11)) {
        pg8::Gemm g{(const bf16*)(ws + WS_H), (const bf16*)(ws + WS_WDN1), M, DM, FF, FF, FF}; pg8::StaticOrder S; S.init(M, DM, F.G, bid);
        pg8::EpiResid E{args.out, args.out, nullptr, SS};
        pg8::gemm_phase<pg8::EpiResid, pg8::StaticOrder, true, true, false>(F.lds, g, S, E);
        GRID_BAR();
    }
    if (IN(12)) { p12_final_norm(F, args); }
#undef IN
#undef GRID_BAR
}

extern "C" void kernel_launch(void* const* d_in, const int* in_sizes, int n_in, void* d_out, int out_size, void* d_ws, size_t ws_size, hipStream_t stream) {
    static int grid = 0;
    if (grid == 0) {
        if (n_in != 15 || in_sizes[0] != M * DM || out_size != M * DM || ws_size < WS_END) { fprintf(stderr, "kernel_launch: unexpected shapes / workspace (n_in %d, in0 %d, out %d, ws %zu); nothing launched\n", n_in, n_in > 0 ? in_sizes[0] : -1, out_size, ws_size); grid = -1; return; }
        int dev = 0, cus = 0, per_cu = 0;
        if (hipGetDevice(&dev) != hipSuccess || hipDeviceGetAttribute(&cus, hipDeviceAttributeMultiprocessorCount, dev) != hipSuccess) { grid = -1; return; }
        if (hipFuncSetAttribute((const void*)mk_fwd, hipFuncAttributeMaxDynamicSharedMemorySize, LDS_BYTES) != hipSuccess) { fprintf(stderr, "kernel_launch: hipFuncSetAttribute failed\n"); grid = -1; return; }
        if (hipOccupancyMaxActiveBlocksPerMultiprocessor(&per_cu, (const void*)mk_fwd, NWAVES * 64, LDS_BYTES) != hipSuccess || per_cu < 1) { fprintf(stderr, "kernel_launch: occupancy query reports %d blocks per CU\n", per_cu); }
        (void)hipGetLastError();
        grid = cus;
    }
    if (grid < 0) return;
    if (hipMemsetAsync((char*)d_ws + WS_CTL, 0, CTL_ZERO_BYTES, stream) != hipSuccess) return;
    Args a{};
    for (int i = 0; i < 15; ++i) a.in[i] = d_in[i];
    a.out = (float*)d_out; a.ws = (unsigned char*)d_ws;
    for (int i = 0; i < 8; ++i) a.inv_a[i] = (float)pow(500000.0, -(double)i / 8.0);
    for (int i = 0; i < 16; ++i) a.inv_b[i] = (float)pow(500000.0, -(double)i / 16.0);
    if (N_LAUNCHES == 1) { a.ph_lo = 0; a.ph_hi = N_PHASES; hipLaunchKernelGGL(mk_fwd, dim3(grid), dim3(NWAVES * 64), LDS_BYTES, stream, a); }
    else for (int li = 0; li < N_PHASES; ++li) { a.ph_lo = li; a.ph_hi = li + 1; hipLaunchKernelGGL(mk_fwd, dim3(grid), dim3(NWAVES * 64), LDS_BYTES, stream, a); }
    const hipError_t le = hipPeekAtLastError();
    if (le != hipSuccess) fprintf(stderr, "kernel_launch: launch failed: %s\n", hipGetErrorName(le));
}
```

```cpp
#include <hip/hip_runtime.h>
#include <cstdio>
#include <cstdint>
#include <cmath>
namespace pg8 {
#define PG8_LAS __attribute__((address_space(3)))
typedef unsigned short bf16_t;
typedef short bf16x8 __attribute__((ext_vector_type(8)));
typedef float f32x4 __attribute__((ext_vector_type(4)));
typedef unsigned u32x4 __attribute__((ext_vector_type(4)));
constexpr int BM = 256, BK = 64, HALF = 128, HTB = HALF * BK * 2  , STAGE_BYTES = 8 * HTB, NXCD = 8, WGM = 8;

__host__ __device__ __forceinline__ int lds_byte(int r, int c) { const int st = (r >> 4) * 2 + (c >> 5), rr = r & 15, cc = c & 31, ob = rr * 64 + cc * 2; return st * 1024 + (ob ^ (((ob >> 9) & 1) << 5)); }
__host__ __device__ __forceinline__ void stage_rc(int b, int& R, int& C) { const int st = b / 1024, sb = b % 1024, swz = sb ^ (((sb >> 9) & 1) << 5); R = (st >> 1) * 16 + swz / 64; C = (st & 1) * 32 + (swz % 64) / 2; }
__host__ __device__ __forceinline__ int perm32(int rho) { const int n = rho >> 4, i = rho & 15; return 8 * (i >> 2) + 4 * n + (i & 3); }

struct Unit { int pm, pn; };
struct Gemm { const bf16_t* A; const bf16_t* Bt; int M, N, K, lda, ldb; };

struct StaticOrder {
    int nM, nN, nwg, G, c;
    __host__ __device__ void init(int M, int N, int G_, int c_) { nM = M / BM; nN = N / BM; nwg = nM * nN; G = G_; c = c_; }
    __host__ __device__ bool next(int i, Unit& u) const {
        const long L = (long)i * G + c; if (L >= nwg) return false;
        int wgid = (int)L; { const int q = nwg / NXCD, r = nwg % NXCD, xcd = wgid % NXCD, off = wgid / NXCD; wgid = (xcd < r ? xcd * (q + 1) : r * (q + 1) + (xcd - r) * q) + off; }
        const int nig = WGM * nN, gid = wgid / nig, fm = gid * WGM, gsz = (nM - fm) < WGM ? (nM - fm) : WGM;
        u.pm = fm + ((wgid % nig) % gsz); u.pn = (wgid % nig) / gsz; return true;
    }
    __device__ __forceinline__ void a_ready(const Unit&) const {}
    __device__ __forceinline__ void done(const Unit&) const {}
};

__device__ __forceinline__ unsigned cvt_pk_bf16(float lo, float hi) { unsigned r; asm volatile("v_cvt_pk_bf16_f32 %0, %1, %2" : "=v"(r) : "v"(lo), "v"(hi)); return r; }
typedef _Float16 f16x8_t __attribute__((ext_vector_type(8)));
typedef _Float16 f16x2_t __attribute__((ext_vector_type(2)));
template <bool F16> __device__ __forceinline__ f32x4 mma16(bf16x8 a, bf16x8 b, f32x4 c) {
    if constexpr (F16) return __builtin_amdgcn_mfma_f32_16x16x32_f16(__builtin_bit_cast(f16x8_t, a), __builtin_bit_cast(f16x8_t, b), c, 0, 0, 0);
    else return __builtin_amdgcn_mfma_f32_16x16x32_bf16(a, b, c, 0, 0, 0);
}
__device__ __forceinline__ unsigned cvt_pk_f16(float lo, float hi) { f16x2_t t = {(_Float16)lo, (_Float16)hi}; return __builtin_bit_cast(unsigned, t); }
__device__ __forceinline__ u32x4 pack8_bf16(f32x4 a, f32x4 b) { u32x4 w; w.x = cvt_pk_bf16(a[0], a[1]); w.y = cvt_pk_bf16(a[2], a[3]); w.z = cvt_pk_bf16(b[0], b[1]); w.w = cvt_pk_bf16(b[2], b[3]); return w; }
__device__ __forceinline__ u32x4 pack8_f16(f32x4 a, f32x4 b) { u32x4 w; w.x = cvt_pk_f16(a[0], a[1]); w.y = cvt_pk_f16(a[2], a[3]); w.z = cvt_pk_f16(b[0], b[1]); w.w = cvt_pk_f16(b[2], b[3]); return w; }
typedef unsigned u32x2 __attribute__((ext_vector_type(2)));
__device__ __forceinline__ u32x2 pack4_bf16(f32x4 a) { u32x2 w; w.x = cvt_pk_bf16(a[0], a[1]); w.y = cvt_pk_bf16(a[2], a[3]); return w; }
__device__ __forceinline__ f32x4 shfl4(f32x4 v, int x) { f32x4 r; r[0] = __shfl_xor(v[0], x); r[1] = __shfl_xor(v[1], x); r[2] = __shfl_xor(v[2], x); r[3] = __shfl_xor(v[3], x); return r; }
__device__ __forceinline__ float sum4(f32x4 v) { return (v[0] + v[1]) + (v[2] + v[3]); }
__device__ __forceinline__ float dot4(f32x4 v) { return (v[0] * v[0] + v[1] * v[1]) + (v[2] * v[2] + v[3] * v[3]); }
constexpr float RMS_EPS = 1e-6f;
__device__ __forceinline__ float rstd_from(const float* p, int n4, float inv_cnt) {
    float s = 0.f;
#pragma unroll 4
    for (int i = 0; i < n4; ++i) s += sum4(((const f32x4*)p)[i]);
    return __builtin_amdgcn_rsqf(s * inv_cnt + RMS_EPS);
}

struct EpiDsaIn {
    static constexpr bool PERM = true, AFTER_DRAIN = false;
    bf16_t* PA; float* WI; const float* SS; const float* cosA; const float* sinA; float wscale;
    __device__ __forceinline__ void operator()(const f32x4 (&acc)[2][2][4][2], const Unit& u, int wr, int wc, int fr, int fq) const {
#pragma unroll
        for (int ai = 0; ai < 2; ++ai)
#pragma unroll
            for (int m = 0; m < 4; ++m) {
                const int row = u.pm * BM + ai * HALF + wr * 64 + m * 16 + fr;
                asm volatile("" ::: "memory");
                const float rs = rstd_from(SS + (size_t)row * 16, 4, 1.0f / 1024.0f);
                const f32x4 c0 = *(const f32x4*)(cosA + (size_t)row * 8), c1 = *(const f32x4*)(cosA + (size_t)row * 8 + 4);
                const f32x4 s0 = *(const f32x4*)(sinA + (size_t)row * 8), s1 = *(const f32x4*)(sinA + (size_t)row * 8 + 4);
#pragma unroll
                for (int bj = 0; bj < 2; ++bj) {
                    const int cb = u.pn * BM + bj * HALF + wc * 32;
                    const int col8 = cb + 8 * fq;
                    f32x4 v0 = acc[ai][bj][m][0] * rs, v1 = acc[ai][bj][m][1] * rs;
                    const bool ropeg = ((cb & 63) == 0) && (cb < 1280 || (cb >= 1536 && cb < 2112));
                    if (ropeg) {
                        const f32x4 p0 = shfl4(v0, 16), p1 = shfl4(v1, 16);
                        if (fq == 0) { v0 = v0 * c0 - p0 * s0; v1 = v1 * c1 - p1 * s1; }
                        else if (fq == 1) { v0 = v0 * c0 + p0 * s0; v1 = v1 * c1 + p1 * s1; }
                    }
                    if (cb < 2112) *(u32x4*)(PA + (size_t)row * 2304 + col8) = pack8_f16(v0, v1);
                    else if (cb == 2112 && fq == 0) { *(f32x4*)(WI + (size_t)row * 8) = v0 * wscale; *(f32x4*)(WI + (size_t)row * 8 + 4) = v1 * wscale; }
                }
            }
    }
};
struct EpiResid {
    static constexpr bool PERM = true, AFTER_DRAIN = false;
    const float* base; float* out; bf16_t* XB; float* SS;
    __device__ __forceinline__ void operator()(const f32x4 (&acc)[2][2][4][2], const Unit& u, int wr, int wc, int fr, int fq) const {
#pragma unroll
        for (int ai = 0; ai < 2; ++ai)
#pragma unroll
            for (int m = 0; m < 4; ++m) {
                const int row = u.pm * BM + ai * HALF + wr * 64 + m * 16 + fr;
                float ssq = 0.f;
#pragma unroll
                for (int bj = 0; bj < 2; ++bj) {
                    const int col8 = u.pn * BM + bj * HALF + wc * 32 + 8 * fq;
                    const float* bp = base + (size_t)row * 1024 + col8;
                    const f32x4 v0 = acc[ai][bj][m][0] + *(const f32x4*)bp, v1 = acc[ai][bj][m][1] + *(const f32x4*)(bp + 4);
                    float* op = out + (size_t)row * 1024 + col8;
                    *(f32x4*)op = v0; *(f32x4*)(op + 4) = v1;
                    if (XB) *(u32x4*)(XB + (size_t)row * 1024 + col8) = pack8_bf16(v0, v1);
                    ssq += dot4(v0) + dot4(v1);
                }
                ssq += __shfl_xor(ssq, 16); ssq += __shfl_xor(ssq, 32);
                if (fq == 0) SS[(size_t)row * 16 + u.pn * 4 + wc] = ssq;
            }
    }
};
struct EpiMlpUp {
    static constexpr bool PERM = true, AFTER_DRAIN = false;
    bf16_t* H; const float* SS;
    __device__ __forceinline__ void operator()(const f32x4 (&acc)[2][2][4][2], const Unit& u, int wr, int wc, int fr, int fq) const {
#pragma unroll
        for (int ai = 0; ai < 2; ++ai)
#pragma unroll
            for (int m = 0; m < 4; ++m) {
                const int row = u.pm * BM + ai * HALF + wr * 64 + m * 16 + fr;
                const float rs = rstd_from(SS + (size_t)row * 16, 4, 1.0f / 1024.0f);
#pragma unroll
                for (int bj = 0; bj < 2; ++bj) {
                    const int col8 = u.pn * BM + bj * HALF + wc * 32 + 8 * fq;
                    f32x4 v0 = acc[ai][bj][m][0] * rs, v1 = acc[ai][bj][m][1] * rs;
                    const f32x4 z = {0.f, 0.f, 0.f, 0.f};
                    v0 = __builtin_elementwise_max(v0, z); v1 = __builtin_elementwise_max(v1, z);
                    *(u32x4*)(H + (size_t)row * 4096 + col8) = pack8_bf16(v0 * v0, v1 * v1);
                }
            }
    }
};
struct EpiMlaIn {
    static constexpr bool PERM = false, AFTER_DRAIN = false;
    bf16_t* CB; float* SSB; const float* SS; const float* cosB; const float* sinB;
    __device__ __forceinline__ void operator()(const f32x4 (&acc)[2][2][4][2], const Unit& u, int wr, int wc, int fr, int fq) const {
#pragma unroll
        for (int ai = 0; ai < 2; ++ai)
#pragma unroll
            for (int m = 0; m < 4; ++m) {
                const int row = u.pm * BM + ai * HALF + wr * 64 + m * 16 + fr;
                const float rs = rstd_from(SS + (size_t)row * 16, 4, 1.0f / 1024.0f);
#pragma unroll
                for (int bj = 0; bj < 2; ++bj) {
                    const int cb = u.pn * BM + bj * HALF + wc * 32;
                    f32x4 v0 = acc[ai][bj][m][0] * rs, v1 = acc[ai][bj][m][1] * rs;
                    if (cb == 640) {
                        const f32x4 c = *(const f32x4*)(cosB + (size_t)row * 16 + 4 * fq), s = *(const f32x4*)(sinB + (size_t)row * 16 + 4 * fq);
                        const f32x4 o0 = v0 * c - v1 * s, o1 = v1 * c + v0 * s; v0 = o0; v1 = o1;
                    }
                    if (cb < 672) { bf16_t* p = CB + (size_t)row * 768 + cb + 4 * fq; *(u32x2*)p = pack4_bf16(v0); *(u32x2*)(p + 16) = pack4_bf16(v1); }
                    if (cb < 640) {
                        float ssq = dot4(v0) + dot4(v1);
                        ssq += __shfl_xor(ssq, 16); ssq += __shfl_xor(ssq, 32);
                        if (fq == 0) SSB[(size_t)row * 24 + (cb >> 5)] = ssq;
                    }
                }
            }
    }
};
struct EpiQUp {
    static constexpr bool PERM = false, AFTER_DRAIN = false;
    bf16_t* QB; const float* SSB; const float* cosB; const float* sinB; float qscale;
    __device__ __forceinline__ void operator()(const f32x4 (&acc)[2][2][4][2], const Unit& u, int wr, int wc, int fr, int fq) const {
#pragma unroll
        for (int ai = 0; ai < 2; ++ai)
#pragma unroll
            for (int m = 0; m < 4; ++m) {
                const int row = u.pm * BM + ai * HALF + wr * 64 + m * 16 + fr;
                asm volatile("" ::: "memory");
                const float rs = rstd_from(SSB + (size_t)row * 24, 3, 1.0f / 384.0f) * qscale;
                const f32x4 c = *(const f32x4*)(cosB + (size_t)row * 16 + 4 * fq), s = *(const f32x4*)(sinB + (size_t)row * 16 + 4 * fq);
#pragma unroll
                for (int bj = 0; bj < 2; ++bj) {
                    const int cb = u.pn * BM + bj * HALF + wc * 32;
                    f32x4 v0 = acc[ai][bj][m][0] * rs, v1 = acc[ai][bj][m][1] * rs;
                    if (((cb >> 5) % 3) == 2) { const f32x4 o0 = v0 * c - v1 * s, o1 = v1 * c + v0 * s; v0 = o0; v1 = o1; }
                    bf16_t* p = QB + (size_t)row * 1536 + cb + 4 * fq; *(u32x2*)p = pack4_bf16(v0); *(u32x2*)(p + 16) = pack4_bf16(v1);
                }
            }
    }
};
struct EpiKvUp {
    static constexpr bool PERM = true, AFTER_DRAIN = false;
    bf16_t* KVB; const float* SSB;
    __device__ __forceinline__ void operator()(const f32x4 (&acc)[2][2][4][2], const Unit& u, int wr, int wc, int fr, int fq) const {
#pragma unroll
        for (int ai = 0; ai < 2; ++ai)
#pragma unroll
            for (int m = 0; m < 4; ++m) {
                const int row = u.pm * BM + ai * HALF + wr * 64 + m * 16 + fr;
                const float rs = rstd_from(SSB + (size_t)row * 24 + 12, 2, 1.0f / 256.0f);
#pragma unroll
                for (int bj = 0; bj < 2; ++bj) {
                    const int col8 = u.pn * BM + bj * HALF + wc * 32 + 8 * fq;
                    *(u32x4*)(KVB + (size_t)row * 2048 + col8) = pack8_bf16(acc[ai][bj][m][0] * rs, acc[ai][bj][m][1] * rs);
                }
            }
    }
};
template <class Epi, class Sched, bool ALIGN_EPI = false, bool SP2 = false, bool F16 = false>
__device__ __forceinline__ void gemm_phase(PG8_LAS unsigned char* lds, const Gemm g, const Sched& S, const Epi& E) {
    const int tid = threadIdx.x, wid = __builtin_amdgcn_readfirstlane(tid >> 6), lane = tid & 63, wr = wid >> 2, wc = wid & 3, fr = lane & 15, fq = lane >> 4;
    const int K = g.K, nt = K / BK;
    unsigned voffA[2], voffB[2];
#pragma unroll
    for (int i = 0; i < 2; ++i) { int R, C; stage_rc(tid * 16 + i * 8192, R, C); const int Rb = Epi::PERM ? ((R & ~31) + perm32(R & 31)) : R;
        voffA[i] = (unsigned)(R * g.lda + C) * 2u; voffB[i] = (unsigned)(Rb * g.ldb + C) * 2u; }
    const size_t kstep = (size_t)(BK * 2);
    const size_t hstepA = (size_t)HALF * g.lda * 2, hstepB = (size_t)HALF * g.ldb * 2;
    const size_t tstepA = 2 * hstepA, tstepB = 2 * hstepB;
    const unsigned ldsw = (unsigned)wid * 1024u;
    const int aoff = lds_byte(wr * 64 + fr, fq * 8), boff = lds_byte(wc * 32 + fr, fq * 8);
#define PG8_SA(b, h) (((b) * 2 + (h)) * HTB)
#define PG8_SB(b, h) ((4 + (b) * 2 + (h)) * HTB)
#define PG8_STAGE(bufoff, gbase, voff) do { _Pragma("unroll") for (int _i = 0; _i < 2; ++_i) \
        __builtin_amdgcn_global_load_lds((const unsigned*)((const char*)(gbase) + (voff)[_i]), (PG8_LAS unsigned*)(lds + (bufoff) + ldsw + _i * 8192), 16, 0, 0); } while (0)
#define PG8_LDA(dst, b, h) do { _Pragma("unroll") for (int m = 0; m < 4; ++m) _Pragma("unroll") for (int k = 0; k < 2; ++k) dst[m][k] = *(const PG8_LAS bf16x8*)(lds + PG8_SA(b, h) + aoff + m * 2048 + k * 1024); } while (0)
#define PG8_LDB(dst, b, h) do { _Pragma("unroll") for (int n = 0; n < 2; ++n) _Pragma("unroll") for (int k = 0; k < 2; ++k) dst[n][k] = *(const PG8_LAS bf16x8*)(lds + PG8_SB(b, h) + boff + n * 2048 + k * 1024); } while (0)
#define PG8_MMA(ai, bj, At, Bt) do { __builtin_amdgcn_s_setprio(1); _Pragma("unroll") for (int m = 0; m < 4; ++m) _Pragma("unroll") for (int n = 0; n < 2; ++n) _Pragma("unroll") for (int k = 0; k < 2; ++k) \
        acc[ai][bj][m][n] = mma16<F16>(Bt[n][k], At[m][k], acc[ai][bj][m][n]); __builtin_amdgcn_s_setprio(0); } while (0)
#define PG8_WAIT_V(n) asm volatile("s_waitcnt vmcnt(" #n ")" ::: "memory")
#define PG8_WAIT_L(n) asm volatile("s_waitcnt lgkmcnt(" #n ")" ::: "memory")
#define PG8_BAR __builtin_amdgcn_s_barrier()
#define PG8_SCHED __builtin_amdgcn_sched_barrier(0)
    Unit cur, nxt; int ui = 0;
    if (!S.next(0, cur)) return;
    f32x4 acc[2][2][4][2];
#pragma unroll
    for (int a = 0; a < 2; ++a)
#pragma unroll
        for (int b = 0; b < 2; ++b)
#pragma unroll
            for (int m = 0; m < 4; ++m)
#pragma unroll
                for (int n = 0; n < 2; ++n) acc[a][b][m][n] = (f32x4){0.f, 0.f, 0.f, 0.f};
    bf16x8 At[4][2], B0[2][2], B1[2][2];
    const char* cA = (const char*)g.A + (size_t)cur.pm * tstepA; const char* cB = (const char*)g.Bt + (size_t)cur.pn * tstepB;
    S.a_ready(cur);
    if constexpr (SP2) {
        PG8_STAGE(PG8_SB(0, 0), cB, voffB); PG8_STAGE(PG8_SB(0, 1), cB + hstepB, voffB); PG8_STAGE(PG8_SA(0, 0), cA, voffA); PG8_STAGE(PG8_SA(0, 1), cA + hstepA, voffA);
        if (wr == 1) PG8_BAR;
        PG8_WAIT_V(2); PG8_BAR;
        PG8_STAGE(PG8_SB(1, 0), cB + kstep, voffB); PG8_STAGE(PG8_SA(1, 0), cA + kstep, voffA); PG8_STAGE(PG8_SB(1, 1), cB + hstepB + kstep, voffB);
        PG8_WAIT_V(6); PG8_BAR;
    } else {
        PG8_STAGE(PG8_SB(0, 0), cB, voffB); PG8_STAGE(PG8_SA(0, 0), cA, voffA); PG8_STAGE(PG8_SB(0, 1), cB + hstepB, voffB); PG8_STAGE(PG8_SA(0, 1), cA + hstepA, voffA);
        if (wr == 1) PG8_BAR;
        PG8_WAIT_V(4); PG8_BAR;
        PG8_STAGE(PG8_SB(1, 0), cB + kstep, voffB); PG8_STAGE(PG8_SA(1, 0), cA + kstep, voffA); PG8_STAGE(PG8_SB(1, 1), cB + hstepB + kstep, voffB);
        PG8_WAIT_V(6); PG8_BAR;
    }
    for (;;) {
        const bool has_next = S.next(ui + 1, nxt);
        const char* nA = has_next ? (const char*)g.A + (size_t)nxt.pm * tstepA : cA; const char* nB = has_next ? (const char*)g.Bt + (size_t)nxt.pn * tstepB : cB;
#pragma nounroll
        for (int t = 0; t < nt; t += 2) {
            const bool last = (t == nt - 2);
            const char* a1 = cA + (size_t)(t + 1) * kstep;
            const char* a2 = last ? nA : cA + (size_t)(t + 2) * kstep; const char* b2 = last ? nB : cB + (size_t)(t + 2) * kstep;
            const char* a3 = a2 + kstep; const char* b3 = b2 + kstep;
            if (last && has_next) S.a_ready(nxt);
            if constexpr (SP2) {
            PG8_LDB(B0, 0, 0); PG8_LDB(B1, 0, 1); PG8_SCHED; PG8_LDA(At, 0, 0); PG8_STAGE(PG8_SA(1, 1), a1 + hstepA, voffA);
            PG8_WAIT_V(8); PG8_WAIT_L(0); PG8_BAR; PG8_MMA(0, 0, At, B0); PG8_MMA(0, 1, At, B1); PG8_BAR; PG8_SCHED;
            PG8_LDA(At, 0, 1); PG8_STAGE(PG8_SB(0, 0), b2, voffB); PG8_STAGE(PG8_SB(0, 1), b2 + hstepB, voffB); PG8_STAGE(PG8_SA(0, 0), a2, voffA);
            PG8_WAIT_V(8); PG8_WAIT_L(0); PG8_BAR; PG8_MMA(1, 0, At, B0); PG8_MMA(1, 1, At, B1); PG8_BAR; PG8_SCHED;
            PG8_LDB(B0, 1, 0); PG8_LDB(B1, 1, 1); PG8_SCHED; PG8_LDA(At, 1, 0); PG8_STAGE(PG8_SA(0, 1), a2 + hstepA, voffA);
            PG8_WAIT_V(8); PG8_WAIT_L(0); PG8_BAR; PG8_MMA(0, 0, At, B0); PG8_MMA(0, 1, At, B1); PG8_BAR; PG8_SCHED;
            PG8_LDA(At, 1, 1); PG8_STAGE(PG8_SB(1, 0), b3, voffB); PG8_STAGE(PG8_SB(1, 1), b3 + hstepB, voffB); PG8_STAGE(PG8_SA(1, 0), a3, voffA);
            PG8_WAIT_V(8); PG8_WAIT_L(0); PG8_BAR; PG8_MMA(1, 0, At, B0); PG8_MMA(1, 1, At, B1); PG8_BAR; PG8_SCHED;
            } else {
            PG8_LDB(B0, 0, 0); PG8_SCHED; PG8_LDA(At, 0, 0); PG8_STAGE(PG8_SA(1, 1), a1 + hstepA, voffA);
            PG8_WAIT_L(8); PG8_BAR; PG8_WAIT_L(0); PG8_MMA(0, 0, At, B0); PG8_BAR; PG8_SCHED;
            PG8_LDB(B1, 0, 1); PG8_STAGE(PG8_SB(0, 0), b2, voffB);
            PG8_BAR; PG8_WAIT_L(0); PG8_MMA(0, 1, At, B1); PG8_BAR;
            PG8_LDA(At, 0, 1); PG8_STAGE(PG8_SA(0, 0), a2, voffA);
            PG8_BAR; PG8_WAIT_L(0); PG8_MMA(1, 0, At, B0); PG8_BAR; PG8_SCHED;
            PG8_STAGE(PG8_SB(0, 1), b2 + hstepB, voffB);
            PG8_WAIT_V(6); PG8_BAR; PG8_MMA(1, 1, At, B1); PG8_BAR;
            PG8_LDB(B0, 1, 0); PG8_SCHED; PG8_LDA(At, 1, 0); PG8_STAGE(PG8_SA(0, 1), a2 + hstepA, voffA);
            PG8_WAIT_L(8); PG8_BAR; PG8_WAIT_L(0); PG8_MMA(0, 0, At, B0); PG8_BAR; PG8_SCHED;
            PG8_LDB(B1, 1, 1); PG8_STAGE(PG8_SB(1, 0), b3, voffB);
            PG8_BAR; PG8_WAIT_L(0); PG8_MMA(0, 1, At, B1); PG8_BAR;
            PG8_LDA(At, 1, 1); PG8_STAGE(PG8_SA(1, 0), a3, voffA);
            PG8_BAR; PG8_WAIT_L(0); PG8_MMA(1, 0, At, B0); PG8_BAR; PG8_SCHED;
            PG8_STAGE(PG8_SB(1, 1), b3 + hstepB, voffB);
            PG8_WAIT_V(6); PG8_BAR; PG8_MMA(1, 1, At, B1); PG8_BAR;
            }
        }
        if constexpr (ALIGN_EPI) { if (wr == 0) PG8_BAR; }
        if constexpr (!Epi::AFTER_DRAIN) { E(acc, cur, wr, wc, fr, fq); S.done(cur); }
        if (!has_next) break;
#pragma unroll
        for (int a = 0; a < 2; ++a)
#pragma unroll
            for (int b = 0; b < 2; ++b)
#pragma unroll
                for (int m = 0; m < 4; ++m)
#pragma unroll
                    for (int n = 0; n < 2; ++n) acc[a][b][m][n] = (f32x4){0.f, 0.f, 0.f, 0.f};
        cur = nxt; cA = nA; cB = nB; ++ui;
        if constexpr (ALIGN_EPI) { if (wr == 1) PG8_BAR; }
    }
    PG8_WAIT_V(0);
    if constexpr (!ALIGN_EPI) { if (wr == 0) PG8_BAR; }
    PG8_BAR;
    if constexpr (Epi::AFTER_DRAIN) { E.fused(acc, cur, wr, wc, fr, fq, lds, wid, lane); S.done(cur); }
#undef PG8_SA
#undef PG8_SB
#undef PG8_STAGE
#undef PG8_LDA
#undef PG8_LDB
#undef PG8_MMA
#undef PG8_WAIT_V
#undef PG8_WAIT_L
#undef PG8_BAR
#undef PG8_SCHED
}
}
constexpr int NWAVES = 8;
#ifndef MK_N_LAUNCHES
#define MK_N_LAUNCHES 1
#endif
constexpr int N_PHASES = 13;
constexpr int N_LAUNCHES = MK_N_LAUNCHES;
constexpr int BATCH = 16, SEQ = 2048, DM = 1024, M = BATCH * SEQ, FF = 4096;
constexpr int A_IN = 2120, A_INP = 2304, B_IN = 672, B_INP = 768, QUP = 1536, KVUP = 2048, QLORA = 384, KVLORA = 256;
constexpr size_t MiB = 1u << 20;
constexpr size_t WS_CTL = 0, CTL_ZERO_BYTES = 64 * 1024;
constexpr size_t WS_WAIN = 1 * MiB, WS_WAOUT = 6 * MiB, WS_WUP0 = 8 * MiB, WS_WUP1 = 16 * MiB, WS_WDN0 = 24 * MiB, WS_WDN1 = 32 * MiB;
constexpr size_t WS_WBIN = 40 * MiB, WS_WQUP = 42 * MiB, WS_WKVUP = 44 * MiB, WS_WBOUT = 46 * MiB;
constexpr size_t WS_COSA = 48 * MiB, WS_SINA = 49 * MiB, WS_COSB = 50 * MiB, WS_SINB = 52 * MiB;
constexpr size_t WS_SS = 54 * MiB, WS_SSB = 56 * MiB, WS_WI = 59 * MiB;
constexpr size_t WS_XB = 64 * MiB;
constexpr size_t WS_BIG = 128 * MiB;
constexpr size_t WS_PA = WS_BIG, WS_OA = WS_BIG + 144 * MiB;
constexpr size_t WS_H = WS_BIG;
constexpr size_t WS_CB = WS_BIG, WS_QB = WS_BIG + 48 * MiB, WS_OB = WS_BIG + 144 * MiB;
constexpr size_t WS_KVB = 384 * MiB, WS_END = 512 * MiB;
static_assert(WS_WAIN + (size_t)A_INP * DM * 2 <= WS_WAOUT && WS_WBIN + (size_t)B_INP * DM * 2 <= WS_WQUP && WS_WQUP + (size_t)QUP * QLORA * 2 <= WS_WKVUP && WS_WKVUP + (size_t)KVUP * KVLORA * 2 <= WS_WBOUT, "weights map");
static_assert(WS_SSB + (size_t)M * 24 * 4 <= WS_WI && WS_WI + (size_t)M * 8 * 4 <= WS_XB && WS_PA + (size_t)M * A_INP * 2 <= WS_OA && WS_OA + (size_t)M * DM * 2 <= WS_KVB && WS_QB + (size_t)M * QUP * 2 <= WS_OB, "activation map");
constexpr int CW_BAR = 1024;
constexpr int RING_BYTES = 131072, LDSCTL_OFF = RING_BYTES, MISC_OFF = LDSCTL_OFF + 320, LDS_BYTES = 147456;
constexpr float IDX_WSCALE = 0.044194173824159216f;
constexpr float QSCALE_B = 0.10206207261596577f * 1.4426950408889634f;

#define GAS __attribute__((address_space(1)))
#define LAS __attribute__((address_space(3)))
typedef unsigned short bf16;
typedef unsigned v4u __attribute__((ext_vector_type(4)));
typedef float f32x4 __attribute__((ext_vector_type(4)));
typedef short bf16x8 __attribute__((ext_vector_type(8)));
typedef GAS unsigned gu32;
typedef GAS unsigned long long gu64;
#define RLX_AGENT __ATOMIC_RELAXED, __HIP_MEMORY_SCOPE_AGENT
#define LDS_WAIT() asm volatile("s_waitcnt lgkmcnt(0)" ::: "memory")
#define VM_WAIT() asm volatile("s_waitcnt vmcnt(0)" ::: "memory")
__device__ __forceinline__ unsigned long long rt() { return __builtin_amdgcn_s_memrealtime(); }
__device__ __forceinline__ unsigned f2bf(float f) { unsigned u = __builtin_bit_cast(unsigned, f); return (u + 0x7fffu + ((u >> 16) & 1u)) >> 16; }
__device__ __forceinline__ unsigned pk2(float lo, float hi) { return f2bf(lo) | (f2bf(hi) << 16); }

#define XB_TMO      128
#define XB_XCNT(j)  (256  + 64 * (j))
#define XB_XSUB(j)  (1280 + 64 * (j))
#define XB_XGEN(j)  (2304 + 64 * (j))
#define XB_TOP      3328
#define XB_TOPGEN   3392
#define XCD_BAR_WORDS 3456
#define XB_SPIN_CAP (1u << 18)

__device__ __forceinline__ unsigned xb_ld(unsigned* p)              { return __hip_atomic_load(p, __ATOMIC_RELAXED, __HIP_MEMORY_SCOPE_AGENT); }
__device__ __forceinline__ unsigned xb_add(unsigned* p, unsigned v) { return __hip_atomic_fetch_add(p, v, __ATOMIC_RELAXED, __HIP_MEMORY_SCOPE_AGENT); }
__device__ __forceinline__ unsigned xb_xcc_id() { return (unsigned)__builtin_amdgcn_s_getreg((3 << 11) | 20) & 0xFu; }
#define XB_SPIN(cond, bar) do { unsigned _sp = 0; while (cond) { __builtin_amdgcn_s_sleep(1); \
    if ((++_sp & 255u) == 0u) { if (xb_ld(&(bar)[XB_TMO])) break; if (_sp > XB_SPIN_CAP) { atomicAdd(&(bar)[XB_TMO], 1u); break; } } } } while (0)

struct XcdBarrier {
    unsigned* bar; unsigned x;
    volatile LAS unsigned* st;
};

__device__ __forceinline__ XcdBarrier xcd_barrier_post(unsigned* bar, volatile LAS unsigned* st) {
    XcdBarrier b; b.bar = bar; b.x = xb_xcc_id(); b.st = st;
    if (threadIdx.x == 0) (void)xb_add(&bar[XB_XCNT(b.x)], 1u);
    return b;
}
__device__ __forceinline__ void xcd_barrier_complete(unsigned* bar, unsigned x, unsigned& nloc, unsigned& nx) {
    const unsigned G = gridDim.x * gridDim.y * gridDim.z;
    unsigned sum, cnt, mine, sp = 0u;
    for (;;) {
        sum = 0u; cnt = 0u; mine = 0u;
#pragma unroll
        for (unsigned j = 0; j < 16; ++j) { const unsigned c = xb_ld(&bar[XB_XCNT(j)]); sum += c; cnt += (c > 0u) ? 1u : 0u; mine = (j == x) ? c : mine; }
        if (sum == G) break;
        __builtin_amdgcn_s_sleep(1);
        if ((++sp & 255u) == 0u) { if (xb_ld(&bar[XB_TMO])) break; if (sp > XB_SPIN_CAP) { atomicAdd(&bar[XB_TMO], 1u); break; } }
    }
    nloc = mine > 0u ? mine : 1u; nx = cnt > 0u ? cnt : 1u;
}

__device__ __forceinline__ void xcd_barrier(const XcdBarrier& b) {
    asm volatile("s_waitcnt vmcnt(0)" ::: "memory");
    __syncthreads();
    if (threadIdx.x == 0) {
        unsigned* bar = b.bar;
        __builtin_amdgcn_s_waitcnt(0);
        unsigned nloc = b.st[0], nx = b.st[1];
        if (nloc == 0u) { xcd_barrier_complete(bar, b.x, nloc, nx); b.st[0] = nloc; b.st[1] = nx; }
        const unsigned old = xb_add(&bar[XB_XSUB(b.x)], 1u);
        const unsigned gen = old / nloc;
        if (old + 1u == (gen + 1u) * nloc) {
            __builtin_amdgcn_fence(__ATOMIC_RELEASE, "agent");
            asm volatile("s_waitcnt vmcnt(0)" ::: "memory");
            const unsigned og = xb_add(&bar[XB_TOP], 1u);
            const unsigned tg = og / nx;
            if (og + 1u == (tg + 1u) * nx) xb_add(&bar[XB_TOPGEN], 1u);
            else XB_SPIN(xb_ld(&bar[XB_TOPGEN]) == tg, bar);
            __builtin_amdgcn_fence(__ATOMIC_ACQUIRE, "agent");
            xb_add(&bar[XB_XGEN(b.x)], 1u);
            asm volatile("s_waitcnt vmcnt(0)" ::: "memory");
        } else {
            XB_SPIN(xb_ld(&bar[XB_XGEN(b.x)]) == gen, bar);
            __builtin_amdgcn_fence(__ATOMIC_ACQUIRE, "agent");
            asm volatile("s_waitcnt vmcnt(0)" ::: "memory");
        }
    }
    __syncthreads();
}
using pg8::u32x4; using pg8::u32x2;
struct Frame {
    LAS unsigned char* lds;
    volatile LAS unsigned* MISC;
    gu32* ctl;
    int tid, lane, wave, G;
};
__device__ __forceinline__ float wave_sum(float v) {
#pragma unroll
    for (int o = 1; o < 64; o <<= 1) v += __shfl_xor(v, o);
    return v;
}
typedef _Float16 half_t;
__device__ __forceinline__ unsigned short f2h(float f) { half_t h = (half_t)f; return __builtin_bit_cast(unsigned short, h); }
__device__ __forceinline__ float h2f(unsigned short u) { return (float)__builtin_bit_cast(half_t, u); }
__device__ __forceinline__ float bf2f(unsigned short u) { return __builtin_bit_cast(float, (unsigned)u << 16); }

template <bool F16>
__device__ __forceinline__ void p0_transpose_item(const float* W, int K, int N, const float* gain, bf16* WT, LAS float* scr, int item, int lane) {
    const int nblk = (N + 31) / 32, kb = item / nblk, nb = item % nblk, k0 = 64 * kb, n0 = 32 * nb;
#pragma unroll 8
    for (int i = 0; i < 32; ++i) { const int kk = 2 * i + (lane >> 5); const int n = n0 + (lane & 31);
        float v = (n < N) ? W[(size_t)(k0 + kk) * N + n] : 0.f; if (gain) v *= gain[k0 + kk]; scr[kk * 33 + (lane & 31)] = v; }
    LDS_WAIT(); asm volatile("" ::: "memory");
    const int c = lane & 7;
#pragma unroll
    for (int j = 0; j < 4; ++j) { const int n = (lane >> 3) + 8 * j; const LAS float* s = scr + (8 * c) * 33 + n;
        v4u o;
        if (F16) { o.x = (unsigned)f2h(s[0 * 33]) | ((unsigned)f2h(s[1 * 33]) << 16); o.y = (unsigned)f2h(s[2 * 33]) | ((unsigned)f2h(s[3 * 33]) << 16);
                   o.z = (unsigned)f2h(s[4 * 33]) | ((unsigned)f2h(s[5 * 33]) << 16); o.w = (unsigned)f2h(s[6 * 33]) | ((unsigned)f2h(s[7 * 33]) << 16); }
        else { o.x = pk2(s[0 * 33], s[1 * 33]); o.y = pk2(s[2 * 33], s[3 * 33]); o.z = pk2(s[4 * 33], s[5 * 33]); o.w = pk2(s[6 * 33], s[7 * 33]); }
        *(GAS v4u*)(WT + (size_t)(n0 + n) * K + k0 + 8 * c) = o; }
    LDS_WAIT(); asm volatile("" ::: "memory");
}
struct Args { const void* in[15]; float* out; unsigned char* ws; float inv_a[8]; float inv_b[16]; int ph_lo, ph_hi; };

__device__ __forceinline__ void p0_prologue(Frame& F, const Args& A) {
    unsigned char* ws = A.ws;
    LAS float* scr = (LAS float*)(F.lds + F.wave * 16384);
    const int gw = blockIdx.x * NWAVES + F.wave, NGW = F.G * NWAVES, lane = F.lane;
    const float* attn_norm = (const float*)A.in[2]; const float* mlp_norm = (const float*)A.in[3];
    constexpr int I_AIN = 16 * 67, I_AOUT = 16 * 32, I_UP = 16 * 128, I_DN = 64 * 32, I_BIN = 16 * 21, I_QUP = 6 * 48, I_KVUP = 4 * 64, I_BOUT = 16 * 32;
    constexpr int NITEMS = I_AIN + I_AOUT + 2 * I_UP + 2 * I_DN + I_BIN + I_QUP + I_KVUP + I_BOUT;
    for (int it = gw; it < NITEMS; it += NGW) {
        int r = it;
        if (r < I_AIN) { p0_transpose_item<true>((const float*)A.in[4], 1024, A_IN, attn_norm, (bf16*)(ws + WS_WAIN), scr, r, lane); continue; } r -= I_AIN;
        if (r < I_AOUT) { p0_transpose_item<false>((const float*)A.in[5], 1024, 1024, nullptr, (bf16*)(ws + WS_WAOUT), scr, r, lane); continue; } r -= I_AOUT;
        if (r < I_UP) { p0_transpose_item<false>((const float*)A.in[12], 1024, 4096, mlp_norm, (bf16*)(ws + WS_WUP0), scr, r, lane); continue; } r -= I_UP;
        if (r < I_UP) { p0_transpose_item<false>((const float*)A.in[12] + (size_t)1024 * 4096, 1024, 4096, mlp_norm + 1024, (bf16*)(ws + WS_WUP1), scr, r, lane); continue; } r -= I_UP;
        if (r < I_DN) { p0_transpose_item<false>((const float*)A.in[13], 4096, 1024, nullptr, (bf16*)(ws + WS_WDN0), scr, r, lane); continue; } r -= I_DN;
        if (r < I_DN) { p0_transpose_item<false>((const float*)A.in[13] + (size_t)4096 * 1024, 4096, 1024, nullptr, (bf16*)(ws + WS_WDN1), scr, r, lane); continue; } r -= I_DN;
        if (r < I_BIN) { p0_transpose_item<false>((const float*)A.in[6], 1024, B_IN, attn_norm + 1024, (bf16*)(ws + WS_WBIN), scr, r, lane); continue; } r -= I_BIN;
        if (r < I_QUP) { p0_transpose_item<false>((const float*)A.in[9], QLORA, QUP, (const float*)A.in[7], (bf16*)(ws + WS_WQUP), scr, r, lane); continue; } r -= I_QUP;
        if (r < I_KVUP) { p0_transpose_item<false>((const float*)A.in[10], KVLORA, KVUP, (const float*)A.in[8], (bf16*)(ws + WS_WKVUP), scr, r, lane); continue; } r -= I_KVUP;
        p0_transpose_item<false>((const float*)A.in[11], 1024, 1024, nullptr, (bf16*)(ws + WS_WBOUT), scr, r, lane);
    }
    {   const int gt = gw * 64 + lane, NT = NGW * 64;
        GAS v4u* z1 = (GAS v4u*)(ws + WS_WAIN + (size_t)2144 * 1024 * 2); const int n1 = (A_INP - 2144) * 1024 * 2 / 16;
        for (int i = gt; i < n1; i += NT) z1[i] = (v4u){0u, 0u, 0u, 0u};
        GAS v4u* z2 = (GAS v4u*)(ws + WS_WBIN + (size_t)B_IN * 1024 * 2); const int n2 = (B_INP - B_IN) * 1024 * 2 / 16;
        for (int i = gt; i < n2; i += NT) z2[i] = (v4u){0u, 0u, 0u, 0u};
        const int* pos = (const int*)A.in[1];
        float* cA = (float*)(ws + WS_COSA); float* sA = (float*)(ws + WS_SINA); float* cB = (float*)(ws + WS_COSB); float* sB = (float*)(ws + WS_SINB);
        for (int i = gt; i < M * 8; i += NT) { const float ang = (float)pos[i >> 3] * A.inv_a[i & 7]; double rev = (double)ang * 0.15915494309189535; rev -= __builtin_rint(rev); const float fr = (float)rev;
            cA[i] = __builtin_amdgcn_cosf(fr); sA[i] = __builtin_amdgcn_sinf(fr); }
        for (int i = gt; i < M * 16; i += NT) { const float ang = (float)pos[i >> 4] * A.inv_b[i & 15]; double rev = (double)ang * 0.15915494309189535; rev -= __builtin_rint(rev); const float fr = (float)rev;
            cB[i] = __builtin_amdgcn_cosf(fr); sB[i] = __builtin_amdgcn_sinf(fr); }
    }
    const float* x = (const float*)A.in[0]; bf16* XB = (bf16*)(ws + WS_XB); float* SS = (float*)(ws + WS_SS);
    for (int m = gw; m < M; m += NGW) {
        const GAS f32x4* xr = (const GAS f32x4*)(x + (size_t)m * DM) + lane; f32x4 v[4]; float s = 0.f;
#pragma unroll
        for (int j = 0; j < 4; ++j) { v[j] = xr[64 * j]; s += (v[j].x * v[j].x + v[j].y * v[j].y) + (v[j].z * v[j].z + v[j].w * v[j].w); }
        s = wave_sum(s);
        GAS unsigned long long* o8 = (GAS unsigned long long*)(XB + (size_t)m * DM) + lane;
#pragma unroll
        for (int j = 0; j < 4; ++j) o8[64 * j] = (unsigned long long)((unsigned)f2h(v[j].x) | ((unsigned)f2h(v[j].y) << 16)) | ((unsigned long long)((unsigned)f2h(v[j].z) | ((unsigned)f2h(v[j].w) << 16)) << 32);
        if (lane < 16) SS[(size_t)m * 16 + lane] = (lane == 0) ? s : 0.f;
    }
}
__device__ __forceinline__ void p12_final_norm(Frame& F, const Args& A) {
    const int gw = blockIdx.x * NWAVES + F.wave, NGW = F.G * NWAVES, lane = F.lane;
    const float* g = (const float*)A.in[14]; const float* SS = (const float*)(A.ws + WS_SS);
    f32x4 gv[4];
#pragma unroll
    for (int j = 0; j < 4; ++j) gv[j] = ((const GAS f32x4*)g)[lane + 64 * j];
    for (int m = gw; m < M; m += NGW) {
        const float rs = pg8::rstd_from(SS + (size_t)m * 16, 4, 1.0f / 1024.0f);
        GAS f32x4* xr = (GAS f32x4*)(A.out + (size_t)m * DM) + lane;
#pragma unroll
        for (int j = 0; j < 4; ++j) { f32x4 v = xr[64 * j]; xr[64 * j] = v * rs * gv[j]; }
    }
}
__device__ __forceinline__ int block_sum_i(int v, volatile LAS unsigned* red, int wid, int lane) {
#pragma unroll
    for (int o = 32; o >= 1; o >>= 1) v += __shfl_xor(v, o);
    __syncthreads();
    if (lane == 0) red[wid] = (unsigned)v;
    __syncthreads();
    int t = 0;
#pragma unroll
    for (int w = 0; w < NWAVES; ++w) t += (int)red[w];
    return t;
}
__device__ __forceinline__ void dsa_naive_phase(Frame& F, const Args& A) {
    const bf16* PA = (const bf16*)(A.ws + WS_PA); const float* WI = (const float*)(A.ws + WS_WI); bf16* OA = (bf16*)(A.ws + WS_OA);
    LAS float* qi_s = (LAS float*)F.lds;
    LAS float* w_s = qi_s + 512;
    LAS unsigned* key_s = (LAS unsigned*)(w_s + 16);
    LAS int* sel_s = (LAS int*)(key_s + 2048);
    LAS float* q_s = (LAS float*)(sel_s + 256);
    LAS float* p_s = q_s + 1024;
    volatile LAS unsigned* red_s = (volatile LAS unsigned*)(p_s + 4096);
    const int tid = F.tid, lane = F.lane, wid = F.wave;
    for (int q = blockIdx.x; q < M; q += F.G) {
        const int b = q >> 11, t = q & 2047, NK = ((t >> 6) + 1) << 6;
        const bf16* prow = PA + (size_t)q * A_INP;
        __syncthreads();
        qi_s[tid] = h2f(prow[1536 + tid]);
        q_s[tid] = h2f(prow[tid]); q_s[tid + 512] = h2f(prow[tid + 512]);
        if (tid < 8) w_s[tid] = WI[(size_t)q * 8 + tid];
        __syncthreads();
        int nsel;
        if (NK <= 256) { nsel = NK; if (tid < NK) sel_s[tid] = tid; }
        else {
            for (int s = tid; s < NK; s += 512) {
                const v4u* kp = (const v4u*)(PA + ((size_t)(b * SEQ + s)) * A_INP + 2048);
                float kk[64];
#pragma unroll
                for (int c = 0; c < 8; ++c) { const v4u w = kp[c];
                    kk[8 * c + 0] = h2f((unsigned short)(w.x & 0xffff)); kk[8 * c + 1] = h2f((unsigned short)(w.x >> 16)); kk[8 * c + 2] = h2f((unsigned short)(w.y & 0xffff)); kk[8 * c + 3] = h2f((unsigned short)(w.y >> 16));
                    kk[8 * c + 4] = h2f((unsigned short)(w.z & 0xffff)); kk[8 * c + 5] = h2f((unsigned short)(w.z >> 16)); kk[8 * c + 6] = h2f((unsigned short)(w.w & 0xffff)); kk[8 * c + 7] = h2f((unsigned short)(w.w >> 16)); }
                float acc = 0.f;
#pragma unroll 1
                for (int h = 0; h < 8; ++h) { float dot = 0.f;
#pragma unroll
                    for (int d = 0; d < 64; ++d) dot = fmaf(qi_s[h * 64 + d], kk[d], dot);
                    acc = fmaf(w_s[h], fmaxf(dot, 0.f), acc); }
                const unsigned u = __builtin_bit_cast(unsigned, acc);
                key_s[s] = (u & 0x80000000u) ? ~u : (u | 0x80000000u);
            }
            __syncthreads();
            unsigned prefix = 0u;
            for (int bit = 31; bit >= 0; --bit) {
                const unsigned cand = prefix | (1u << bit); int c = 0;
                for (int s = tid; s < NK; s += 512) c += (key_s[s] >= cand) ? 1 : 0;
                c = block_sum_i(c, red_s, wid, lane);
                if (c >= 256) prefix = cand;
            }
            const unsigned T = prefix;
            int cg = 0, ce = 0;
            for (int s = tid; s < NK; s += 512) { const unsigned k = key_s[s]; cg += (k > T) ? 1 : 0; ce += (k == T) ? 1 : 0; }
            cg = block_sum_i(cg, red_s, wid, lane); ce = block_sum_i(ce, red_s, wid, lane);
            const int need_eq = 256 - cg;
            int tie_cut = NK;
            if (ce > need_eq) {
                __syncthreads();
                if (tid == 0) { int cnt = 0, cut = NK; for (int s = 0; s < NK; ++s) if (key_s[s] == T) { if (++cnt == need_eq) { cut = s + 1; break; } } red_s[8] = (unsigned)cut; }
                __syncthreads();
                tie_cut = (int)red_s[8];
            }
            int running = 0;
            for (int base = 0; base < NK; base += 512) {
                const int s = base + tid; bool flag = false;
                if (s < NK) { const unsigned k = key_s[s]; flag = (k > T) || (k == T && s < tie_cut); }
                const unsigned long long mask = __ballot(flag);
                const int rank = __popcll(mask & ((1ull << lane) - 1ull));
                __syncthreads();
                if (lane == 0) red_s[wid] = (unsigned)__popcll(mask);
                __syncthreads();
                int off = running, tot = 0;
#pragma unroll
                for (int w = 0; w < NWAVES; ++w) { const int cw = (int)red_s[w]; if (w < wid) off += cw; tot += cw; }
                if (flag) sel_s[off + rank] = s;
                running += tot;
            }
            nsel = running;
        }
        __syncthreads();
        const int hh = tid >> 5, l32 = tid & 31, g = hh >> 2;
        float lmax = -INFINITY;
        for (int j = l32; j < nsel; j += 32) {
            const int s = sel_s[j]; const v4u* kp = (const v4u*)(PA + ((size_t)(b * SEQ + s)) * A_INP + 1024 + g * 64);
            float dot = 0.f;
#pragma unroll
            for (int c = 0; c < 8; ++c) { const v4u w = kp[c]; const LAS float* qq = q_s + hh * 64 + 8 * c;
                dot = fmaf(qq[0], h2f((unsigned short)(w.x & 0xffff)), dot); dot = fmaf(qq[1], h2f((unsigned short)(w.x >> 16)), dot); dot = fmaf(qq[2], h2f((unsigned short)(w.y & 0xffff)), dot); dot = fmaf(qq[3], h2f((unsigned short)(w.y >> 16)), dot);
                dot = fmaf(qq[4], h2f((unsigned short)(w.z & 0xffff)), dot); dot = fmaf(qq[5], h2f((unsigned short)(w.z >> 16)), dot); dot = fmaf(qq[6], h2f((unsigned short)(w.w & 0xffff)), dot); dot = fmaf(qq[7], h2f((unsigned short)(w.w >> 16)), dot); }
            const float lg = dot * 0.125f; p_s[hh * 256 + j] = lg; lmax = fmaxf(lmax, lg);
        }
#pragma unroll
        for (int o = 16; o >= 1; o >>= 1) lmax = fmaxf(lmax, __shfl_xor(lmax, o));
        float lsum = 0.f;
        for (int j = l32; j < nsel; j += 32) { const float e = __expf(p_s[hh * 256 + j] - lmax); p_s[hh * 256 + j] = e; lsum += e; }
#pragma unroll
        for (int o = 16; o >= 1; o >>= 1) lsum += __shfl_xor(lsum, o);
        __syncthreads();
        const float inv = 1.0f / lsum;
        float a0 = 0.f, a1 = 0.f;
        for (int j = 0; j < nsel; ++j) { const float p = p_s[hh * 256 + j]; const bf16* vp = PA + ((size_t)(b * SEQ + sel_s[j])) * A_INP + 1280 + g * 64 + l32;
            a0 = fmaf(p, h2f(vp[0]), a0); a1 = fmaf(p, h2f(vp[32]), a1); }
        OA[(size_t)q * DM + hh * 64 + l32] = (bf16)f2bf(a0 * inv); OA[(size_t)q * DM + hh * 64 + l32 + 32] = (bf16)f2bf(a1 * inv);
    }
}

namespace mla {
typedef float f32x16 __attribute__((ext_vector_type(16)));
typedef short s16x4 __attribute__((ext_vector_type(4)));
constexpr int KP = 208;
constexpr int LDS_K = 0, LDS_V = 64 * KP, LDS_END = LDS_V + 8192;
__device__ __forceinline__ float xmax32(float m) { auto rr = __builtin_amdgcn_permlane32_swap(__float_as_uint(m), __float_as_uint(m), false, false); return fmaxf(__uint_as_float(rr[0]), __uint_as_float(rr[1])); }
__device__ __forceinline__ void attn_unit(LAS unsigned char* lds, const bf16* QB, const bf16* KVB, const bf16* CB, bf16* OB, int b, int h, int qb) {
    const int tid = threadIdx.x, lane = tid & 63, r32 = lane & 31, hi = lane >> 5; const int wid = __builtin_amdgcn_readfirstlane(tid >> 6);
    const int c0 = qb * 4, cw = c0 + (wid >> 1), ntile = c0 + 4;
    const size_t row0 = (size_t)b * SEQ;
    const bf16* qp = QB + (row0 + (size_t)qb * 256 + wid * 32 + r32) * QUP + h * 96 + hi * 8;
    bf16x8 qf[6];
#pragma unroll
    for (int ks = 0; ks < 6; ++ks) qf[ks] = *(const bf16x8*)(qp + ks * 16);
    f32x16 o0 = {}, o1 = {}; float mrun = -INFINITY, lrun = 0.f;
    const unsigned vb = (unsigned)(uintptr_t)(lds + LDS_V) + ((lane >> 4) & 1) * 32 + (lane & 3) * 8 + (4 * hi + ((lane & 15) >> 2)) * 64;
    for (int kt = 0; kt < ntile; ++kt) {
        __syncthreads();
        for (int c = tid; c < 768; c += 512) { const int key = c / 12, ci = c % 12; const size_t krow = row0 + (size_t)kt * 64 + key;
            const bf16* src = (ci < 8) ? (KVB + krow * KVUP + h * 128 + ci * 8) : (CB + krow * B_INP + 640 + (ci - 8) * 8);
            *(LAS v4u*)(lds + LDS_K + key * KP + ci * 16) = *(const v4u*)src; }
        { const int key = tid >> 3, c8 = tid & 7; const bf16* src = KVB + (row0 + (size_t)kt * 64 + key) * KVUP + h * 128 + 64 + c8 * 8;
          *(LAS v4u*)(lds + LDS_V + (c8 >> 2) * 4096 + (key >> 3) * 512 + (key & 7) * 64 + (c8 & 3) * 16) = *(const v4u*)src; }
        __syncthreads();
        if (kt <= cw) {
            f32x16 p0 = {}, p1 = {};
#pragma unroll
            for (int ks = 0; ks < 6; ++ks) {
                const bf16x8 k0 = *(const LAS bf16x8*)(lds + LDS_K + r32 * KP + ks * 32 + hi * 16);
                const bf16x8 k1 = *(const LAS bf16x8*)(lds + LDS_K + (32 + r32) * KP + ks * 32 + hi * 16);
                p0 = __builtin_amdgcn_mfma_f32_32x32x16_bf16(k0, qf[ks], p0, 0, 0, 0);
                p1 = __builtin_amdgcn_mfma_f32_32x32x16_bf16(k1, qf[ks], p1, 0, 0, 0);
            }
            float mx = fmaxf(p0[0], p1[0]);
#pragma unroll
            for (int r = 1; r < 16; ++r) mx = fmaxf(mx, fmaxf(p0[r], p1[r]));
            mx = xmax32(mx);
            const float mn = fmaxf(mrun, mx), alpha = __builtin_amdgcn_exp2f(mrun - mn); mrun = mn;
            float ls = 0.f;
#pragma unroll
            for (int r = 0; r < 16; ++r) { p0[r] = __builtin_amdgcn_exp2f(p0[r] - mn); p1[r] = __builtin_amdgcn_exp2f(p1[r] - mn); ls += p0[r] + p1[r]; }
            lrun = lrun * alpha + ls;
#pragma unroll
            for (int r = 0; r < 16; ++r) { o0[r] *= alpha; o1[r] *= alpha; }
            bf16x8 pa[4];
#pragma unroll
            for (int s = 0; s < 2; ++s) {
                u32x4 w0, w1;
                w0.x = pg8::cvt_pk_bf16(p0[8 * s + 0], p0[8 * s + 1]); w0.y = pg8::cvt_pk_bf16(p0[8 * s + 2], p0[8 * s + 3]); w0.z = pg8::cvt_pk_bf16(p0[8 * s + 4], p0[8 * s + 5]); w0.w = pg8::cvt_pk_bf16(p0[8 * s + 6], p0[8 * s + 7]);
                w1.x = pg8::cvt_pk_bf16(p1[8 * s + 0], p1[8 * s + 1]); w1.y = pg8::cvt_pk_bf16(p1[8 * s + 2], p1[8 * s + 3]); w1.z = pg8::cvt_pk_bf16(p1[8 * s + 4], p1[8 * s + 5]); w1.w = pg8::cvt_pk_bf16(p1[8 * s + 6], p1[8 * s + 7]);
                pa[s] = __builtin_bit_cast(bf16x8, w0); pa[2 + s] = __builtin_bit_cast(bf16x8, w1);
            }
#pragma unroll
            for (int d0 = 0; d0 < 2; ++d0) {
                s16x4 lo[4], hi4[4];
#pragma unroll
                for (int ks = 0; ks < 4; ++ks) {
                    asm volatile("ds_read_b64_tr_b16 %0,%1 offset:%c2" : "=&v"(lo[ks]) : "v"(vb), "i"(d0 * 4096 + ks * 1024) : "memory");
                    asm volatile("ds_read_b64_tr_b16 %0,%1 offset:%c2" : "=&v"(hi4[ks]) : "v"(vb), "i"(d0 * 4096 + ks * 1024 + 512) : "memory"); }
                asm volatile("s_waitcnt lgkmcnt(0)" ::: "memory"); __builtin_amdgcn_sched_barrier(0);
#define MLA_PK(k) (bf16x8){lo[k][0], lo[k][1], lo[k][2], lo[k][3], hi4[k][0], hi4[k][1], hi4[k][2], hi4[k][3]}
                if (d0 == 0) { o0 = __builtin_amdgcn_mfma_f32_32x32x16_bf16(MLA_PK(0), pa[0], o0, 0, 0, 0); o0 = __builtin_amdgcn_mfma_f32_32x32x16_bf16(MLA_PK(1), pa[1], o0, 0, 0, 0);
                               o0 = __builtin_amdgcn_mfma_f32_32x32x16_bf16(MLA_PK(2), pa[2], o0, 0, 0, 0); o0 = __builtin_amdgcn_mfma_f32_32x32x16_bf16(MLA_PK(3), pa[3], o0, 0, 0, 0); }
                else         { o1 = __builtin_amdgcn_mfma_f32_32x32x16_bf16(MLA_PK(0), pa[0], o1, 0, 0, 0); o1 = __builtin_amdgcn_mfma_f32_32x32x16_bf16(MLA_PK(1), pa[1], o1, 0, 0, 0);
                               o1 = __builtin_amdgcn_mfma_f32_32x32x16_bf16(MLA_PK(2), pa[2], o1, 0, 0, 0); o1 = __builtin_amdgcn_mfma_f32_32x32x16_bf16(MLA_PK(3), pa[3], o1, 0, 0, 0); }
#undef MLA_PK
            }
        }
    }
    lrun += __shfl_xor(lrun, 32);
    const float inv = 1.0f / lrun;
    bf16* op = OB + (row0 + (size_t)qb * 256 + wid * 32 + r32) * DM + h * 64 + 4 * hi;
#pragma unroll
    for (int g = 0; g < 4; ++g) {
        u32x2 w; w.x = pg8::cvt_pk_bf16(o0[4 * g] * inv, o0[4 * g + 1] * inv); w.y = pg8::cvt_pk_bf16(o0[4 * g + 2] * inv, o0[4 * g + 3] * inv); *(u32x2*)(op + 8 * g) = w;
        u32x2 z; z.x = pg8::cvt_pk_bf16(o1[4 * g] * inv, o1[4 * g + 1] * inv); z.y = pg8::cvt_pk_bf16(o1[4 * g + 2] * inv, o1[4 * g + 3] * inv); *(u32x2*)(op + 32 + 8 * g) = z;
    }
}
__device__ __forceinline__ void attn_phase(Frame& F, const Args& A) {
    const bf16* QB = (const bf16*)(A.ws + WS_QB); const bf16* KVB = (const bf16*)(A.ws + WS_KVB); const bf16* CB = (const bf16*)(A.ws + WS_CB); bf16* OB = (bf16*)(A.ws + WS_OB);
    for (int u = blockIdx.x; u < BATCH * 16 * 8; u += F.G) { const int bh = u & 255, qb = u >> 8; attn_unit(F.lds, QB, KVB, CB, OB, bh >> 4, bh & 15, qb); }
}
}
__global__ void __launch_bounds__(NWAVES * 64, 2) mk_fwd(Args args) {
    extern __shared__ __attribute__((aligned(16))) unsigned char lds_raw[];
    Frame F;
    F.lds = (LAS unsigned char*)lds_raw;
    F.MISC = (volatile LAS unsigned*)(F.lds + MISC_OFF);
    F.tid = threadIdx.x; F.lane = F.tid & 63; F.wave = __builtin_amdgcn_readfirstlane(F.tid >> 6);
    F.G = gridDim.x;
    unsigned char* ws = args.ws;
    F.ctl = (gu32*)(ws + WS_CTL);
    for (int u = F.tid; u < (LDS_BYTES - LDSCTL_OFF) / 4; u += NWAVES * 64) ((LAS unsigned*)(F.lds + LDSCTL_OFF))[u] = 0u;
    __syncthreads();
    XcdBarrier bar; bar.bar = (unsigned*)(F.ctl + CW_BAR); bar.x = 0; bar.st = nullptr;
    if (N_LAUNCHES == 1) bar = xcd_barrier_post((unsigned*)(F.ctl + CW_BAR), F.MISC + 8);
#define GRID_BAR() do { if (N_LAUNCHES == 1) xcd_barrier(bar); } while (0)
    const int lo = args.ph_lo, hi = args.ph_hi;
#ifndef PHMASK
#define PHMASK 0x1fff
#endif
#define IN(k) (((PHMASK >> (k)) & 1) && lo <= (k) && (k) < hi)
    bf16* const XB = (bf16*)(ws + WS_XB); float* const SS = (float*)(ws + WS_SS); float* const SSB = (float*)(ws + WS_SSB);
    const float* const cosA = (const float*)(ws + WS_COSA); const float* const sinA = (const float*)(ws + WS_SINA);
    const float* const cosB = (const float*)(ws + WS_COSB); const float* const sinB = (const float*)(ws + WS_SINB);
    const int bid = (int)blockIdx.x;

    if (IN(0)) { p0_prologue(F, args); GRID_BAR(); }
    if (IN(1)) {
        pg8::Gemm g{XB, (const bf16*)(ws + WS_WAIN), M, A_INP, DM, DM, DM}; pg8::StaticOrder S; S.init(M, A_INP, F.G, bid);
        pg8::EpiDsaIn E{(bf16*)(ws + WS_PA), (float*)(ws + WS_WI), SS, cosA, sinA, IDX_WSCALE};
        pg8::gemm_phase<pg8::EpiDsaIn, pg8::StaticOrder, true, true, true>(F.lds, g, S, E);
        GRID_BAR();
    }
    if (IN(2)) { dsa_naive_phase(F, args); GRID_BAR(); }
    if (IN(3)) {
        pg8::Gemm g{(const bf16*)(ws + WS_OA), (const bf16*)(ws + WS_WAOUT), M, DM, DM, DM, DM}; pg8::StaticOrder S; S.init(M, DM, F.G, bid);
        pg8::EpiResid E{(const float*)args.in[0], args.out, XB, SS};
        pg8::gemm_phase<pg8::EpiResid, pg8::StaticOrder, true, true, false>(F.lds, g, S, E);
        GRID_BAR();
    }
    if (IN(4)) {
        pg8::Gemm g{XB, (const bf16*)(ws + WS_WUP0), M, FF, DM, DM, DM}; pg8::StaticOrder S; S.init(M, FF, F.G, bid);
        pg8::EpiMlpUp E{(bf16*)(ws + WS_H), SS};
        pg8::gemm_phase<pg8::EpiMlpUp, pg8::StaticOrder, true, true, false>(F.lds, g, S, E);
        GRID_BAR();
    }
    if (IN(5)) {
        pg8::Gemm g{(const bf16*)(ws + WS_H), (const bf16*)(ws + WS_WDN0), M, DM, FF, FF, FF}; pg8::StaticOrder S; S.init(M, DM, F.G, bid);
        pg8::EpiResid E{args.out, args.out, XB, SS};
        pg8::gemm_phase<pg8::EpiResid, pg8::StaticOrder, true, true, false>(F.lds, g, S, E);
        GRID_BAR();
    }
    if (IN(6)) {
        pg8::Gemm g{XB, (const bf16*)(ws + WS_WBIN), M, B_INP, DM, DM, DM}; pg8::StaticOrder S; S.init(M, B_INP, F.G, bid);
        pg8::EpiMlaIn E{(bf16*)(ws + WS_CB), SSB, SS, cosB, sinB};
        pg8::gemm_phase<pg8::EpiMlaIn, pg8::StaticOrder, true, true, false>(F.lds, g, S, E);
        GRID_BAR();
    }
    if (IN(7)) {
#ifndef NO_QUP
        { pg8::Gemm g{(const bf16*)(ws + WS_CB), (const bf16*)(ws + WS_WQUP), M, QUP, QLORA, B_INP, QLORA}; pg8::StaticOrder S; S.init(M, QUP, F.G, bid);
          pg8::EpiQUp E{(bf16*)(ws + WS_QB), SSB, cosB, sinB, QSCALE_B};
          pg8::gemm_phase<pg8::EpiQUp, pg8::StaticOrder, true, true, false>(F.lds, g, S, E); }
#endif
#ifndef NO_KVUP
        { pg8::Gemm g{(const bf16*)(ws + WS_CB) + QLORA, (const bf16*)(ws + WS_WKVUP), M, KVUP, KVLORA, B_INP, KVLORA}; pg8::StaticOrder S; S.init(M, KVUP, F.G, bid);
          pg8::EpiKvUp E{(bf16*)(ws + WS_KVB), SSB};
          pg8::gemm_phase<pg8::EpiKvUp, pg8::StaticOrder, true, true, false>(F.lds, g, S, E); }
#endif
        GRID_BAR();
    }
    if (IN(8)) { mla::attn_phase(F, args); GRID_BAR(); }
    if (IN(9)) {
        pg8::Gemm g{(const bf16*)(ws + WS_OB), (const bf16*)(ws + WS_WBOUT), M, DM, DM, DM, DM}; pg8::StaticOrder S; S.init(M, DM, F.G, bid);
        pg8::EpiResid E{args.out, args.out, XB, SS};
        pg8::gemm_phase<pg8::EpiResid, pg8::StaticOrder, true, true, false>(F.lds, g, S, E);
        GRID_BAR();
    }
    if (IN(10)) {
        pg8::Gemm g{XB, (const bf16*)(ws + WS_WUP1), M, FF, DM, DM, DM}; pg8::StaticOrder S; S.init(M, FF, F.G, bid);
        pg8::EpiMlpUp E{(bf16*)(ws + WS_H), SS};
        pg8::gemm_phase<pg8::EpiMlpUp, pg8::StaticOrder, true, true, false>(F.lds, g, S, E);
        GRID_BAR();
    }
    if (IN(11)) {
        pg8::Gemm g{(const bf16*)(ws + WS_H), (const bf16*)(ws + WS_WDN1), M, DM, FF, FF, FF}; pg8::StaticOrder S; S.init(M, DM, F.G, bid);
        pg8::EpiResid E{args.out, args.out, nullptr, SS};
        pg8::gemm_phase<pg8::EpiResid, pg8::StaticOrder, true, true, false>(F.lds, g, S, E);
        GRID_BAR();
    }
    if (IN(12)) { p12_final_norm(F, args); }
#undef IN
#undef GRID_BAR
}

extern "C" void kernel_launch(void* const* d_in, const int* in_sizes, int n_in, void* d_out, int out_size, void* d_ws, size_t ws_size, hipStream_t stream) {
    static int grid = 0;
    if (grid == 0) {
        if (n_in != 15 || in_sizes[0] != M * DM || out_size != M * DM || ws_size < WS_END) { fprintf(stderr, "kernel_launch: unexpected shapes / workspace (n_in %d, in0 %d, out %d, ws %zu); nothing launched\n", n_in, n_in > 0 ? in_sizes[0] : -1, out_size, ws_size); grid = -1; return; }
        int dev = 0, cus = 0, per_cu = 0;
        if (hipGetDevice(&dev) != hipSuccess || hipDeviceGetAttribute(&cus, hipDeviceAttributeMultiprocessorCount, dev) != hipSuccess) { grid = -1; return; }
        if (hipFuncSetAttribute((const void*)mk_fwd, hipFuncAttributeMaxDynamicSharedMemorySize, LDS_BYTES) != hipSuccess) { fprintf(stderr, "kernel_launch: hipFuncSetAttribute failed\n"); grid = -1; return; }
        if (hipOccupancyMaxActiveBlocksPerMultiprocessor(&per_cu, (const void*)mk_fwd, NWAVES * 64, LDS_BYTES) != hipSuccess || per_cu < 1) { fprintf(stderr, "kernel_launch: occupancy query reports %d blocks per CU\n", per_cu); }
        (void)hipGetLastError();
        grid = cus;
    }
    if (grid < 0) return;
    if (hipMemsetAsync((char*)d_ws + WS_CTL, 0, CTL_ZERO_BYTES, stream) != hipSuccess) return;
    Args a{};
    for (int i = 0; i < 15; ++i) a.in[i] = d_in[i];
    a.out = (float*)d_out; a.ws = (unsigned char*)d_ws;
    for (int i = 0; i < 8; ++i) a.inv_a[i] = (float)pow(500000.0, -(double)i / 8.0);
    for (int i = 0; i < 16; ++i) a.inv_b[i] = (float)pow(500000.0, -(double)i / 16.0);
    if (N_LAUNCHES == 1) { a.ph_lo = 0; a.ph_hi = N_PHASES; hipLaunchKernelGGL(mk_fwd, dim3(grid), dim3(NWAVES * 64), LDS_BYTES, stream, a); }
    else for (int li = 0; li < N_PHASES; ++li) { a.ph_lo = li; a.ph_hi = li + 1; hipLaunchKernelGGL(mk_fwd, dim3(grid), dim3(NWAVES * 64), LDS_BYTES, stream, a); }
    const hipError_t le = hipPeekAtLastError();
    if (le != hipSuccess) fprintf(stderr, "kernel_launch: launch failed: %s\n", hipGetErrorName(le));
}
```

```cpp
#include <hip/hip_runtime.h>
#include <cstdio>
#include <cstdint>
#include <cmath>
namespace pg8 {
#define PG8_LAS __attribute__((address_space(3)))
typedef unsigned short bf16_t;
typedef short bf16x8 __attribute__((ext_vector_type(8)));
typedef float f32x4 __attribute__((ext_vector_type(4)));
typedef unsigned u32x4 __attribute__((ext_vector_type(4)));
constexpr int BM = 256, BK = 64, HALF = 128, HTB = HALF * BK * 2  , STAGE_BYTES = 8 * HTB, NXCD = 8, WGM = 8;

__host__ __device__ __forceinline__ int lds_byte(int r, int c) { const int st = (r >> 4) * 2 + (c >> 5), rr = r & 15, cc = c & 31, ob = rr * 64 + cc * 2; return st * 1024 + (ob ^ (((ob >> 9) & 1) << 5)); }
__host__ __device__ __forceinline__ void stage_rc(int b, int& R, int& C) { const int st = b / 1024, sb = b % 1024, swz = sb ^ (((sb >> 9) & 1) << 5); R = (st >> 1) * 16 + swz / 64; C = (st & 1) * 32 + (swz % 64) / 2; }
__host__ __device__ __forceinline__ int perm32(int rho) { const int n = rho >> 4, i = rho & 15; return 8 * (i >> 2) + 4 * n + (i & 3); }

struct Unit { int pm, pn; };
struct Gemm { const bf16_t* A; const bf16_t* Bt; int M, N, K, lda, ldb; };

struct StaticOrder {
    int nM, nN, nwg, G, c;
    __host__ __device__ void init(int M, int N, int G_, int c_) { nM = M / BM; nN = N / BM; nwg = nM * nN; G = G_; c = c_; }
    __host__ __device__ bool next(int i, Unit& u) const {
        const long L = (long)i * G + c; if (L >= nwg) return false;
        int wgid = (int)L; { const int q = nwg / NXCD, r = nwg % NXCD, xcd = wgid % NXCD, off = wgid / NXCD; wgid = (xcd < r ? xcd * (q + 1) : r * (q + 1) + (xcd - r) * q) + off; }
        const int nig = WGM * nN, gid = wgid / nig, fm = gid * WGM, gsz = (nM - fm) < WGM ? (nM - fm) : WGM;
        u.pm = fm + ((wgid % nig) % gsz); u.pn = (wgid % nig) / gsz; return true;
    }
    __device__ __forceinline__ void a_ready(const Unit&) const {}
    __device__ __forceinline__ void done(const Unit&) const {}
};

__device__ __forceinline__ unsigned cvt_pk_bf16(float lo, float hi) { unsigned r; asm volatile("v_cvt_pk_bf16_f32 %0, %1, %2" : "=v"(r) : "v"(lo), "v"(hi)); return r; }
typedef _Float16 f16x8_t __attribute__((ext_vector_type(8)));
typedef _Float16 f16x2_t __attribute__((ext_vector_type(2)));
template <bool F16> __device__ __forceinline__ f32x4 mma16(bf16x8 a, bf16x8 b, f32x4 c) {
    if constexpr (F16) return __builtin_amdgcn_mfma_f32_16x16x32_f16(__builtin_bit_cast(f16x8_t, a), __builtin_bit_cast(f16x8_t, b), c, 0, 0, 0);
    else return __builtin_amdgcn_mfma_f32_16x16x32_bf16(a, b, c, 0, 0, 0);
}
__device__ __forceinline__ unsigned cvt_pk_f16(float lo, float hi) { f16x2_t t = {(_Float16)lo, (_Float16)hi}; return __builtin_bit_cast(unsigned, t); }
__device__ __forceinline__ u32x4 pack8_bf16(f32x4 a, f32x4 b) { u32x4 w; w.x = cvt_pk_bf16(a[0], a[1]); w.y = cvt_pk_bf16(a[2], a[3]); w.z = cvt_pk_bf16(b[0], b[1]); w.w = cvt_pk_bf16(b[2], b[3]); return w; }
__device__ __forceinline__ u32x4 pack8_f16(f32x4 a, f32x4 b) { u32x4 w; w.x = cvt_pk_f16(a[0], a[1]); w.y = cvt_pk_f16(a[2], a[3]); w.z = cvt_pk_f16(b[0], b[1]); w.w = cvt_pk_f16(b[2], b[3]); return w; }
typedef unsigned u32x2 __attribute__((ext_vector_type(2)));
__device__ __forceinline__ u32x2 pack4_bf16(f32x4 a) { u32x2 w; w.x = cvt_pk_bf16(a[0], a[1]); w.y = cvt_pk_bf16(a[2], a[3]); return w; }
__device__ __forceinline__ f32x4 shfl4(f32x4 v, int x) { f32x4 r; r[0] = __shfl_xor(v[0], x); r[1] = __shfl_xor(v[1], x); r[2] = __shfl_xor(v[2], x); r[3] = __shfl_xor(v[3], x); return r; }
__device__ __forceinline__ float sum4(f32x4 v) { return (v[0] + v[1]) + (v[2] + v[3]); }
__device__ __forceinline__ float dot4(f32x4 v) { return (v[0] * v[0] + v[1] * v[1]) + (v[2] * v[2] + v[3] * v[3]); }
constexpr float RMS_EPS = 1e-6f;
__device__ __forceinline__ float rstd_from(const float* p, int n4, float inv_cnt) {
    float s = 0.f;
#pragma unroll 4
    for (int i = 0; i < n4; ++i) s += sum4(((const f32x4*)p)[i]);
    return __builtin_amdgcn_rsqf(s * inv_cnt + RMS_EPS);
}

struct EpiDsaIn {
    static constexpr bool PERM = true, AFTER_DRAIN = false;
    bf16_t* PA; float* WI; const float* SS; const float* cosA; const float* sinA; float wscale, qscale;
    __device__ __forceinline__ void operator()(const f32x4 (&acc)[2][2][4][2], const Unit& u, int wr, int wc, int fr, int fq) const {
#pragma unroll
        for (int ai = 0; ai < 2; ++ai)
#pragma unroll
            for (int m = 0; m < 4; ++m) {
                const int row = u.pm * BM + ai * HALF + wr * 64 + m * 16 + fr;
                asm volatile("" ::: "memory");
                const float rs = rstd_from(SS + (size_t)row * 16, 4, 1.0f / 1024.0f);
                const f32x4 c0 = *(const f32x4*)(cosA + (size_t)row * 8), c1 = *(const f32x4*)(cosA + (size_t)row * 8 + 4);
                const f32x4 s0 = *(const f32x4*)(sinA + (size_t)row * 8), s1 = *(const f32x4*)(sinA + (size_t)row * 8 + 4);
#pragma unroll
                for (int bj = 0; bj < 2; ++bj) {
                    const int cb = u.pn * BM + bj * HALF + wc * 32;
                    const int col8 = cb + 8 * fq;
                    f32x4 v0 = acc[ai][bj][m][0] * rs, v1 = acc[ai][bj][m][1] * rs;
                    const bool ropeg = ((cb & 63) == 0) && (cb < 1280 || (cb >= 1536 && cb < 2112));
                    if (ropeg) {
                        const f32x4 p0 = shfl4(v0, 16), p1 = shfl4(v1, 16);
                        if (fq == 0) { v0 = v0 * c0 - p0 * s0; v1 = v1 * c1 - p1 * s1; }
                        else if (fq == 1) { v0 = v0 * c0 + p0 * s0; v1 = v1 * c1 + p1 * s1; }
                    }
                    if (cb < 1024) { v0 = v0 * qscale; v1 = v1 * qscale; }
                    if (cb < 2112) *(u32x4*)(PA + (size_t)row * 2304 + col8) = pack8_f16(v0, v1);
                    else if (cb == 2112 && fq == 0) { *(f32x4*)(WI + (size_t)row * 8) = v0 * wscale; *(f32x4*)(WI + (size_t)row * 8 + 4) = v1 * wscale; }
                }
            }
    }
};
struct EpiResid {
    static constexpr bool PERM = true, AFTER_DRAIN = false;
    const float* base; float* out; bf16_t* XB; float* SS;
    __device__ __forceinline__ void operator()(const f32x4 (&acc)[2][2][4][2], const Unit& u, int wr, int wc, int fr, int fq) const {
#pragma unroll
        for (int ai = 0; ai < 2; ++ai)
#pragma unroll
            for (int m = 0; m < 4; ++m) {
                const int row = u.pm * BM + ai * HALF + wr * 64 + m * 16 + fr;
                float ssq = 0.f;
#pragma unroll
                for (int bj = 0; bj < 2; ++bj) {
                    const int col8 = u.pn * BM + bj * HALF + wc * 32 + 8 * fq;
                    const float* bp = base + (size_t)row * 1024 + col8;
                    const f32x4 v0 = acc[ai][bj][m][0] + *(const f32x4*)bp, v1 = acc[ai][bj][m][1] + *(const f32x4*)(bp + 4);
                    float* op = out + (size_t)row * 1024 + col8;
                    *(f32x4*)op = v0; *(f32x4*)(op + 4) = v1;
                    if (XB) *(u32x4*)(XB + (size_t)row * 1024 + col8) = pack8_bf16(v0, v1);
                    ssq += dot4(v0) + dot4(v1);
                }
                ssq += __shfl_xor(ssq, 16); ssq += __shfl_xor(ssq, 32);
                if (fq == 0) SS[(size_t)row * 16 + u.pn * 4 + wc] = ssq;
            }
    }
};
struct EpiMlpUp {
    static constexpr bool PERM = true, AFTER_DRAIN = false;
    bf16_t* H; const float* SS;
    __device__ __forceinline__ void operator()(const f32x4 (&acc)[2][2][4][2], const Unit& u, int wr, int wc, int fr, int fq) const {
#pragma unroll
        for (int ai = 0; ai < 2; ++ai)
#pragma unroll
            for (int m = 0; m < 4; ++m) {
                const int row = u.pm * BM + ai * HALF + wr * 64 + m * 16 + fr;
                const float rs = rstd_from(SS + (size_t)row * 16, 4, 1.0f / 1024.0f);
#pragma unroll
                for (int bj = 0; bj < 2; ++bj) {
                    const int col8 = u.pn * BM + bj * HALF + wc * 32 + 8 * fq;
                    f32x4 v0 = acc[ai][bj][m][0] * rs, v1 = acc[ai][bj][m][1] * rs;
                    const f32x4 z = {0.f, 0.f, 0.f, 0.f};
                    v0 = __builtin_elementwise_max(v0, z); v1 = __builtin_elementwise_max(v1, z);
                    *(u32x4*)(H + (size_t)row * 4096 + col8) = pack8_bf16(v0 * v0, v1 * v1);
                }
            }
    }
};
struct EpiMlaIn {
    static constexpr bool PERM = false, AFTER_DRAIN = false;
    bf16_t* CB; float* SSB; const float* SS; const float* cosB; const float* sinB;
    __device__ __forceinline__ void operator()(const f32x4 (&acc)[2][2][4][2], const Unit& u, int wr, int wc, int fr, int fq) const {
#pragma unroll
        for (int ai = 0; ai < 2; ++ai)
#pragma unroll
            for (int m = 0; m < 4; ++m) {
                const int row = u.pm * BM + ai * HALF + wr * 64 + m * 16 + fr;
                const float rs = rstd_from(SS + (size_t)row * 16, 4, 1.0f / 1024.0f);
#pragma unroll
                for (int bj = 0; bj < 2; ++bj) {
                    const int cb = u.pn * BM + bj * HALF + wc * 32;
                    f32x4 v0 = acc[ai][bj][m][0] * rs, v1 = acc[ai][bj][m][1] * rs;
                    if (cb == 640) {
                        const f32x4 c = *(const f32x4*)(cosB + (size_t)row * 16 + 4 * fq), s = *(const f32x4*)(sinB + (size_t)row * 16 + 4 * fq);
                        const f32x4 o0 = v0 * c - v1 * s, o1 = v1 * c + v0 * s; v0 = o0; v1 = o1;
                    }
                    if (cb < 672) { bf16_t* p = CB + (size_t)row * 768 + cb + 4 * fq; *(u32x2*)p = pack4_bf16(v0); *(u32x2*)(p + 16) = pack4_bf16(v1); }
                    if (cb < 640) {
                        float ssq = dot4(v0) + dot4(v1);
                        ssq += __shfl_xor(ssq, 16); ssq += __shfl_xor(ssq, 32);
                        if (fq == 0) SSB[(size_t)row * 24 + (cb >> 5)] = ssq;
                    }
                }
            }
    }
};
struct EpiQUp {
    static constexpr bool PERM = false, AFTER_DRAIN = false;
    bf16_t* QB; const float* SSB; const float* cosB; const float* sinB; float qscale;
    __device__ __forceinline__ void operator()(const f32x4 (&acc)[2][2][4][2], const Unit& u, int wr, int wc, int fr, int fq) const {
#pragma unroll
        for (int ai = 0; ai < 2; ++ai)
#pragma unroll
            for (int m = 0; m < 4; ++m) {
                const int row = u.pm * BM + ai * HALF + wr * 64 + m * 16 + fr;
                asm volatile("" ::: "memory");
                const float rs = rstd_from(SSB + (size_t)row * 24, 3, 1.0f / 384.0f) * qscale;
                const f32x4 c = *(const f32x4*)(cosB + (size_t)row * 16 + 4 * fq), s = *(const f32x4*)(sinB + (size_t)row * 16 + 4 * fq);
#pragma unroll
                for (int bj = 0; bj < 2; ++bj) {
                    const int cb = u.pn * BM + bj * HALF + wc * 32;
                    f32x4 v0 = acc[ai][bj][m][0] * rs, v1 = acc[ai][bj][m][1] * rs;
                    if (((cb >> 5) % 3) == 2) { const f32x4 o0 = v0 * c - v1 * s, o1 = v1 * c + v0 * s; v0 = o0; v1 = o1; }
                    bf16_t* p = QB + (size_t)row * 1536 + cb + 4 * fq; *(u32x2*)p = pack4_bf16(v0); *(u32x2*)(p + 16) = pack4_bf16(v1);
                }
            }
    }
};
struct EpiKvUp {
    static constexpr bool PERM = true, AFTER_DRAIN = false;
    bf16_t* KVB; const float* SSB;
    __device__ __forceinline__ void operator()(const f32x4 (&acc)[2][2][4][2], const Unit& u, int wr, int wc, int fr, int fq) const {
#pragma unroll
        for (int ai = 0; ai < 2; ++ai)
#pragma unroll
            for (int m = 0; m < 4; ++m) {
                const int row = u.pm * BM + ai * HALF + wr * 64 + m * 16 + fr;
                const float rs = rstd_from(SSB + (size_t)row * 24 + 12, 2, 1.0f / 256.0f);
#pragma unroll
                for (int bj = 0; bj < 2; ++bj) {
                    const int col8 = u.pn * BM + bj * HALF + wc * 32 + 8 * fq;
                    *(u32x4*)(KVB + (size_t)row * 2048 + col8) = pack8_bf16(acc[ai][bj][m][0] * rs, acc[ai][bj][m][1] * rs);
                }
            }
    }
};
template <class Epi, class Sched, bool ALIGN_EPI = false, bool SP2 = false, bool F16 = false>
__device__ __forceinline__ void gemm_phase(PG8_LAS unsigned char* lds, const Gemm g, const Sched& S, const Epi& E) {
    const int tid = threadIdx.x, wid = __builtin_amdgcn_readfirstlane(tid >> 6), lane = tid & 63, wr = wid >> 2, wc = wid & 3, fr = lane & 15, fq = lane >> 4;
    const int K = g.K, nt = K / BK;
    unsigned voffA[2], voffB[2];
#pragma unroll
    for (int i = 0; i < 2; ++i) { int R, C; stage_rc(tid * 16 + i * 8192, R, C); const int Rb = Epi::PERM ? ((R & ~31) + perm32(R & 31)) : R;
        voffA[i] = (unsigned)(R * g.lda + C) * 2u; voffB[i] = (unsigned)(Rb * g.ldb + C) * 2u; }
    const size_t kstep = (size_t)(BK * 2);
    const size_t hstepA = (size_t)HALF * g.lda * 2, hstepB = (size_t)HALF * g.ldb * 2;
    const size_t tstepA = 2 * hstepA, tstepB = 2 * hstepB;
    const unsigned ldsw = (unsigned)wid * 1024u;
    const int aoff = lds_byte(wr * 64 + fr, fq * 8), boff = lds_byte(wc * 32 + fr, fq * 8);
#define PG8_SA(b, h) (((b) * 2 + (h)) * HTB)
#define PG8_SB(b, h) ((4 + (b) * 2 + (h)) * HTB)
#define PG8_STAGE(bufoff, gbase, voff) do { _Pragma("unroll") for (int _i = 0; _i < 2; ++_i) \
        __builtin_amdgcn_global_load_lds((const unsigned*)((const char*)(gbase) + (voff)[_i]), (PG8_LAS unsigned*)(lds + (bufoff) + ldsw + _i * 8192), 16, 0, 0); } while (0)
#define PG8_LDA(dst, b, h) do { _Pragma("unroll") for (int m = 0; m < 4; ++m) _Pragma("unroll") for (int k = 0; k < 2; ++k) dst[m][k] = *(const PG8_LAS bf16x8*)(lds + PG8_SA(b, h) + aoff + m * 2048 + k * 1024); } while (0)
#define PG8_LDB(dst, b, h) do { _Pragma("unroll") for (int n = 0; n < 2; ++n) _Pragma("unroll") for (int k = 0; k < 2; ++k) dst[n][k] = *(const PG8_LAS bf16x8*)(lds + PG8_SB(b, h) + boff + n * 2048 + k * 1024); } while (0)
#define PG8_MMA(ai, bj, At, Bt) do { __builtin_amdgcn_s_setprio(1); _Pragma("unroll") for (int m = 0; m < 4; ++m) _Pragma("unroll") for (int n = 0; n < 2; ++n) _Pragma("unroll") for (int k = 0; k < 2; ++k) \
        acc[ai][bj][m][n] = mma16<F16>(Bt[n][k], At[m][k], acc[ai][bj][m][n]); __builtin_amdgcn_s_setprio(0); } while (0)
#define PG8_WAIT_V(n) asm volatile("s_waitcnt vmcnt(" #n ")" ::: "memory")
#define PG8_WAIT_L(n) asm volatile("s_waitcnt lgkmcnt(" #n ")" ::: "memory")
#define PG8_BAR __builtin_amdgcn_s_barrier()
#define PG8_SCHED __builtin_amdgcn_sched_barrier(0)
    Unit cur, nxt; int ui = 0;
    if (!S.next(0, cur)) return;
    f32x4 acc[2][2][4][2];
#pragma unroll
    for (int a = 0; a < 2; ++a)
#pragma unroll
        for (int b = 0; b < 2; ++b)
#pragma unroll
            for (int m = 0; m < 4; ++m)
#pragma unroll
                for (int n = 0; n < 2; ++n) acc[a][b][m][n] = (f32x4){0.f, 0.f, 0.f, 0.f};
    bf16x8 At[4][2], B0[2][2], B1[2][2];
    const char* cA = (const char*)g.A + (size_t)cur.pm * tstepA; const char* cB = (const char*)g.Bt + (size_t)cur.pn * tstepB;
    S.a_ready(cur);
    if constexpr (SP2) {
        PG8_STAGE(PG8_SB(0, 0), cB, voffB); PG8_STAGE(PG8_SB(0, 1), cB + hstepB, voffB); PG8_STAGE(PG8_SA(0, 0), cA, voffA); PG8_STAGE(PG8_SA(0, 1), cA + hstepA, voffA);
        if (wr == 1) PG8_BAR;
        PG8_WAIT_V(2); PG8_BAR;
        PG8_STAGE(PG8_SB(1, 0), cB + kstep, voffB); PG8_STAGE(PG8_SA(1, 0), cA + kstep, voffA); PG8_STAGE(PG8_SB(1, 1), cB + hstepB + kstep, voffB);
        PG8_WAIT_V(6); PG8_BAR;
    } else {
        PG8_STAGE(PG8_SB(0, 0), cB, voffB); PG8_STAGE(PG8_SA(0, 0), cA, voffA); PG8_STAGE(PG8_SB(0, 1), cB + hstepB, voffB); PG8_STAGE(PG8_SA(0, 1), cA + hstepA, voffA);
        if (wr == 1) PG8_BAR;
        PG8_WAIT_V(4); PG8_BAR;
        PG8_STAGE(PG8_SB(1, 0), cB + kstep, voffB); PG8_STAGE(PG8_SA(1, 0), cA + kstep, voffA); PG8_STAGE(PG8_SB(1, 1), cB + hstepB + kstep, voffB);
        PG8_WAIT_V(6); PG8_BAR;
    }
    for (;;) {
        const bool has_next = S.next(ui + 1, nxt);
        const char* nA = has_next ? (const char*)g.A + (size_t)nxt.pm * tstepA : cA; const char* nB = has_next ? (const char*)g.Bt + (size_t)nxt.pn * tstepB : cB;
#pragma nounroll
        for (int t = 0; t < nt; t += 2) {
            const bool last = (t == nt - 2);
            const char* a1 = cA + (size_t)(t + 1) * kstep;
            const char* a2 = last ? nA : cA + (size_t)(t + 2) * kstep; const char* b2 = last ? nB : cB + (size_t)(t + 2) * kstep;
            const char* a3 = a2 + kstep; const char* b3 = b2 + kstep;
            if (last && has_next) S.a_ready(nxt);
            if constexpr (SP2) {
            PG8_LDB(B0, 0, 0); PG8_LDB(B1, 0, 1); PG8_SCHED; PG8_LDA(At, 0, 0); PG8_STAGE(PG8_SA(1, 1), a1 + hstepA, voffA);
            PG8_WAIT_V(8); PG8_WAIT_L(0); PG8_BAR; PG8_MMA(0, 0, At, B0); PG8_MMA(0, 1, At, B1); PG8_BAR; PG8_SCHED;
            PG8_LDA(At, 0, 1); PG8_STAGE(PG8_SB(0, 0), b2, voffB); PG8_STAGE(PG8_SB(0, 1), b2 + hstepB, voffB); PG8_STAGE(PG8_SA(0, 0), a2, voffA);
            PG8_WAIT_V(8); PG8_WAIT_L(0); PG8_BAR; PG8_MMA(1, 0, At, B0); PG8_MMA(1, 1, At, B1); PG8_BAR; PG8_SCHED;
            PG8_LDB(B0, 1, 0); PG8_LDB(B1, 1, 1); PG8_SCHED; PG8_LDA(At, 1, 0); PG8_STAGE(PG8_SA(0, 1), a2 + hstepA, voffA);
            PG8_WAIT_V(8); PG8_WAIT_L(0); PG8_BAR; PG8_MMA(0, 0, At, B0); PG8_MMA(0, 1, At, B1); PG8_BAR; PG8_SCHED;
            PG8_LDA(At, 1, 1); PG8_STAGE(PG8_SB(1, 0), b3, voffB); PG8_STAGE(PG8_SB(1, 1), b3 + hstepB, voffB); PG8_STAGE(PG8_SA(1, 0), a3, voffA);
            PG8_WAIT_V(8); PG8_WAIT_L(0); PG8_BAR; PG8_MMA(1, 0, At, B0); PG8_MMA(1, 1, At, B1); PG8_BAR; PG8_SCHED;
            } else {
            PG8_LDB(B0, 0, 0); PG8_SCHED; PG8_LDA(At, 0, 0); PG8_STAGE(PG8_SA(1, 1), a1 + hstepA, voffA);
            PG8_WAIT_L(8); PG8_BAR; PG8_WAIT_L(0); PG8_MMA(0, 0, At, B0); PG8_BAR; PG8_SCHED;
            PG8_LDB(B1, 0, 1); PG8_STAGE(PG8_SB(0, 0), b2, voffB);
            PG8_BAR; PG8_WAIT_L(0); PG8_MMA(0, 1, At, B1); PG8_BAR;
            PG8_LDA(At, 0, 1); PG8_STAGE(PG8_SA(0, 0), a2, voffA);
            PG8_BAR; PG8_WAIT_L(0); PG8_MMA(1, 0, At, B0); PG8_BAR; PG8_SCHED;
            PG8_STAGE(PG8_SB(0, 1), b2 + hstepB, voffB);
            PG8_WAIT_V(6); PG8_BAR; PG8_MMA(1, 1, At, B1); PG8_BAR;
            PG8_LDB(B0, 1, 0); PG8_SCHED; PG8_LDA(At, 1, 0); PG8_STAGE(PG8_SA(0, 1), a2 + hstepA, voffA);
            PG8_WAIT_L(8); PG8_BAR; PG8_WAIT_L(0); PG8_MMA(0, 0, At, B0); PG8_BAR; PG8_SCHED;
            PG8_LDB(B1, 1, 1); PG8_STAGE(PG8_SB(1, 0), b3, voffB);
            PG8_BAR; PG8_WAIT_L(0); PG8_MMA(0, 1, At, B1); PG8_BAR;
            PG8_LDA(At, 1, 1); PG8_STAGE(PG8_SA(1, 0), a3, voffA);
            PG8_BAR; PG8_WAIT_L(0); PG8_MMA(1, 0, At, B0); PG8_BAR; PG8_SCHED;
            PG8_STAGE(PG8_SB(1, 1), b3 + hstepB, voffB);
            PG8_WAIT_V(6); PG8_BAR; PG8_MMA(1, 1, At, B1); PG8_BAR;
            }
        }
        if constexpr (ALIGN_EPI) { if (wr == 0) PG8_BAR; }
        if constexpr (!Epi::AFTER_DRAIN) { E(acc, cur, wr, wc, fr, fq); S.done(cur); }
        if (!has_next) break;
#pragma unroll
        for (int a = 0; a < 2; ++a)
#pragma unroll
            for (int b = 0; b < 2; ++b)
#pragma unroll
                for (int m = 0; m < 4; ++m)
#pragma unroll
                    for (int n = 0; n < 2; ++n) acc[a][b][m][n] = (f32x4){0.f, 0.f, 0.f, 0.f};
        cur = nxt; cA = nA; cB = nB; ++ui;
        if constexpr (ALIGN_EPI) { if (wr == 1) PG8_BAR; }
    }
    PG8_WAIT_V(0);
    if constexpr (!ALIGN_EPI) { if (wr == 0) PG8_BAR; }
    PG8_BAR;
    if constexpr (Epi::AFTER_DRAIN) { E.fused(acc, cur, wr, wc, fr, fq, lds, wid, lane); S.done(cur); }
#undef PG8_SA
#undef PG8_SB
#undef PG8_STAGE
#undef PG8_LDA
#undef PG8_LDB
#undef PG8_MMA
#undef PG8_WAIT_V
#undef PG8_WAIT_L
#undef PG8_BAR
#undef PG8_SCHED
}
}
constexpr int NWAVES = 8;
#ifndef MK_N_LAUNCHES
#define MK_N_LAUNCHES 1
#endif
constexpr int N_PHASES = 13;
constexpr int N_LAUNCHES = MK_N_LAUNCHES;
constexpr int BATCH = 16, SEQ = 2048, DM = 1024, M = BATCH * SEQ, FF = 4096;
constexpr int A_IN = 2120, A_INP = 2304, B_IN = 672, B_INP = 768, QUP = 1536, KVUP = 2048, QLORA = 384, KVLORA = 256;
constexpr size_t MiB = 1u << 20;
constexpr size_t WS_CTL = 0, CTL_ZERO_BYTES = 64 * 1024;
constexpr size_t WS_WAIN = 1 * MiB, WS_WAOUT = 6 * MiB, WS_WUP0 = 8 * MiB, WS_WUP1 = 16 * MiB, WS_WDN0 = 24 * MiB, WS_WDN1 = 32 * MiB;
constexpr size_t WS_WBIN = 40 * MiB, WS_WQUP = 42 * MiB, WS_WKVUP = 44 * MiB, WS_WBOUT = 46 * MiB;
constexpr size_t WS_COSA = 48 * MiB, WS_SINA = 49 * MiB, WS_COSB = 50 * MiB, WS_SINB = 52 * MiB;
constexpr size_t WS_SS = 54 * MiB, WS_SSB = 56 * MiB, WS_WI = 59 * MiB;
constexpr size_t WS_XB = 64 * MiB;
constexpr size_t WS_BIG = 128 * MiB;
constexpr size_t WS_PA = WS_BIG, WS_OA = WS_BIG + 144 * MiB;
constexpr size_t WS_H = WS_BIG;
constexpr size_t WS_CB = WS_BIG, WS_QB = WS_BIG + 48 * MiB, WS_OB = WS_BIG + 144 * MiB;
constexpr size_t WS_KVB = 384 * MiB, WS_END = 512 * MiB;
static_assert(WS_WAIN + (size_t)A_INP * DM * 2 <= WS_WAOUT && WS_WBIN + (size_t)B_INP * DM * 2 <= WS_WQUP && WS_WQUP + (size_t)QUP * QLORA * 2 <= WS_WKVUP && WS_WKVUP + (size_t)KVUP * KVLORA * 2 <= WS_WBOUT, "weights map");
static_assert(WS_SSB + (size_t)M * 24 * 4 <= WS_WI && WS_WI + (size_t)M * 8 * 4 <= WS_XB && WS_PA + (size_t)M * A_INP * 2 <= WS_OA && WS_OA + (size_t)M * DM * 2 <= WS_KVB && WS_QB + (size_t)M * QUP * 2 <= WS_OB, "activation map");
constexpr int CW_BAR = 1024;
constexpr int RING_BYTES = 131072, LDSCTL_OFF = RING_BYTES, MISC_OFF = LDSCTL_OFF + 320, LDS_BYTES = 147456;
constexpr float IDX_WSCALE = 0.044194173824159216f;
constexpr float QSCALE_A = 0.125f * 1.4426950408889634f;
constexpr float QSCALE_B = 0.10206207261596577f * 1.4426950408889634f;

#define GAS __attribute__((address_space(1)))
#define LAS __attribute__((address_space(3)))
typedef unsigned short bf16;
typedef unsigned v4u __attribute__((ext_vector_type(4)));
typedef float f32x4 __attribute__((ext_vector_type(4)));
typedef short bf16x8 __attribute__((ext_vector_type(8)));
typedef GAS unsigned gu32;
typedef GAS unsigned long long gu64;
#define RLX_AGENT __ATOMIC_RELAXED, __HIP_MEMORY_SCOPE_AGENT
#define LDS_WAIT() asm volatile("s_waitcnt lgkmcnt(0)" ::: "memory")
#define VM_WAIT() asm volatile("s_waitcnt vmcnt(0)" ::: "memory")
__device__ __forceinline__ unsigned long long rt() { return __builtin_amdgcn_s_memrealtime(); }
__device__ __forceinline__ unsigned f2bf(float f) { unsigned u = __builtin_bit_cast(unsigned, f); return (u + 0x7fffu + ((u >> 16) & 1u)) >> 16; }
__device__ __forceinline__ unsigned pk2(float lo, float hi) { return f2bf(lo) | (f2bf(hi) << 16); }

#define XB_TMO      128
#define XB_XCNT(j)  (256  + 64 * (j))
#define XB_XSUB(j)  (1280 + 64 * (j))
#define XB_XGEN(j)  (2304 + 64 * (j))
#define XB_TOP      3328
#define XB_TOPGEN   3392
#define XCD_BAR_WORDS 3456
#define XB_SPIN_CAP (1u << 18)

__device__ __forceinline__ unsigned xb_ld(unsigned* p)              { return __hip_atomic_load(p, __ATOMIC_RELAXED, __HIP_MEMORY_SCOPE_AGENT); }
__device__ __forceinline__ unsigned xb_add(unsigned* p, unsigned v) { return __hip_atomic_fetch_add(p, v, __ATOMIC_RELAXED, __HIP_MEMORY_SCOPE_AGENT); }
__device__ __forceinline__ unsigned xb_xcc_id() { return (unsigned)__builtin_amdgcn_s_getreg((3 << 11) | 20) & 0xFu; }
#define XB_SPIN(cond, bar) do { unsigned _sp = 0; while (cond) { __builtin_amdgcn_s_sleep(1); \
    if ((++_sp & 255u) == 0u) { if (xb_ld(&(bar)[XB_TMO])) break; if (_sp > XB_SPIN_CAP) { atomicAdd(&(bar)[XB_TMO], 1u); break; } } } } while (0)

struct XcdBarrier {
    unsigned* bar; unsigned x;
    volatile LAS unsigned* st;
};

__device__ __forceinline__ XcdBarrier xcd_barrier_post(unsigned* bar, volatile LAS unsigned* st) {
    XcdBarrier b; b.bar = bar; b.x = xb_xcc_id(); b.st = st;
    if (threadIdx.x == 0) (void)xb_add(&bar[XB_XCNT(b.x)], 1u);
    return b;
}
__device__ __forceinline__ void xcd_barrier_complete(unsigned* bar, unsigned x, unsigned& nloc, unsigned& nx) {
    const unsigned G = gridDim.x * gridDim.y * gridDim.z;
    unsigned sum, cnt, mine, sp = 0u;
    for (;;) {
        sum = 0u; cnt = 0u; mine = 0u;
#pragma unroll
        for (unsigned j = 0; j < 16; ++j) { const unsigned c = xb_ld(&bar[XB_XCNT(j)]); sum += c; cnt += (c > 0u) ? 1u : 0u; mine = (j == x) ? c : mine; }
        if (sum == G) break;
        __builtin_amdgcn_s_sleep(1);
        if ((++sp & 255u) == 0u) { if (xb_ld(&bar[XB_TMO])) break; if (sp > XB_SPIN_CAP) { atomicAdd(&bar[XB_TMO], 1u); break; } }
    }
    nloc = mine > 0u ? mine : 1u; nx = cnt > 0u ? cnt : 1u;
}

__device__ __forceinline__ void xcd_barrier(const XcdBarrier& b) {
    asm volatile("s_waitcnt vmcnt(0)" ::: "memory");
    __syncthreads();
    if (threadIdx.x == 0) {
        unsigned* bar = b.bar;
        __builtin_amdgcn_s_waitcnt(0);
        unsigned nloc = b.st[0], nx = b.st[1];
        if (nloc == 0u) { xcd_barrier_complete(bar, b.x, nloc, nx); b.st[0] = nloc; b.st[1] = nx; }
        const unsigned old = xb_add(&bar[XB_XSUB(b.x)], 1u);
        const unsigned gen = old / nloc;
        if (old + 1u == (gen + 1u) * nloc) {
            __builtin_amdgcn_fence(__ATOMIC_RELEASE, "agent");
            asm volatile("s_waitcnt vmcnt(0)" ::: "memory");
            const unsigned og = xb_add(&bar[XB_TOP], 1u);
            const unsigned tg = og / nx;
            if (og + 1u == (tg + 1u) * nx) xb_add(&bar[XB_TOPGEN], 1u);
            else XB_SPIN(xb_ld(&bar[XB_TOPGEN]) == tg, bar);
            __builtin_amdgcn_fence(__ATOMIC_ACQUIRE, "agent");
            xb_add(&bar[XB_XGEN(b.x)], 1u);
            asm volatile("s_waitcnt vmcnt(0)" ::: "memory");
        } else {
            XB_SPIN(xb_ld(&bar[XB_XGEN(b.x)]) == gen, bar);
            __builtin_amdgcn_fence(__ATOMIC_ACQUIRE, "agent");
            asm volatile("s_waitcnt vmcnt(0)" ::: "memory");
        }
    }
    __syncthreads();
}
using pg8::u32x4; using pg8::u32x2;
struct Frame {
    LAS unsigned char* lds;
    volatile LAS unsigned* MISC;
    gu32* ctl;
    int tid, lane, wave, G;
};
__device__ __forceinline__ float wave_sum(float v) {
#pragma unroll
    for (int o = 1; o < 64; o <<= 1) v += __shfl_xor(v, o);
    return v;
}
typedef _Float16 half_t;
__device__ __forceinline__ unsigned short f2h(float f) { half_t h = (half_t)f; return __builtin_bit_cast(unsigned short, h); }
__device__ __forceinline__ float h2f(unsigned short u) { return (float)__builtin_bit_cast(half_t, u); }
__device__ __forceinline__ float bf2f(unsigned short u) { return __builtin_bit_cast(float, (unsigned)u << 16); }

template <bool F16>
__device__ __forceinline__ void p0_transpose_item(const float* W, int K, int N, const float* gain, bf16* WT, LAS float* scr, int item, int lane) {
    const int nblk = (N + 31) / 32, kb = item / nblk, nb = item % nblk, k0 = 64 * kb, n0 = 32 * nb;
#pragma unroll 8
    for (int i = 0; i < 32; ++i) { const int kk = 2 * i + (lane >> 5); const int n = n0 + (lane & 31);
        float v = (n < N) ? W[(size_t)(k0 + kk) * N + n] : 0.f; if (gain) v *= gain[k0 + kk]; scr[kk * 33 + (lane & 31)] = v; }
    LDS_WAIT(); asm volatile("" ::: "memory");
    const int c = lane & 7;
#pragma unroll
    for (int j = 0; j < 4; ++j) { const int n = (lane >> 3) + 8 * j; const LAS float* s = scr + (8 * c) * 33 + n;
        v4u o;
        if (F16) { o.x = (unsigned)f2h(s[0 * 33]) | ((unsigned)f2h(s[1 * 33]) << 16); o.y = (unsigned)f2h(s[2 * 33]) | ((unsigned)f2h(s[3 * 33]) << 16);
                   o.z = (unsigned)f2h(s[4 * 33]) | ((unsigned)f2h(s[5 * 33]) << 16); o.w = (unsigned)f2h(s[6 * 33]) | ((unsigned)f2h(s[7 * 33]) << 16); }
        else { o.x = pk2(s[0 * 33], s[1 * 33]); o.y = pk2(s[2 * 33], s[3 * 33]); o.z = pk2(s[4 * 33], s[5 * 33]); o.w = pk2(s[6 * 33], s[7 * 33]); }
        *(GAS v4u*)(WT + (size_t)(n0 + n) * K + k0 + 8 * c) = o; }
    LDS_WAIT(); asm volatile("" ::: "memory");
}
struct Args { const void* in[15]; float* out; unsigned char* ws; float inv_a[8]; float inv_b[16]; int ph_lo, ph_hi; };

__device__ __forceinline__ void p0_prologue(Frame& F, const Args& A) {
    unsigned char* ws = A.ws;
    LAS float* scr = (LAS float*)(F.lds + F.wave * 16384);
    const int gw = blockIdx.x * NWAVES + F.wave, NGW = F.G * NWAVES, lane = F.lane;
    const float* attn_norm = (const float*)A.in[2]; const float* mlp_norm = (const float*)A.in[3];
    constexpr int I_AIN = 16 * 67, I_AOUT = 16 * 32, I_UP = 16 * 128, I_DN = 64 * 32, I_BIN = 16 * 21, I_QUP = 6 * 48, I_KVUP = 4 * 64, I_BOUT = 16 * 32;
    constexpr int NITEMS = I_AIN + I_AOUT + 2 * I_UP + 2 * I_DN + I_BIN + I_QUP + I_KVUP + I_BOUT;
    for (int it = gw; it < NITEMS; it += NGW) {
        int r = it;
        if (r < I_AIN) { p0_transpose_item<true>((const float*)A.in[4], 1024, A_IN, attn_norm, (bf16*)(ws + WS_WAIN), scr, r, lane); continue; } r -= I_AIN;
        if (r < I_AOUT) { p0_transpose_item<false>((const float*)A.in[5], 1024, 1024, nullptr, (bf16*)(ws + WS_WAOUT), scr, r, lane); continue; } r -= I_AOUT;
        if (r < I_UP) { p0_transpose_item<false>((const float*)A.in[12], 1024, 4096, mlp_norm, (bf16*)(ws + WS_WUP0), scr, r, lane); continue; } r -= I_UP;
        if (r < I_UP) { p0_transpose_item<false>((const float*)A.in[12] + (size_t)1024 * 4096, 1024, 4096, mlp_norm + 1024, (bf16*)(ws + WS_WUP1), scr, r, lane); continue; } r -= I_UP;
        if (r < I_DN) { p0_transpose_item<false>((const float*)A.in[13], 4096, 1024, nullptr, (bf16*)(ws + WS_WDN0), scr, r, lane); continue; } r -= I_DN;
        if (r < I_DN) { p0_transpose_item<false>((const float*)A.in[13] + (size_t)4096 * 1024, 4096, 1024, nullptr, (bf16*)(ws + WS_WDN1), scr, r, lane); continue; } r -= I_DN;
        if (r < I_BIN) { p0_transpose_item<false>((const float*)A.in[6], 1024, B_IN, attn_norm + 1024, (bf16*)(ws + WS_WBIN), scr, r, lane); continue; } r -= I_BIN;
        if (r < I_QUP) { p0_transpose_item<false>((const float*)A.in[9], QLORA, QUP, (const float*)A.in[7], (bf16*)(ws + WS_WQUP), scr, r, lane); continue; } r -= I_QUP;
        if (r < I_KVUP) { p0_transpose_item<false>((const float*)A.in[10], KVLORA, KVUP, (const float*)A.in[8], (bf16*)(ws + WS_WKVUP), scr, r, lane); continue; } r -= I_KVUP;
        p0_transpose_item<false>((const float*)A.in[11], 1024, 1024, nullptr, (bf16*)(ws + WS_WBOUT), scr, r, lane);
    }
    {   const int gt = gw * 64 + lane, NT = NGW * 64;
        GAS v4u* z1 = (GAS v4u*)(ws + WS_WAIN + (size_t)2144 * 1024 * 2); const int n1 = (A_INP - 2144) * 1024 * 2 / 16;
        for (int i = gt; i < n1; i += NT) z1[i] = (v4u){0u, 0u, 0u, 0u};
        GAS v4u* z2 = (GAS v4u*)(ws + WS_WBIN + (size_t)B_IN * 1024 * 2); const int n2 = (B_INP - B_IN) * 1024 * 2 / 16;
        for (int i = gt; i < n2; i += NT) z2[i] = (v4u){0u, 0u, 0u, 0u};
        const int* pos = (const int*)A.in[1];
        float* cA = (float*)(ws + WS_COSA); float* sA = (float*)(ws + WS_SINA); float* cB = (float*)(ws + WS_COSB); float* sB = (float*)(ws + WS_SINB);
        for (int i = gt; i < M * 8; i += NT) { const float ang = (float)pos[i >> 3] * A.inv_a[i & 7]; double rev = (double)ang * 0.15915494309189535; rev -= __builtin_rint(rev); const float fr = (float)rev;
            cA[i] = __builtin_amdgcn_cosf(fr); sA[i] = __builtin_amdgcn_sinf(fr); }
        for (int i = gt; i < M * 16; i += NT) { const float ang = (float)pos[i >> 4] * A.inv_b[i & 15]; double rev = (double)ang * 0.15915494309189535; rev -= __builtin_rint(rev); const float fr = (float)rev;
            cB[i] = __builtin_amdgcn_cosf(fr); sB[i] = __builtin_amdgcn_sinf(fr); }
    }
    const float* x = (const float*)A.in[0]; bf16* XB = (bf16*)(ws + WS_XB); float* SS = (float*)(ws + WS_SS);
    for (int m = gw; m < M; m += NGW) {
        const GAS f32x4* xr = (const GAS f32x4*)(x + (size_t)m * DM) + lane; f32x4 v[4]; float s = 0.f;
#pragma unroll
        for (int j = 0; j < 4; ++j) { v[j] = xr[64 * j]; s += (v[j].x * v[j].x + v[j].y * v[j].y) + (v[j].z * v[j].z + v[j].w * v[j].w); }
        s = wave_sum(s);
        GAS unsigned long long* o8 = (GAS unsigned long long*)(XB + (size_t)m * DM) + lane;
#pragma unroll
        for (int j = 0; j < 4; ++j) o8[64 * j] = (unsigned long long)((unsigned)f2h(v[j].x) | ((unsigned)f2h(v[j].y) << 16)) | ((unsigned long long)((unsigned)f2h(v[j].z) | ((unsigned)f2h(v[j].w) << 16)) << 32);
        if (lane < 16) SS[(size_t)m * 16 + lane] = (lane == 0) ? s : 0.f;
    }
}
__device__ __forceinline__ void p12_final_norm(Frame& F, const Args& A) {
    const int gw = blockIdx.x * NWAVES + F.wave, NGW = F.G * NWAVES, lane = F.lane;
    const float* g = (const float*)A.in[14]; const float* SS = (const float*)(A.ws + WS_SS);
    f32x4 gv[4];
#pragma unroll
    for (int j = 0; j < 4; ++j) gv[j] = ((const GAS f32x4*)g)[lane + 64 * j];
    for (int m = gw; m < M; m += NGW) {
        const float rs = pg8::rstd_from(SS + (size_t)m * 16, 4, 1.0f / 1024.0f);
        GAS f32x4* xr = (GAS f32x4*)(A.out + (size_t)m * DM) + lane;
#pragma unroll
        for (int j = 0; j < 4; ++j) { f32x4 v = xr[64 * j]; xr[64 * j] = v * rs * gv[j]; }
    }
}
namespace dsa {
typedef float f32x16 __attribute__((ext_vector_type(16)));
typedef _Float16 f16x8 __attribute__((ext_vector_type(8)));
typedef short s16x4 __attribute__((ext_vector_type(4)));
constexpr int KP = 144;
constexpr int MP = 65;
constexpr int LDS_MASK = 0, LDS_KV = 16896, KBYTES = 64 * KP, KVBUF = KBYTES + 8192, LDS_KI = LDS_KV, KIBUF = 256 * KP;
static_assert(64 * MP * 4 <= LDS_KV && LDS_KV + 2 * KVBUF <= RING_BYTES && LDS_KI + 2 * KIBUF <= RING_BYTES, "dsa LDS map");
__device__ __forceinline__ unsigned sortable(float f) { const unsigned u = __builtin_bit_cast(unsigned, f); return (u & 0x80000000u) ? ~u : (u | 0x80000000u); }
__device__ __forceinline__ float xmax32(float m) { auto rr = __builtin_amdgcn_permlane32_swap(__float_as_uint(m), __float_as_uint(m), false, false); return fmaxf(__uint_as_float(rr[0]), __uint_as_float(rr[1])); }
__device__ __forceinline__ unsigned half_sum(unsigned v) {
#pragma unroll
    for (int o = 16; o >= 1; o >>= 1) v += (unsigned)__shfl_xor((int)v, o);
    return v;
}
__device__ __forceinline__ void index_select(LAS unsigned char* lds, LAS unsigned* maskQ, const bf16* PA, const float* WI, size_t row0, int qp0, int mp0, int tq, int nkt, int tid, int wid, int lane) {
    const int r32 = lane & 31, hh = lane >> 5;
    const int q0 = qp0 + 4 * wid, mrow0 = mp0 + 4 * wid;
    const int a_ = r32 & 3, hic = (r32 >> 2) & 1, bq = r32 >> 3; const int headA = a_ + 4 * (bq & 1), tlocA = 2 * hic + (bq >> 1);
    const bf16* ap = PA + (row0 + q0 + tlocA) * A_INP + 1536 + headA * 64 + 8 * hh;
    f16x8 qa[4];
#pragma unroll
    for (int ks = 0; ks < 4; ++ks) qa[ks] = *(const f16x8*)(ap + 16 * ks);
    float w[8];
    { const float* wq = WI + (row0 + q0 + 2 * hh + tq) * 8; const f32x4 wa = *(const f32x4*)wq, wb = *(const f32x4*)(wq + 4);
      w[0] = wa[0]; w[1] = wa[1]; w[2] = wa[2]; w[3] = wa[3]; w[4] = wb[0]; w[5] = wb[1]; w[6] = wb[2]; w[7] = wb[3]; }
    const int nch = (nkt + 7) >> 3;
    const int skey = tid >> 3, sc8 = tid & 7;
    const bf16* spc = PA + (row0 + skey) * A_INP + 2048 + sc8 * 8;
    v4u st[4];
#pragma unroll
    for (int i = 0; i < 4; ++i) st[i] = *(const v4u*)(spc + (size_t)(64 * i) * A_INP);
    LAS unsigned char* const stw = lds + LDS_KI + skey * KP + sc8 * 16;
    const LAS unsigned char* const krd = lds + LDS_KI + r32 * KP + hh * 16;
    unsigned sc[64];
    __syncthreads();
#pragma unroll
    for (int ch = 0; ch < 8; ++ch) {
        if (ch < nch) {
#pragma unroll
            for (int i = 0; i < 4; ++i) *(LAS v4u*)(stw + (ch & 1) * KIBUF + 64 * i * KP) = st[i];
            if (ch + 1 < nch) {
                spc += (size_t)256 * A_INP; asm volatile("" : "+v"(spc));
#pragma unroll
                for (int i = 0; i < 4; ++i) st[i] = *(const v4u*)(spc + (size_t)(64 * i) * A_INP); }
            __syncthreads();
#pragma unroll
            for (int k = 0; k < 8; ++k) {
                const int kt = 8 * ch + k;
                if (kt < nkt) {
                    const LAS unsigned char* kq = krd + (ch & 1) * KIBUF + 32 * k * KP;
                    f32x16 c = {};
#pragma unroll
                    for (int ks = 0; ks < 4; ++ks) c = __builtin_amdgcn_mfma_f32_32x32x16_f16(qa[ks], *(const LAS f16x8*)(kq + 32 * ks), c, 0, 0, 0);
                    float acc = 0.f;
                    if (tq == 0) {
#pragma unroll
                        for (int hd = 0; hd < 8; ++hd) acc = fmaf(w[hd], fmaxf(c[hd], 0.f), acc);
                    } else {
#pragma unroll
                        for (int hd = 0; hd < 8; ++hd) acc = fmaf(w[hd], fmaxf(c[hd + 8], 0.f), acc);
                    }
                    unsigned key = sortable(acc); asm volatile("" : "+v"(key)); sc[kt] = key;
                } else { sc[kt] = 0u; }
                __builtin_amdgcn_sched_barrier(0);
            }
        } else {
#pragma unroll
            for (int k = 0; k < 8; ++k) sc[8 * ch + k] = 0u;
        }
    }
    unsigned pre = 0u, cge = (unsigned)nkt * 32u; bool done = false;
    for (int bit = 31; bit >= 0; --bit) {
        const unsigned cand = pre | (1u << bit);
        unsigned cnt = 0u;
#pragma unroll
        for (int blk = 0; blk < 8; ++blk) if (nkt > 8 * blk) {
#pragma unroll
            for (int k = 0; k < 8; ++k) cnt += (sc[8 * blk + k] >= cand) ? 1u : 0u; }
        cnt = half_sum(cnt);
        if (!done && cnt >= 256u) { pre = cand; cge = cnt; done = (cnt == 256u); }
        if (__all(done)) break;
    }
    int ktc = 64; bool le = true;
    if (__any(cge > 256u)) {
        unsigned cnt = 0u;
#pragma unroll
        for (int kt = 0; kt < 64; ++kt) cnt += (sc[kt] > pre) ? 1u : 0u;
        cnt = half_sum(cnt);
        const int need = 256 - (int)cnt;
        int run = 0;
#pragma unroll
        for (int kt = 0; kt < 64; ++kt) {
            const unsigned long long b0 = __ballot(sc[kt] == pre);
            unsigned h0 = hh ? (unsigned)(b0 >> 32) : (unsigned)b0;
            const int n0 = __popc(h0);
            if (cge > 256u && run < need && run + n0 >= need) { for (int i = run + 1; i < need; ++i) h0 &= h0 - 1u; ktc = kt; le = r32 <= (__ffs((int)h0) - 1); }
            run += n0;
        }
    }
    LAS unsigned* const mq = maskQ + (mrow0 + tq) * MP;
#pragma unroll
    for (int kt = 0; kt < 64; ++kt) {
        if (kt < nkt) {
            const bool e0 = (kt < ktc) || (kt == ktc && le);
            const unsigned long long b0 = __ballot(sc[kt] > pre || (sc[kt] == pre && e0));
            if (lane == 0) { mq[kt] = (unsigned)b0; mq[2 * MP + kt] = (unsigned)(b0 >> 32); }
        }
    }
}
__device__ __forceinline__ void unit(LAS unsigned char* lds, const bf16* PA, const float* WI, bf16* OA, int b, int qblk) {
    const int tid = threadIdx.x, lane = tid & 63, r32 = lane & 31, hh = lane >> 5; const int wid = __builtin_amdgcn_readfirstlane(tid >> 6);
    const size_t row0 = (size_t)b * SEQ;
    const int nkt = 2 * (qblk + 1), nk64 = qblk + 1;
    LAS unsigned* maskQ = (LAS unsigned*)(lds + LDS_MASK);
    __syncthreads();
    if (qblk < 4) { for (int i = tid; i < 64 * MP; i += 512) maskQ[i] = 0xFFFFFFFFu; }
    else {
#pragma unroll 1
        for (int p = 0; p < 4; ++p) index_select(lds, maskQ, PA, WI, row0, qblk * 64 + 32 * (p >> 1), 32 * (p >> 1), p & 1, nkt, tid, wid, lane);
    }
    const int qh = wid & 1, hr = wid >> 1;
    const int qrow = qblk * 64 + 32 * qh + r32;
    const unsigned vb = (unsigned)(uintptr_t)(lds + LDS_KV + KBYTES) + ((lane >> 4) & 1) * 32 + (lane & 3) * 8 + (4 * hh + ((lane & 15) >> 2)) * 64;
    const int skey = tid >> 3, sc8 = tid & 7;
    const unsigned kdst = LDS_KV + skey * KP + sc8 * 16, vdst = LDS_KV + KBYTES + (sc8 >> 2) * 4096 + (skey >> 3) * 512 + (skey & 7) * 64 + (sc8 & 3) * 16;
    const LAS unsigned* mrow = maskQ + (32 * qh + r32) * MP;
#pragma unroll 1
    for (int g = 0; g < 4; ++g) {
        const int hq = 4 * g + hr;
        const bf16* qp = PA + (row0 + qrow) * A_INP + hq * 64 + 8 * hh;
        f16x8 qf[4];
#pragma unroll
        for (int ks = 0; ks < 4; ++ks) qf[ks] = *(const f16x8*)(qp + 16 * ks);
        const bf16* kg = PA + (row0 + skey) * A_INP + 1024 + g * 64 + sc8 * 8;
        v4u kreg = *(const v4u*)kg, vreg = *(const v4u*)(kg + 256);
        f32x16 o0 = {}, o1 = {}; float mrun = -INFINITY, lrun = 0.f;
        __syncthreads();
#pragma unroll 1
        for (int kt = 0; kt < nk64; ++kt) {
            const unsigned bo = (kt & 1) * KVBUF;
            *(LAS v4u*)(lds + kdst + bo) = kreg; *(LAS v4u*)(lds + vdst + bo) = vreg;
            if (kt + 1 < nk64) { const bf16* kn = kg + (size_t)(kt + 1) * 64 * A_INP; kreg = *(const v4u*)kn; vreg = *(const v4u*)(kn + 256); }
            __syncthreads();
            const LAS unsigned char* kb = lds + LDS_KV + bo;
            f32x16 p0 = {}, p1 = {};
#pragma unroll
            for (int ks = 0; ks < 4; ++ks) {
                const f16x8 k0 = *(const LAS f16x8*)(kb + r32 * KP + ks * 32 + hh * 16);
                const f16x8 k1 = *(const LAS f16x8*)(kb + (32 + r32) * KP + ks * 32 + hh * 16);
                p0 = __builtin_amdgcn_mfma_f32_32x32x16_f16(k0, qf[ks], p0, 0, 0, 0);
                p1 = __builtin_amdgcn_mfma_f32_32x32x16_f16(k1, qf[ks], p1, 0, 0, 0);
            }
            const int w0 = (int)(mrow[2 * kt] >> (4 * hh)), w1 = (int)(mrow[2 * kt + 1] >> (4 * hh));
            float mx = fmaxf(p0[0], p1[0]);
#pragma unroll
            for (int r = 1; r < 16; ++r) mx = fmaxf(mx, fmaxf(p0[r], p1[r]));
            mx = xmax32(mx);
            const float mn = fmaxf(mrun, mx);
            if (__any(mn > mrun)) { const float alpha = __builtin_amdgcn_exp2f(mrun - mn); lrun *= alpha;
#pragma unroll
                for (int r = 0; r < 16; ++r) { o0[r] *= alpha; o1[r] *= alpha; } }
            mrun = mn;
            float ls = 0.f;
#pragma unroll
            for (int r = 0; r < 16; ++r) {
                const int cr = (r & 3) + 8 * (r >> 2);
                const float e0 = __builtin_amdgcn_exp2f(p0[r] - mn), e1 = __builtin_amdgcn_exp2f(p1[r] - mn);
                p0[r] = __builtin_bit_cast(float, __builtin_bit_cast(int, e0) & __builtin_amdgcn_sbfe(w0, cr, 1));
                p1[r] = __builtin_bit_cast(float, __builtin_bit_cast(int, e1) & __builtin_amdgcn_sbfe(w1, cr, 1));
                ls += p0[r] + p1[r];
            }
            lrun += ls;
            f16x8 pa[4];
#pragma unroll
            for (int s = 0; s < 2; ++s) {
                typedef _Float16 h2_t __attribute__((ext_vector_type(2)));
                u32x4 x0, x1;
                x0.x = __builtin_bit_cast(unsigned, __builtin_amdgcn_cvt_pkrtz(p0[8 * s + 0], p0[8 * s + 1])); x0.y = __builtin_bit_cast(unsigned, __builtin_amdgcn_cvt_pkrtz(p0[8 * s + 2], p0[8 * s + 3]));
                x0.z = __builtin_bit_cast(unsigned, __builtin_amdgcn_cvt_pkrtz(p0[8 * s + 4], p0[8 * s + 5])); x0.w = __builtin_bit_cast(unsigned, __builtin_amdgcn_cvt_pkrtz(p0[8 * s + 6], p0[8 * s + 7]));
                x1.x = __builtin_bit_cast(unsigned, __builtin_amdgcn_cvt_pkrtz(p1[8 * s + 0], p1[8 * s + 1])); x1.y = __builtin_bit_cast(unsigned, __builtin_amdgcn_cvt_pkrtz(p1[8 * s + 2], p1[8 * s + 3]));
                x1.z = __builtin_bit_cast(unsigned, __builtin_amdgcn_cvt_pkrtz(p1[8 * s + 4], p1[8 * s + 5])); x1.w = __builtin_bit_cast(unsigned, __builtin_amdgcn_cvt_pkrtz(p1[8 * s + 6], p1[8 * s + 7]));
                pa[s] = __builtin_bit_cast(f16x8, x0); pa[2 + s] = __builtin_bit_cast(f16x8, x1);
            }
            const unsigned vbt = vb + bo;
#pragma unroll
            for (int d0 = 0; d0 < 2; ++d0) {
                s16x4 lo[4], hi4[4];
#pragma unroll
                for (int ks = 0; ks < 4; ++ks) {
                    asm volatile("ds_read_b64_tr_b16 %0,%1 offset:%c2" : "=&v"(lo[ks]) : "v"(vbt), "i"(d0 * 4096 + ks * 1024) : "memory");
                    asm volatile("ds_read_b64_tr_b16 %0,%1 offset:%c2" : "=&v"(hi4[ks]) : "v"(vbt), "i"(d0 * 4096 + ks * 1024 + 512) : "memory"); }
                asm volatile("s_waitcnt lgkmcnt(0)" ::: "memory"); __builtin_amdgcn_sched_barrier(0);
#define DSA_PK(k) __builtin_bit_cast(f16x8, (bf16x8){lo[k][0], lo[k][1], lo[k][2], lo[k][3], hi4[k][0], hi4[k][1], hi4[k][2], hi4[k][3]})
                if (d0 == 0) { o0 = __builtin_amdgcn_mfma_f32_32x32x16_f16(DSA_PK(0), pa[0], o0, 0, 0, 0); o0 = __builtin_amdgcn_mfma_f32_32x32x16_f16(DSA_PK(1), pa[1], o0, 0, 0, 0);
                               o0 = __builtin_amdgcn_mfma_f32_32x32x16_f16(DSA_PK(2), pa[2], o0, 0, 0, 0); o0 = __builtin_amdgcn_mfma_f32_32x32x16_f16(DSA_PK(3), pa[3], o0, 0, 0, 0); }
                else         { o1 = __builtin_amdgcn_mfma_f32_32x32x16_f16(DSA_PK(0), pa[0], o1, 0, 0, 0); o1 = __builtin_amdgcn_mfma_f32_32x32x16_f16(DSA_PK(1), pa[1], o1, 0, 0, 0);
                               o1 = __builtin_amdgcn_mfma_f32_32x32x16_f16(DSA_PK(2), pa[2], o1, 0, 0, 0); o1 = __builtin_amdgcn_mfma_f32_32x32x16_f16(DSA_PK(3), pa[3], o1, 0, 0, 0); }
#undef DSA_PK
            }
        }
        lrun += __shfl_xor(lrun, 32);
        const float inv = 1.0f / lrun;
        bf16* op = OA + (row0 + qrow) * DM + hq * 64 + 4 * hh;
#pragma unroll
        for (int gq = 0; gq < 4; ++gq) {
            u32x2 x; x.x = pg8::cvt_pk_bf16(o0[4 * gq] * inv, o0[4 * gq + 1] * inv); x.y = pg8::cvt_pk_bf16(o0[4 * gq + 2] * inv, o0[4 * gq + 3] * inv); *(u32x2*)(op + 8 * gq) = x;
            u32x2 z; z.x = pg8::cvt_pk_bf16(o1[4 * gq] * inv, o1[4 * gq + 1] * inv); z.y = pg8::cvt_pk_bf16(o1[4 * gq + 2] * inv, o1[4 * gq + 3] * inv); *(u32x2*)(op + 32 + 8 * gq) = z;
        }
    }
}
__device__ __forceinline__ void phase(Frame& F, const Args& A) {
    const bf16* PA = (const bf16*)(A.ws + WS_PA); const float* WI = (const float*)(A.ws + WS_WI); bf16* OA = (bf16*)(A.ws + WS_OA);
    for (int u = blockIdx.x; u < 256; u += F.G) { const int b = u >> 4, j = u & 15; unit(F.lds, PA, WI, OA, b, 31 - j); unit(F.lds, PA, WI, OA, b, j); }
}
}
namespace mla {
typedef float f32x16 __attribute__((ext_vector_type(16)));
typedef short s16x4 __attribute__((ext_vector_type(4)));
constexpr int KP = 208;
constexpr int LDS_K = 0, LDS_V = 64 * KP, LDS_END = LDS_V + 8192;
__device__ __forceinline__ float xmax32(float m) { auto rr = __builtin_amdgcn_permlane32_swap(__float_as_uint(m), __float_as_uint(m), false, false); return fmaxf(__uint_as_float(rr[0]), __uint_as_float(rr[1])); }
__device__ __forceinline__ void attn_unit(LAS unsigned char* lds, const bf16* QB, const bf16* KVB, const bf16* CB, bf16* OB, int b, int h, int qb) {
    const int tid = threadIdx.x, lane = tid & 63, r32 = lane & 31, hi = lane >> 5; const int wid = __builtin_amdgcn_readfirstlane(tid >> 6);
    const int c0 = qb * 4, cw = c0 + (wid >> 1), ntile = c0 + 4;
    const size_t row0 = (size_t)b * SEQ;
    const bf16* qp = QB + (row0 + (size_t)qb * 256 + wid * 32 + r32) * QUP + h * 96 + hi * 8;
    bf16x8 qf[6];
#pragma unroll
    for (int ks = 0; ks < 6; ++ks) qf[ks] = *(const bf16x8*)(qp + ks * 16);
    f32x16 o0 = {}, o1 = {}; float mrun = -INFINITY, lrun = 0.f;
    const unsigned vb = (unsigned)(uintptr_t)(lds + LDS_V) + ((lane >> 4) & 1) * 32 + (lane & 3) * 8 + (4 * hi + ((lane & 15) >> 2)) * 64;
    for (int kt = 0; kt < ntile; ++kt) {
        __syncthreads();
        for (int c = tid; c < 768; c += 512) { const int key = c / 12, ci = c % 12; const size_t krow = row0 + (size_t)kt * 64 + key;
            const bf16* src = (ci < 8) ? (KVB + krow * KVUP + h * 128 + ci * 8) : (CB + krow * B_INP + 640 + (ci - 8) * 8);
            *(LAS v4u*)(lds + LDS_K + key * KP + ci * 16) = *(const v4u*)src; }
        { const int key = tid >> 3, c8 = tid & 7; const bf16* src = KVB + (row0 + (size_t)kt * 64 + key) * KVUP + h * 128 + 64 + c8 * 8;
          *(LAS v4u*)(lds + LDS_V + (c8 >> 2) * 4096 + (key >> 3) * 512 + (key & 7) * 64 + (c8 & 3) * 16) = *(const v4u*)src; }
        __syncthreads();
        if (kt <= cw) {
            f32x16 p0 = {}, p1 = {};
#pragma unroll
            for (int ks = 0; ks < 6; ++ks) {
                const bf16x8 k0 = *(const LAS bf16x8*)(lds + LDS_K + r32 * KP + ks * 32 + hi * 16);
                const bf16x8 k1 = *(const LAS bf16x8*)(lds + LDS_K + (32 + r32) * KP + ks * 32 + hi * 16);
                p0 = __builtin_amdgcn_mfma_f32_32x32x16_bf16(k0, qf[ks], p0, 0, 0, 0);
                p1 = __builtin_amdgcn_mfma_f32_32x32x16_bf16(k1, qf[ks], p1, 0, 0, 0);
            }
            float mx = fmaxf(p0[0], p1[0]);
#pragma unroll
            for (int r = 1; r < 16; ++r) mx = fmaxf(mx, fmaxf(p0[r], p1[r]));
            mx = xmax32(mx);
            const float mn = fmaxf(mrun, mx), alpha = __builtin_amdgcn_exp2f(mrun - mn); mrun = mn;
            float ls = 0.f;
#pragma unroll
            for (int r = 0; r < 16; ++r) { p0[r] = __builtin_amdgcn_exp2f(p0[r] - mn); p1[r] = __builtin_amdgcn_exp2f(p1[r] - mn); ls += p0[r] + p1[r]; }
            lrun = lrun * alpha + ls;
#pragma unroll
            for (int r = 0; r < 16; ++r) { o0[r] *= alpha; o1[r] *= alpha; }
            bf16x8 pa[4];
#pragma unroll
            for (int s = 0; s < 2; ++s) {
                u32x4 w0, w1;
                w0.x = pg8::cvt_pk_bf16(p0[8 * s + 0], p0[8 * s + 1]); w0.y = pg8::cvt_pk_bf16(p0[8 * s + 2], p0[8 * s + 3]); w0.z = pg8::cvt_pk_bf16(p0[8 * s + 4], p0[8 * s + 5]); w0.w = pg8::cvt_pk_bf16(p0[8 * s + 6], p0[8 * s + 7]);
                w1.x = pg8::cvt_pk_bf16(p1[8 * s + 0], p1[8 * s + 1]); w1.y = pg8::cvt_pk_bf16(p1[8 * s + 2], p1[8 * s + 3]); w1.z = pg8::cvt_pk_bf16(p1[8 * s + 4], p1[8 * s + 5]); w1.w = pg8::cvt_pk_bf16(p1[8 * s + 6], p1[8 * s + 7]);
                pa[s] = __builtin_bit_cast(bf16x8, w0); pa[2 + s] = __builtin_bit_cast(bf16x8, w1);
            }
#pragma unroll
            for (int d0 = 0; d0 < 2; ++d0) {
                s16x4 lo[4], hi4[4];
#pragma unroll
                for (int ks = 0; ks < 4; ++ks) {
                    asm volatile("ds_read_b64_tr_b16 %0,%1 offset:%c2" : "=&v"(lo[ks]) : "v"(vb), "i"(d0 * 4096 + ks * 1024) : "memory");
                    asm volatile("ds_read_b64_tr_b16 %0,%1 offset:%c2" : "=&v"(hi4[ks]) : "v"(vb), "i"(d0 * 4096 + ks * 1024 + 512) : "memory"); }
                asm volatile("s_waitcnt lgkmcnt(0)" ::: "memory"); __builtin_amdgcn_sched_barrier(0);
#define MLA_PK(k) (bf16x8){lo[k][0], lo[k][1], lo[k][2], lo[k][3], hi4[k][0], hi4[k][1], hi4[k][2], hi4[k][3]}
                if (d0 == 0) { o0 = __builtin_amdgcn_mfma_f32_32x32x16_bf16(MLA_PK(0), pa[0], o0, 0, 0, 0); o0 = __builtin_amdgcn_mfma_f32_32x32x16_bf16(MLA_PK(1), pa[1], o0, 0, 0, 0);
                               o0 = __builtin_amdgcn_mfma_f32_32x32x16_bf16(MLA_PK(2), pa[2], o0, 0, 0, 0); o0 = __builtin_amdgcn_mfma_f32_32x32x16_bf16(MLA_PK(3), pa[3], o0, 0, 0, 0); }
                else         { o1 = __builtin_amdgcn_mfma_f32_32x32x16_bf16(MLA_PK(0), pa[0], o1, 0, 0, 0); o1 = __builtin_amdgcn_mfma_f32_32x32x16_bf16(MLA_PK(1), pa[1], o1, 0, 0, 0);
                               o1 = __builtin_amdgcn_mfma_f32_32x32x16_bf16(MLA_PK(2), pa[2], o1, 0, 0, 0); o1 = __builtin_amdgcn_mfma_f32_32x32x16_bf16(MLA_PK(3), pa[3], o1, 0, 0, 0); }
#undef MLA_PK
            }
        }
    }
    lrun += __shfl_xor(lrun, 32);
    const float inv = 1.0f / lrun;
    bf16* op = OB + (row0 + (size_t)qb * 256 + wid * 32 + r32) * DM + h * 64 + 4 * hi;
#pragma unroll
    for (int g = 0; g < 4; ++g) {
        u32x2 w; w.x = pg8::cvt_pk_bf16(o0[4 * g] * inv, o0[4 * g + 1] * inv); w.y = pg8::cvt_pk_bf16(o0[4 * g + 2] * inv, o0[4 * g + 3] * inv); *(u32x2*)(op + 8 * g) = w;
        u32x2 z; z.x = pg8::cvt_pk_bf16(o1[4 * g] * inv, o1[4 * g + 1] * inv); z.y = pg8::cvt_pk_bf16(o1[4 * g + 2] * inv, o1[4 * g + 3] * inv); *(u32x2*)(op + 32 + 8 * g) = z;
    }
}
__device__ __forceinline__ void attn_phase(Frame& F, const Args& A) {
    const bf16* QB = (const bf16*)(A.ws + WS_QB); const bf16* KVB = (const bf16*)(A.ws + WS_KVB); const bf16* CB = (const bf16*)(A.ws + WS_CB); bf16* OB = (bf16*)(A.ws + WS_OB);
    for (int u = blockIdx.x; u < BATCH * 16 * 8; u += F.G) { const int bh = u & 255, qb = u >> 8; attn_unit(F.lds, QB, KVB, CB, OB, bh >> 4, bh & 15, qb); }
}
}
__global__ void __launch_bounds__(NWAVES * 64, 2) mk_fwd(Args args) {
    extern __shared__ __attribute__((aligned(16))) unsigned char lds_raw[];
    Frame F;
    F.lds = (LAS unsigned char*)lds_raw;
    F.MISC = (volatile LAS unsigned*)(F.lds + MISC_OFF);
    F.tid = threadIdx.x; F.lane = F.tid & 63; F.wave = __builtin_amdgcn_readfirstlane(F.tid >> 6);
    F.G = gridDim.x;
    unsigned char* ws = args.ws;
    F.ctl = (gu32*)(ws + WS_CTL);
    for (int u = F.tid; u < (LDS_BYTES - LDSCTL_OFF) / 4; u += NWAVES * 64) ((LAS unsigned*)(F.lds + LDSCTL_OFF))[u] = 0u;
    __syncthreads();
    XcdBarrier bar; bar.bar = (unsigned*)(F.ctl + CW_BAR); bar.x = 0; bar.st = nullptr;
    if (N_LAUNCHES == 1) bar = xcd_barrier_post((unsigned*)(F.ctl + CW_BAR), F.MISC + 8);
#define GRID_BAR() do { if (N_LAUNCHES == 1) xcd_barrier(bar); } while (0)
    const int lo = args.ph_lo, hi = args.ph_hi;
#ifndef PHMASK
#define PHMASK 0x1fff
#endif
#define IN(k) (((PHMASK >> (k)) & 1) && lo <= (k) && (k) < hi)
    bf16* const XB = (bf16*)(ws + WS_XB); float* const SS = (float*)(ws + WS_SS); float* const SSB = (float*)(ws + WS_SSB);
    const float* const cosA = (const float*)(ws + WS_COSA); const float* const sinA = (const float*)(ws + WS_SINA);
    const float* const cosB = (const float*)(ws + WS_COSB); const float* const sinB = (const float*)(ws + WS_SINB);
    const int bid = (int)blockIdx.x;

    if (IN(0)) { p0_prologue(F, args); GRID_BAR(); }
    if (IN(1)) {
        pg8::Gemm g{XB, (const bf16*)(ws + WS_WAIN), M, A_INP, DM, DM, DM}; pg8::StaticOrder S; S.init(M, A_INP, F.G, bid);
        pg8::EpiDsaIn E{(bf16*)(ws + WS_PA), (float*)(ws + WS_WI), SS, cosA, sinA, IDX_WSCALE, QSCALE_A};
        pg8::gemm_phase<pg8::EpiDsaIn, pg8::StaticOrder, true, true, true>(F.lds, g, S, E);
        GRID_BAR();
    }
    if (IN(2)) { dsa::phase(F, args); GRID_BAR(); }
    if (IN(3)) {
        pg8::Gemm g{(const bf16*)(ws + WS_OA), (const bf16*)(ws + WS_WAOUT), M, DM, DM, DM, DM}; pg8::StaticOrder S; S.init(M, DM, F.G, bid);
        pg8::EpiResid E{(const float*)args.in[0], args.out, XB, SS};
        pg8::gemm_phase<pg8::EpiResid, pg8::StaticOrder, true, true, false>(F.lds, g, S, E);
        GRID_BAR();
    }
    if (IN(4)) {
        pg8::Gemm g{XB, (const bf16*)(ws + WS_WUP0), M, FF, DM, DM, DM}; pg8::StaticOrder S; S.init(M, FF, F.G, bid);
        pg8::EpiMlpUp E{(bf16*)(ws + WS_H), SS};
        pg8::gemm_phase<pg8::EpiMlpUp, pg8::StaticOrder, true, true, false>(F.lds, g, S, E);
        GRID_BAR();
    }
    if (IN(5)) {
        pg8::Gemm g{(const bf16*)(ws + WS_H), (const bf16*)(ws + WS_WDN0), M, DM, FF, FF, FF}; pg8::StaticOrder S; S.init(M, DM, F.G, bid);
        pg8::EpiResid E{args.out, args.out, XB, SS};
        pg8::gemm_phase<pg8::EpiResid, pg8::StaticOrder, true, true, false>(F.lds, g, S, E);
        GRID_BAR();
    }
    if (IN(6)) {
        pg8::Gemm g{XB, (const bf16*)(ws + WS_WBIN), M, B_INP, DM, DM, DM}; pg8::StaticOrder S; S.init(M, B_INP, F.G, bid);
        pg8::EpiMlaIn E{(bf16*)(ws + WS_CB), SSB, SS, cosB, sinB};
        pg8::gemm_phase<pg8::EpiMlaIn, pg8::StaticOrder, true, true, false>(F.lds, g, S, E);
        GRID_BAR();
    }
    if (IN(7)) {
#ifndef NO_QUP
        { pg8::Gemm g{(const bf16*)(ws + WS_CB), (const bf16*)(ws + WS_WQUP), M, QUP, QLORA, B_INP, QLORA}; pg8::StaticOrder S; S.init(M, QUP, F.G, bid);
          pg8::EpiQUp E{(bf16*)(ws + WS_QB), SSB, cosB, sinB, QSCALE_B};
          pg8::gemm_phase<pg8::EpiQUp, pg8::StaticOrder, true, true, false>(F.lds, g, S, E); }
#endif
#ifndef NO_KVUP
        { pg8::Gemm g{(const bf16*)(ws + WS_CB) + QLORA, (const bf16*)(ws + WS_WKVUP), M, KVUP, KVLORA, B_INP, KVLORA}; pg8::StaticOrder S; S.init(M, KVUP, F.G, bid);
          pg8::EpiKvUp E{(bf16*)(ws + WS_KVB), SSB};
          pg8::gemm_phase<pg8::EpiKvUp, pg8::StaticOrder, true, true, false>(F.lds, g, S, E); }
#endif
        GRID_BAR();
    }
    if (IN(8)) { mla::attn_phase(F, args); GRID_BAR(); }
    if (IN(9)) {
        pg8::Gemm g{(const bf16*)(ws + WS_OB), (const bf16*)(ws + WS_WBOUT), M, DM, DM, DM, DM}; pg8::StaticOrder S; S.init(M, DM, F.G, bid);
        pg8::EpiResid E{args.out, args.out, XB, SS};
        pg8::gemm_phase<pg8::EpiResid, pg8::StaticOrder, true, true, false>(F.lds, g, S, E);
        GRID_BAR();
    }
    if (IN(10)) {
        pg8::Gemm g{XB, (const bf16*)(ws + WS_WUP1), M, FF, DM, DM, DM}; pg8::StaticOrder S; S.init(M, FF, F.G, bid);
        pg8::EpiMlpUp E{(bf16*)(ws + WS_H), SS};
        pg8::gemm_phase<pg8::EpiMlpUp, pg8::StaticOrder, true, true, false>(F.lds, g, S, E);
        GRID_BAR();
    }
    if (IN(11)) {
        pg8::Gemm g{(const bf16*)(ws + WS_H), (const bf16*)(ws + WS_WDN1), M, DM, FF, FF, FF}; pg8::StaticOrder S; S.init(M, DM, F.G, bid);
        pg8::EpiResid E{args.out, args.out, nullptr, SS};
        pg8::gemm_phase<pg8::EpiResid, pg8::StaticOrder, true, true, false>(F.lds, g, S, E);
        GRID_BAR();
    }
    if (IN(12)) { p12_final_norm(F, args); }
#undef IN
#undef GRID_BAR
}

extern "C" void kernel_launch(void* const* d_in, const int* in_sizes, int n_in, void* d_out, int out_size, void* d_ws, size_t ws_size, hipStream_t stream) {
    static int grid = 0;
    if (grid == 0) {
        if (n_in != 15 || in_sizes[0] != M * DM || out_size != M * DM || ws_size < WS_END) { fprintf(stderr, "kernel_launch: unexpected shapes / workspace (n_in %d, in0 %d, out %d, ws %zu); nothing launched\n", n_in, n_in > 0 ? in_sizes[0] : -1, out_size, ws_size); grid = -1; return; }
        int dev = 0, cus = 0, per_cu = 0;
        if (hipGetDevice(&dev) != hipSuccess || hipDeviceGetAttribute(&cus, hipDeviceAttributeMultiprocessorCount, dev) != hipSuccess) { grid = -1; return; }
        if (hipFuncSetAttribute((const void*)mk_fwd, hipFuncAttributeMaxDynamicSharedMemorySize, LDS_BYTES) != hipSuccess) { fprintf(stderr, "kernel_launch: hipFuncSetAttribute failed\n"); grid = -1; return; }
        if (hipOccupancyMaxActiveBlocksPerMultiprocessor(&per_cu, (const void*)mk_fwd, NWAVES * 64, LDS_BYTES) != hipSuccess || per_cu < 1) { fprintf(stderr, "kernel_launch: occupancy query reports %d blocks per CU\n", per_cu); }
        (void)hipGetLastError();
        grid = cus;
    }
    if (grid < 0) return;
    if (hipMemsetAsync((char*)d_ws + WS_CTL, 0, CTL_ZERO_BYTES, stream) != hipSuccess) return;
    Args a{};
    for (int i = 0; i < 15; ++i) a.in[i] = d_in[i];
    a.out = (float*)d_out; a.ws = (unsigned char*)d_ws;
    for (int i = 0; i < 8; ++i) a.inv_a[i] = (float)pow(500000.0, -(double)i / 8.0);
    for (int i = 0; i < 16; ++i) a.inv_b[i] = (float)pow(500000.0, -(double)i / 16.0);
    if (N_LAUNCHES == 1) { a.ph_lo = 0; a.ph_hi = N_PHASES; hipLaunchKernelGGL(mk_fwd, dim3(grid), dim3(NWAVES * 64), LDS_BYTES, stream, a); }
    else for (int li = 0; li < N_PHASES; ++li) { a.ph_lo = li; a.ph_hi = li + 1; hipLaunchKernelGGL(mk_fwd, dim3(grid), dim3(NWAVES * 64), LDS_BYTES, stream, a); }
    const hipError_t le = hipPeekAtLastError();
    if (le != hipSuccess) fprintf(stderr, "kernel_launch: launch failed: %s\n", hipGetErrorName(le));
}
```

```cpp
#include <hip/hip_runtime.h>
#include <cstdio>
#include <cstdint>
#include <cmath>
namespace pg8 {
#define PG8_LAS __attribute__((address_space(3)))
typedef unsigned short bf16_t;
typedef short bf16x8 __attribute__((ext_vector_type(8)));
typedef float f32x4 __attribute__((ext_vector_type(4)));
typedef unsigned u32x4 __attribute__((ext_vector_type(4)));
constexpr int BM = 256, BK = 64, HALF = 128, HTB = HALF * BK * 2  , STAGE_BYTES = 8 * HTB, NXCD = 8, WGM = 8;

__host__ __device__ __forceinline__ int lds_byte(int r, int c) { const int st = (r >> 4) * 2 + (c >> 5), rr = r & 15, cc = c & 31, ob = rr * 64 + cc * 2; return st * 1024 + (ob ^ (((ob >> 9) & 1) << 5)); }
__host__ __device__ __forceinline__ void stage_rc(int b, int& R, int& C) { const int st = b / 1024, sb = b % 1024, swz = sb ^ (((sb >> 9) & 1) << 5); R = (st >> 1) * 16 + swz / 64; C = (st & 1) * 32 + (swz % 64) / 2; }
__host__ __device__ __forceinline__ int perm32(int rho) { const int n = rho >> 4, i = rho & 15; return 8 * (i >> 2) + 4 * n + (i & 3); }

struct Unit { int pm, pn; };
struct Gemm { const bf16_t* A; const bf16_t* Bt; int M, N, K, lda, ldb; };

struct StaticOrder {
    int nM, nN, nwg, G, c;
    __host__ __device__ void init(int M, int N, int G_, int c_) { nM = M / BM; nN = N / BM; nwg = nM * nN; G = G_; c = c_; }
    __host__ __device__ bool next(int i, Unit& u) const {
        const long L = (long)i * G + c; if (L >= nwg) return false;
        int wgid = (int)L; { const int q = nwg / NXCD, r = nwg % NXCD, xcd = wgid % NXCD, off = wgid / NXCD; wgid = (xcd < r ? xcd * (q + 1) : r * (q + 1) + (xcd - r) * q) + off; }
        const int nig = WGM * nN, gid = wgid / nig, fm = gid * WGM, gsz = (nM - fm) < WGM ? (nM - fm) : WGM;
        u.pm = fm + ((wgid % nig) % gsz); u.pn = (wgid % nig) / gsz; return true;
    }
    __device__ __forceinline__ void a_ready(const Unit&) const {}
    __device__ __forceinline__ void done(const Unit&) const {}
};

__device__ __forceinline__ unsigned cvt_pk_bf16(float lo, float hi) { unsigned r; asm volatile("v_cvt_pk_bf16_f32 %0, %1, %2" : "=v"(r) : "v"(lo), "v"(hi)); return r; }
typedef _Float16 f16x8_t __attribute__((ext_vector_type(8)));
typedef _Float16 f16x2_t __attribute__((ext_vector_type(2)));
template <bool F16> __device__ __forceinline__ f32x4 mma16(bf16x8 a, bf16x8 b, f32x4 c) {
    if constexpr (F16) return __builtin_amdgcn_mfma_f32_16x16x32_f16(__builtin_bit_cast(f16x8_t, a), __builtin_bit_cast(f16x8_t, b), c, 0, 0, 0);
    else return __builtin_amdgcn_mfma_f32_16x16x32_bf16(a, b, c, 0, 0, 0);
}
__device__ __forceinline__ unsigned cvt_pk_f16(float lo, float hi) { f16x2_t t = {(_Float16)lo, (_Float16)hi}; return __builtin_bit_cast(unsigned, t); }
__device__ __forceinline__ u32x4 pack8_bf16(f32x4 a, f32x4 b) { u32x4 w; w.x = cvt_pk_bf16(a[0], a[1]); w.y = cvt_pk_bf16(a[2], a[3]); w.z = cvt_pk_bf16(b[0], b[1]); w.w = cvt_pk_bf16(b[2], b[3]); return w; }
__device__ __forceinline__ u32x4 pack8_f16(f32x4 a, f32x4 b) { u32x4 w; w.x = cvt_pk_f16(a[0], a[1]); w.y = cvt_pk_f16(a[2], a[3]); w.z = cvt_pk_f16(b[0], b[1]); w.w = cvt_pk_f16(b[2], b[3]); return w; }
typedef unsigned u32x2 __attribute__((ext_vector_type(2)));
__device__ __forceinline__ u32x2 pack4_bf16(f32x4 a) { u32x2 w; w.x = cvt_pk_bf16(a[0], a[1]); w.y = cvt_pk_bf16(a[2], a[3]); return w; }
__device__ __forceinline__ f32x4 shfl4(f32x4 v, int x) { f32x4 r; r[0] = __shfl_xor(v[0], x); r[1] = __shfl_xor(v[1], x); r[2] = __shfl_xor(v[2], x); r[3] = __shfl_xor(v[3], x); return r; }
__device__ __forceinline__ float sum4(f32x4 v) { return (v[0] + v[1]) + (v[2] + v[3]); }
__device__ __forceinline__ float dot4(f32x4 v) { return (v[0] * v[0] + v[1] * v[1]) + (v[2] * v[2] + v[3] * v[3]); }
constexpr float RMS_EPS = 1e-6f;
__device__ __forceinline__ float rstd_from(const float* p, int n4, float inv_cnt) {
    float s = 0.f;
#pragma unroll 4
    for (int i = 0; i < n4; ++i) s += sum4(((const f32x4*)p)[i]);
    return __builtin_amdgcn_rsqf(s * inv_cnt + RMS_EPS);
}

struct EpiDsaIn {
    static constexpr bool PERM = true, AFTER_DRAIN = false;
    bf16_t* PA; float* WI; const float* SS; const float* cosA; const float* sinA; float wscale, qscale;
    __device__ __forceinline__ void operator()(const f32x4 (&acc)[2][2][4][2], const Unit& u, int wr, int wc, int fr, int fq) const {
#pragma unroll
        for (int ai = 0; ai < 2; ++ai)
#pragma unroll
            for (int m = 0; m < 4; ++m) {
                const int row = u.pm * BM + ai * HALF + wr * 64 + m * 16 + fr;
                asm volatile("" ::: "memory");
                const float rs = rstd_from(SS + (size_t)row * 16, 4, 1.0f / 1024.0f);
                const f32x4 c0 = *(const f32x4*)(cosA + (size_t)row * 8), c1 = *(const f32x4*)(cosA + (size_t)row * 8 + 4);
                const f32x4 s0 = *(const f32x4*)(sinA + (size_t)row * 8), s1 = *(const f32x4*)(sinA + (size_t)row * 8 + 4);
#pragma unroll
                for (int bj = 0; bj < 2; ++bj) {
                    const int cb = u.pn * BM + bj * HALF + wc * 32;
                    const int col8 = cb + 8 * fq;
                    f32x4 v0 = acc[ai][bj][m][0] * rs, v1 = acc[ai][bj][m][1] * rs;
                    const bool ropeg = ((cb & 63) == 0) && (cb < 1280 || (cb >= 1536 && cb < 2112));
                    if (ropeg) {
                        const f32x4 p0 = shfl4(v0, 16), p1 = shfl4(v1, 16);
                        if (fq == 0) { v0 = v0 * c0 - p0 * s0; v1 = v1 * c1 - p1 * s1; }
                        else if (fq == 1) { v0 = v0 * c0 + p0 * s0; v1 = v1 * c1 + p1 * s1; }
                    }
                    if (cb < 1024) { v0 = v0 * qscale; v1 = v1 * qscale; }
                    if (cb < 2112) *(u32x4*)(PA + (size_t)row * 2304 + col8) = pack8_f16(v0, v1);
                    else if (cb == 2112 && fq == 0) { *(f32x4*)(WI + (size_t)row * 8) = v0 * wscale; *(f32x4*)(WI + (size_t)row * 8 + 4) = v1 * wscale; }
                }
            }
    }
};
struct EpiResid {
    static constexpr bool PERM = true, AFTER_DRAIN = false;
    const float* base; float* out; bf16_t* XB; float* SS;
    __device__ __forceinline__ void operator()(const f32x4 (&acc)[2][2][4][2], const Unit& u, int wr, int wc, int fr, int fq) const {
#pragma unroll
        for (int ai = 0; ai < 2; ++ai)
#pragma unroll
            for (int m = 0; m < 4; ++m) {
                const int row = u.pm * BM + ai * HALF + wr * 64 + m * 16 + fr;
                float ssq = 0.f;
#pragma unroll
                for (int bj = 0; bj < 2; ++bj) {
                    const int col8 = u.pn * BM + bj * HALF + wc * 32 + 8 * fq;
                    const float* bp = base + (size_t)row * 1024 + col8;
                    const f32x4 v0 = acc[ai][bj][m][0] + *(const f32x4*)bp, v1 = acc[ai][bj][m][1] + *(const f32x4*)(bp + 4);
                    float* op = out + (size_t)row * 1024 + col8;
                    *(f32x4*)op = v0; *(f32x4*)(op + 4) = v1;
                    if (XB) *(u32x4*)(XB + (size_t)row * 1024 + col8) = pack8_bf16(v0, v1);
                    ssq += dot4(v0) + dot4(v1);
                }
                ssq += __shfl_xor(ssq, 16); ssq += __shfl_xor(ssq, 32);
                if (fq == 0) SS[(size_t)row * 16 + u.pn * 4 + wc] = ssq;
            }
    }
};
struct EpiMlpUp {
    static constexpr bool PERM = true, AFTER_DRAIN = false;
    bf16_t* H; const float* SS;
    __device__ __forceinline__ void operator()(const f32x4 (&acc)[2][2][4][2], const Unit& u, int wr, int wc, int fr, int fq) const {
#pragma unroll
        for (int ai = 0; ai < 2; ++ai)
#pragma unroll
            for (int m = 0; m < 4; ++m) {
                const int row = u.pm * BM + ai * HALF + wr * 64 + m * 16 + fr;
                const float rs = rstd_from(SS + (size_t)row * 16, 4, 1.0f / 1024.0f);
#pragma unroll
                for (int bj = 0; bj < 2; ++bj) {
                    const int col8 = u.pn * BM + bj * HALF + wc * 32 + 8 * fq;
                    f32x4 v0 = acc[ai][bj][m][0] * rs, v1 = acc[ai][bj][m][1] * rs;
                    const f32x4 z = {0.f, 0.f, 0.f, 0.f};
                    v0 = __builtin_elementwise_max(v0, z); v1 = __builtin_elementwise_max(v1, z);
                    *(u32x4*)(H + (size_t)row * 4096 + col8) = pack8_bf16(v0 * v0, v1 * v1);
                }
            }
    }
};
struct EpiMlaIn {
    static constexpr bool PERM = false, AFTER_DRAIN = false;
    bf16_t* CB; float* SSB; const float* SS; const float* cosB; const float* sinB;
    __device__ __forceinline__ void operator()(const f32x4 (&acc)[2][2][4][2], const Unit& u, int wr, int wc, int fr, int fq) const {
#pragma unroll
        for (int ai = 0; ai < 2; ++ai)
#pragma unroll
            for (int m = 0; m < 4; ++m) {
                const int row = u.pm * BM + ai * HALF + wr * 64 + m * 16 + fr;
                const float rs = rstd_from(SS + (size_t)row * 16, 4, 1.0f / 1024.0f);
#pragma unroll
                for (int bj = 0; bj < 2; ++bj) {
                    const int cb = u.pn * BM + bj * HALF + wc * 32;
                    f32x4 v0 = acc[ai][bj][m][0] * rs, v1 = acc[ai][bj][m][1] * rs;
                    if (cb == 640) {
                        const f32x4 c = *(const f32x4*)(cosB + (size_t)row * 16 + 4 * fq), s = *(const f32x4*)(sinB + (size_t)row * 16 + 4 * fq);
                        const f32x4 o0 = v0 * c - v1 * s, o1 = v1 * c + v0 * s; v0 = o0; v1 = o1;
                    }
                    if (cb < 672) { bf16_t* p = CB + (size_t)row * 768 + cb + 4 * fq; *(u32x2*)p = pack4_bf16(v0); *(u32x2*)(p + 16) = pack4_bf16(v1); }
                    if (cb < 640) {
                        float ssq = dot4(v0) + dot4(v1);
                        ssq += __shfl_xor(ssq, 16); ssq += __shfl_xor(ssq, 32);
                        if (fq == 0) SSB[(size_t)row * 24 + (cb >> 5)] = ssq;
                    }
                }
            }
    }
};
struct EpiQUp {
    static constexpr bool PERM = false, AFTER_DRAIN = false;
    bf16_t* QB; const float* SSB; const float* cosB; const float* sinB; float qscale;
    __device__ __forceinline__ void operator()(const f32x4 (&acc)[2][2][4][2], const Unit& u, int wr, int wc, int fr, int fq) const {
#pragma unroll
        for (int ai = 0; ai < 2; ++ai)
#pragma unroll
            for (int m = 0; m < 4; ++m) {
                const int row = u.pm * BM + ai * HALF + wr * 64 + m * 16 + fr;
                asm volatile("" ::: "memory");
                const float rs = rstd_from(SSB + (size_t)row * 24, 3, 1.0f / 384.0f) * qscale;
                const f32x4 c = *(const f32x4*)(cosB + (size_t)row * 16 + 4 * fq), s = *(const f32x4*)(sinB + (size_t)row * 16 + 4 * fq);
#pragma unroll
                for (int bj = 0; bj < 2; ++bj) {
                    const int cb = u.pn * BM + bj * HALF + wc * 32;
                    f32x4 v0 = acc[ai][bj][m][0] * rs, v1 = acc[ai][bj][m][1] * rs;
                    if (((cb >> 5) % 3) == 2) { const f32x4 o0 = v0 * c - v1 * s, o1 = v1 * c + v0 * s; v0 = o0; v1 = o1; }
                    bf16_t* p = QB + (size_t)row * 1536 + cb + 4 * fq; *(u32x2*)p = pack4_bf16(v0); *(u32x2*)(p + 16) = pack4_bf16(v1);
                }
            }
    }
};
struct EpiKvUp {
    static constexpr bool PERM = true, AFTER_DRAIN = false;
    bf16_t* KVB; const float* SSB;
    __device__ __forceinline__ void operator()(const f32x4 (&acc)[2][2][4][2], const Unit& u, int wr, int wc, int fr, int fq) const {
#pragma unroll
        for (int ai = 0; ai < 2; ++ai)
#pragma unroll
            for (int m = 0; m < 4; ++m) {
                const int row = u.pm * BM + ai * HALF + wr * 64 + m * 16 + fr;
                const float rs = rstd_from(SSB + (size_t)row * 24 + 12, 2, 1.0f / 256.0f);
#pragma unroll
                for (int bj = 0; bj < 2; ++bj) {
                    const int col8 = u.pn * BM + bj * HALF + wc * 32 + 8 * fq;
                    *(u32x4*)(KVB + (size_t)row * 2048 + col8) = pack8_bf16(acc[ai][bj][m][0] * rs, acc[ai][bj][m][1] * rs);
                }
            }
    }
};
template <class Epi, class Sched, bool ALIGN_EPI = false, bool SP2 = false, bool F16 = false>
__device__ __forceinline__ void gemm_phase(PG8_LAS unsigned char* lds, const Gemm g, const Sched& S, const Epi& E) {
    const int tid = threadIdx.x, wid = __builtin_amdgcn_readfirstlane(tid >> 6), lane = tid & 63, wr = wid >> 2, wc = wid & 3, fr = lane & 15, fq = lane >> 4;
    const int K = g.K, nt = K / BK;
    unsigned voffA[2], voffB[2];
#pragma unroll
    for (int i = 0; i < 2; ++i) { int R, C; stage_rc(tid * 16 + i * 8192, R, C); const int Rb = Epi::PERM ? ((R & ~31) + perm32(R & 31)) : R;
        voffA[i] = (unsigned)(R * g.lda + C) * 2u; voffB[i] = (unsigned)(Rb * g.ldb + C) * 2u; }
    const size_t kstep = (size_t)(BK * 2);
    const size_t hstepA = (size_t)HALF * g.lda * 2, hstepB = (size_t)HALF * g.ldb * 2;
    const size_t tstepA = 2 * hstepA, tstepB = 2 * hstepB;
    const unsigned ldsw = (unsigned)wid * 1024u;
    const int aoff = lds_byte(wr * 64 + fr, fq * 8), boff = lds_byte(wc * 32 + fr, fq * 8);
#define PG8_SA(b, h) (((b) * 2 + (h)) * HTB)
#define PG8_SB(b, h) ((4 + (b) * 2 + (h)) * HTB)
#define PG8_STAGE(bufoff, gbase, voff) do { _Pragma("unroll") for (int _i = 0; _i < 2; ++_i) \
        __builtin_amdgcn_global_load_lds((const unsigned*)((const char*)(gbase) + (voff)[_i]), (PG8_LAS unsigned*)(lds + (bufoff) + ldsw + _i * 8192), 16, 0, 0); } while (0)
#define PG8_LDA(dst, b, h) do { _Pragma("unroll") for (int m = 0; m < 4; ++m) _Pragma("unroll") for (int k = 0; k < 2; ++k) dst[m][k] = *(const PG8_LAS bf16x8*)(lds + PG8_SA(b, h) + aoff + m * 2048 + k * 1024); } while (0)
#define PG8_LDB(dst, b, h) do { _Pragma("unroll") for (int n = 0; n < 2; ++n) _Pragma("unroll") for (int k = 0; k < 2; ++k) dst[n][k] = *(const PG8_LAS bf16x8*)(lds + PG8_SB(b, h) + boff + n * 2048 + k * 1024); } while (0)
#define PG8_MMA(ai, bj, At, Bt) do { __builtin_amdgcn_s_setprio(1); _Pragma("unroll") for (int m = 0; m < 4; ++m) _Pragma("unroll") for (int n = 0; n < 2; ++n) _Pragma("unroll") for (int k = 0; k < 2; ++k) \
        acc[ai][bj][m][n] = mma16<F16>(Bt[n][k], At[m][k], acc[ai][bj][m][n]); __builtin_amdgcn_s_setprio(0); } while (0)
#define PG8_WAIT_V(n) asm volatile("s_waitcnt vmcnt(" #n ")" ::: "memory")
#define PG8_WAIT_L(n) asm volatile("s_waitcnt lgkmcnt(" #n ")" ::: "memory")
#define PG8_BAR __builtin_amdgcn_s_barrier()
#define PG8_SCHED __builtin_amdgcn_sched_barrier(0)
    Unit cur, nxt; int ui = 0;
    if (!S.next(0, cur)) return;
    f32x4 acc[2][2][4][2];
#pragma unroll
    for (int a = 0; a < 2; ++a)
#pragma unroll
        for (int b = 0; b < 2; ++b)
#pragma unroll
            for (int m = 0; m < 4; ++m)
#pragma unroll
                for (int n = 0; n < 2; ++n) acc[a][b][m][n] = (f32x4){0.f, 0.f, 0.f, 0.f};
    bf16x8 At[4][2], B0[2][2], B1[2][2];
    const char* cA = (const char*)g.A + (size_t)cur.pm * tstepA; const char* cB = (const char*)g.Bt + (size_t)cur.pn * tstepB;
    S.a_ready(cur);
    if constexpr (SP2) {
        PG8_STAGE(PG8_SB(0, 0), cB, voffB); PG8_STAGE(PG8_SB(0, 1), cB + hstepB, voffB); PG8_STAGE(PG8_SA(0, 0), cA, voffA); PG8_STAGE(PG8_SA(0, 1), cA + hstepA, voffA);
        if (wr == 1) PG8_BAR;
        PG8_WAIT_V(2); PG8_BAR;
        PG8_STAGE(PG8_SB(1, 0), cB + kstep, voffB); PG8_STAGE(PG8_SA(1, 0), cA + kstep, voffA); PG8_STAGE(PG8_SB(1, 1), cB + hstepB + kstep, voffB);
        PG8_WAIT_V(6); PG8_BAR;
    } else {
        PG8_STAGE(PG8_SB(0, 0), cB, voffB); PG8_STAGE(PG8_SA(0, 0), cA, voffA); PG8_STAGE(PG8_SB(0, 1), cB + hstepB, voffB); PG8_STAGE(PG8_SA(0, 1), cA + hstepA, voffA);
        if (wr == 1) PG8_BAR;
        PG8_WAIT_V(4); PG8_BAR;
        PG8_STAGE(PG8_SB(1, 0), cB + kstep, voffB); PG8_STAGE(PG8_SA(1, 0), cA + kstep, voffA); PG8_STAGE(PG8_SB(1, 1), cB + hstepB + kstep, voffB);
        PG8_WAIT_V(6); PG8_BAR;
    }
    for (;;) {
        const bool has_next = S.next(ui + 1, nxt);
        const char* nA = has_next ? (const char*)g.A + (size_t)nxt.pm * tstepA : cA; const char* nB = has_next ? (const char*)g.Bt + (size_t)nxt.pn * tstepB : cB;
#pragma nounroll
        for (int t = 0; t < nt; t += 2) {
            const bool last = (t == nt - 2);
            const char* a1 = cA + (size_t)(t + 1) * kstep;
            const char* a2 = last ? nA : cA + (size_t)(t + 2) * kstep; const char* b2 = last ? nB : cB + (size_t)(t + 2) * kstep;
            const char* a3 = a2 + kstep; const char* b3 = b2 + kstep;
            if (last && has_next) S.a_ready(nxt);
            if constexpr (SP2) {
            PG8_LDB(B0, 0, 0); PG8_LDB(B1, 0, 1); PG8_SCHED; PG8_LDA(At, 0, 0); PG8_STAGE(PG8_SA(1, 1), a1 + hstepA, voffA);
            PG8_WAIT_V(8); PG8_WAIT_L(0); PG8_BAR; PG8_MMA(0, 0, At, B0); PG8_MMA(0, 1, At, B1); PG8_BAR; PG8_SCHED;
            PG8_LDA(At, 0, 1); PG8_STAGE(PG8_SB(0, 0), b2, voffB); PG8_STAGE(PG8_SB(0, 1), b2 + hstepB, voffB); PG8_STAGE(PG8_SA(0, 0), a2, voffA);
            PG8_WAIT_V(8); PG8_WAIT_L(0); PG8_BAR; PG8_MMA(1, 0, At, B0); PG8_MMA(1, 1, At, B1); PG8_BAR; PG8_SCHED;
            PG8_LDB(B0, 1, 0); PG8_LDB(B1, 1, 1); PG8_SCHED; PG8_LDA(At, 1, 0); PG8_STAGE(PG8_SA(0, 1), a2 + hstepA, voffA);
            PG8_WAIT_V(8); PG8_WAIT_L(0); PG8_BAR; PG8_MMA(0, 0, At, B0); PG8_MMA(0, 1, At, B1); PG8_BAR; PG8_SCHED;
            PG8_LDA(At, 1, 1); PG8_STAGE(PG8_SB(1, 0), b3, voffB); PG8_STAGE(PG8_SB(1, 1), b3 + hstepB, voffB); PG8_STAGE(PG8_SA(1, 0), a3, voffA);
            PG8_WAIT_V(8); PG8_WAIT_L(0); PG8_BAR; PG8_MMA(1, 0, At, B0); PG8_MMA(1, 1, At, B1); PG8_BAR; PG8_SCHED;
            } else {
            PG8_LDB(B0, 0, 0); PG8_SCHED; PG8_LDA(At, 0, 0); PG8_STAGE(PG8_SA(1, 1), a1 + hstepA, voffA);
            PG8_WAIT_L(8); PG8_BAR; PG8_WAIT_L(0); PG8_MMA(0, 0, At, B0); PG8_BAR; PG8_SCHED;
            PG8_LDB(B1, 0, 1); PG8_STAGE(PG8_SB(0, 0), b2, voffB);
            PG8_BAR; PG8_WAIT_L(0); PG8_MMA(0, 1, At, B1); PG8_BAR;
            PG8_LDA(At, 0, 1); PG8_STAGE(PG8_SA(0, 0), a2, voffA);
            PG8_BAR; PG8_WAIT_L(0); PG8_MMA(1, 0, At, B0); PG8_BAR; PG8_SCHED;
            PG8_STAGE(PG8_SB(0, 1), b2 + hstepB, voffB);
            PG8_WAIT_V(6); PG8_BAR; PG8_MMA(1, 1, At, B1); PG8_BAR;
            PG8_LDB(B0, 1, 0); PG8_SCHED; PG8_LDA(At, 1, 0); PG8_STAGE(PG8_SA(0, 1), a2 + hstepA, voffA);
            PG8_WAIT_L(8); PG8_BAR; PG8_WAIT_L(0); PG8_MMA(0, 0, At, B0); PG8_BAR; PG8_SCHED;
            PG8_LDB(B1, 1, 1); PG8_STAGE(PG8_SB(1, 0), b3, voffB);
            PG8_BAR; PG8_WAIT_L(0); PG8_MMA(0, 1, At, B1); PG8_BAR;
            PG8_LDA(At, 1, 1); PG8_STAGE(PG8_SA(1, 0), a3, voffA);
            PG8_BAR; PG8_WAIT_L(0); PG8_MMA(1, 0, At, B0); PG8_BAR; PG8_SCHED;
            PG8_STAGE(PG8_SB(1, 1), b3 + hstepB, voffB);
            PG8_WAIT_V(6); PG8_BAR; PG8_MMA(1, 1, At, B1); PG8_BAR;
            }
        }
        if constexpr (ALIGN_EPI) { if (wr == 0) PG8_BAR; }
        if constexpr (!Epi::AFTER_DRAIN) { E(acc, cur, wr, wc, fr, fq); S.done(cur); }
        if (!has_next) break;
#pragma unroll
        for (int a = 0; a < 2; ++a)
#pragma unroll
            for (int b = 0; b < 2; ++b)
#pragma unroll
                for (int m = 0; m < 4; ++m)
#pragma unroll
                    for (int n = 0; n < 2; ++n) acc[a][b][m][n] = (f32x4){0.f, 0.f, 0.f, 0.f};
        cur = nxt; cA = nA; cB = nB; ++ui;
        if constexpr (ALIGN_EPI) { if (wr == 1) PG8_BAR; }
    }
    PG8_WAIT_V(0);
    if constexpr (!ALIGN_EPI) { if (wr == 0) PG8_BAR; }
    PG8_BAR;
    if constexpr (Epi::AFTER_DRAIN) { E.fused(acc, cur, wr, wc, fr, fq, lds, wid, lane); S.done(cur); }
#undef PG8_SA
#undef PG8_SB
#undef PG8_STAGE
#undef PG8_LDA
#undef PG8_LDB
#undef PG8_MMA
#undef PG8_WAIT_V
#undef PG8_WAIT_L
#undef PG8_BAR
#undef PG8_SCHED
}
}
constexpr int NWAVES = 8;
#ifndef MK_N_LAUNCHES
#define MK_N_LAUNCHES 1
#endif
constexpr int N_PHASES = 13;
constexpr int N_LAUNCHES = MK_N_LAUNCHES;
constexpr int BATCH = 16, SEQ = 2048, DM = 1024, M = BATCH * SEQ, FF = 4096;
constexpr int A_IN = 2120, A_INP = 2304, B_IN = 672, B_INP = 768, QUP = 1536, KVUP = 2048, QLORA = 384, KVLORA = 256;
constexpr size_t MiB = 1u << 20;
constexpr size_t WS_CTL = 0, CTL_ZERO_BYTES = 64 * 1024;
constexpr size_t WS_WAIN = 1 * MiB, WS_WAOUT = 6 * MiB, WS_WUP0 = 8 * MiB, WS_WUP1 = 16 * MiB, WS_WDN0 = 24 * MiB, WS_WDN1 = 32 * MiB;
constexpr size_t WS_WBIN = 40 * MiB, WS_WQUP = 42 * MiB, WS_WKVUP = 44 * MiB, WS_WBOUT = 46 * MiB;
constexpr size_t WS_COSA = 48 * MiB, WS_SINA = 49 * MiB, WS_COSB = 50 * MiB, WS_SINB = 52 * MiB;
constexpr size_t WS_SS = 54 * MiB, WS_SSB = 56 * MiB, WS_WI = 59 * MiB;
constexpr size_t WS_XB = 64 * MiB;
constexpr size_t WS_BIG = 128 * MiB;
constexpr size_t WS_PA = WS_BIG, WS_OA = WS_BIG + 144 * MiB;
constexpr size_t WS_H = WS_BIG;
constexpr size_t WS_CB = WS_BIG, WS_QB = WS_BIG + 48 * MiB, WS_OB = WS_BIG + 144 * MiB;
constexpr size_t WS_KVB = 384 * MiB, WS_END = 512 * MiB;
static_assert(WS_WAIN + (size_t)A_INP * DM * 2 <= WS_WAOUT && WS_WBIN + (size_t)B_INP * DM * 2 <= WS_WQUP && WS_WQUP + (size_t)QUP * QLORA * 2 <= WS_WKVUP && WS_WKVUP + (size_t)KVUP * KVLORA * 2 <= WS_WBOUT, "weights map");
static_assert(WS_SSB + (size_t)M * 24 * 4 <= WS_WI && WS_WI + (size_t)M * 8 * 4 <= WS_XB && WS_PA + (size_t)M * A_INP * 2 <= WS_OA && WS_OA + (size_t)M * DM * 2 <= WS_KVB && WS_QB + (size_t)M * QUP * 2 <= WS_OB, "activation map");
constexpr int CW_BAR = 1024;
constexpr int RING_BYTES = 131072, LDSCTL_OFF = RING_BYTES, MISC_OFF = LDSCTL_OFF + 320, LDS_BYTES = 147456;
constexpr float IDX_WSCALE = 0.044194173824159216f;
constexpr float QSCALE_A = 0.125f * 1.4426950408889634f;
constexpr float QSCALE_B = 0.10206207261596577f * 1.4426950408889634f;

#define GAS __attribute__((address_space(1)))
#define LAS __attribute__((address_space(3)))
typedef unsigned short bf16;
typedef unsigned v4u __attribute__((ext_vector_type(4)));
typedef float f32x4 __attribute__((ext_vector_type(4)));
typedef short bf16x8 __attribute__((ext_vector_type(8)));
typedef GAS unsigned gu32;
typedef GAS unsigned long long gu64;
#define RLX_AGENT __ATOMIC_RELAXED, __HIP_MEMORY_SCOPE_AGENT
#define LDS_WAIT() asm volatile("s_waitcnt lgkmcnt(0)" ::: "memory")
#define VM_WAIT() asm volatile("s_waitcnt vmcnt(0)" ::: "memory")
__device__ __forceinline__ unsigned long long rt() { return __builtin_amdgcn_s_memrealtime(); }
__device__ __forceinline__ unsigned f2bf(float f) { unsigned u = __builtin_bit_cast(unsigned, f); return (u + 0x7fffu + ((u >> 16) & 1u)) >> 16; }
__device__ __forceinline__ unsigned pk2(float lo, float hi) { return f2bf(lo) | (f2bf(hi) << 16); }

#define XB_TMO      128
#define XB_XCNT(j)  (256  + 64 * (j))
#define XB_XSUB(j)  (1280 + 64 * (j))
#define XB_XGEN(j)  (2304 + 64 * (j))
#define XB_TOP      3328
#define XB_TOPGEN   3392
#define XCD_BAR_WORDS 3456
#define XB_SPIN_CAP (1u << 18)

__device__ __forceinline__ unsigned xb_ld(unsigned* p)              { return __hip_atomic_load(p, __ATOMIC_RELAXED, __HIP_MEMORY_SCOPE_AGENT); }
__device__ __forceinline__ unsigned xb_add(unsigned* p, unsigned v) { return __hip_atomic_fetch_add(p, v, __ATOMIC_RELAXED, __HIP_MEMORY_SCOPE_AGENT); }
__device__ __forceinline__ unsigned xb_xcc_id() { return (unsigned)__builtin_amdgcn_s_getreg((3 << 11) | 20) & 0xFu; }
#define XB_SPIN(cond, bar) do { unsigned _sp = 0; while (cond) { __builtin_amdgcn_s_sleep(1); \
    if ((++_sp & 255u) == 0u) { if (xb_ld(&(bar)[XB_TMO])) break; if (_sp > XB_SPIN_CAP) { atomicAdd(&(bar)[XB_TMO], 1u); break; } } } } while (0)

struct XcdBarrier {
    unsigned* bar; unsigned x;
    volatile LAS unsigned* st;
};

__device__ __forceinline__ XcdBarrier xcd_barrier_post(unsigned* bar, volatile LAS unsigned* st) {
    XcdBarrier b; b.bar = bar; b.x = xb_xcc_id(); b.st = st;
    if (threadIdx.x == 0) (void)xb_add(&bar[XB_XCNT(b.x)], 1u);
    return b;
}
__device__ __forceinline__ void xcd_barrier_complete(unsigned* bar, unsigned x, unsigned& nloc, unsigned& nx) {
    const unsigned G = gridDim.x * gridDim.y * gridDim.z;
    unsigned sum, cnt, mine, sp = 0u;
    for (;;) {
        sum = 0u; cnt = 0u; mine = 0u;
#pragma unroll
        for (unsigned j = 0; j < 16; ++j) { const unsigned c = xb_ld(&bar[XB_XCNT(j)]); sum += c; cnt += (c > 0u) ? 1u : 0u; mine = (j == x) ? c : mine; }
        if (sum == G) break;
        __builtin_amdgcn_s_sleep(1);
        if ((++sp & 255u) == 0u) { if (xb_ld(&bar[XB_TMO])) break; if (sp > XB_SPIN_CAP) { atomicAdd(&bar[XB_TMO], 1u); break; } }
    }
    nloc = mine > 0u ? mine : 1u; nx = cnt > 0u ? cnt : 1u;
}

__device__ __forceinline__ void xcd_barrier(const XcdBarrier& b) {
    asm volatile("s_waitcnt vmcnt(0)" ::: "memory");
    __syncthreads();
    if (threadIdx.x == 0) {
        unsigned* bar = b.bar;
        __builtin_amdgcn_s_waitcnt(0);
        unsigned nloc = b.st[0], nx = b.st[1];
        if (nloc == 0u) { xcd_barrier_complete(bar, b.x, nloc, nx); b.st[0] = nloc; b.st[1] = nx; }
        const unsigned old = xb_add(&bar[XB_XSUB(b.x)], 1u);
        const unsigned gen = old / nloc;
        if (old + 1u == (gen + 1u) * nloc) {
            __builtin_amdgcn_fence(__ATOMIC_RELEASE, "agent");
            asm volatile("s_waitcnt vmcnt(0)" ::: "memory");
            const unsigned og = xb_add(&bar[XB_TOP], 1u);
            const unsigned tg = og / nx;
            if (og + 1u == (tg + 1u) * nx) xb_add(&bar[XB_TOPGEN], 1u);
            else XB_SPIN(xb_ld(&bar[XB_TOPGEN]) == tg, bar);
            __builtin_amdgcn_fence(__ATOMIC_ACQUIRE, "agent");
            xb_add(&bar[XB_XGEN(b.x)], 1u);
            asm volatile("s_waitcnt vmcnt(0)" ::: "memory");
        } else {
            XB_SPIN(xb_ld(&bar[XB_XGEN(b.x)]) == gen, bar);
            __builtin_amdgcn_fence(__ATOMIC_ACQUIRE, "agent");
            asm volatile("s_waitcnt vmcnt(0)" ::: "memory");
        }
    }
    __syncthreads();
}
using pg8::u32x4; using pg8::u32x2;
struct Frame {
    LAS unsigned char* lds;
    volatile LAS unsigned* MISC;
    gu32* ctl;
    int tid, lane, wave, G;
};
__device__ __forceinline__ float wave_sum(float v) {
#pragma unroll
    for (int o = 1; o < 64; o <<= 1) v += __shfl_xor(v, o);
    return v;
}
typedef _Float16 half_t;
__device__ __forceinline__ unsigned short f2h(float f) { half_t h = (half_t)f; return __builtin_bit_cast(unsigned short, h); }
__device__ __forceinline__ float h2f(unsigned short u) { return (float)__builtin_bit_cast(half_t, u); }
__device__ __forceinline__ float bf2f(unsigned short u) { return __builtin_bit_cast(float, (unsigned)u << 16); }

template <bool F16>
__device__ __forceinline__ void p0_transpose_item(const float* W, int K, int N, const float* gain, bf16* WT, LAS float* scr, int item, int lane) {
    const int nblk = (N + 31) / 32, kb = item / nblk, nb = item % nblk, k0 = 64 * kb, n0 = 32 * nb;
#pragma unroll 8
    for (int i = 0; i < 32; ++i) { const int kk = 2 * i + (lane >> 5); const int n = n0 + (lane & 31);
        float v = (n < N) ? W[(size_t)(k0 + kk) * N + n] : 0.f; if (gain) v *= gain[k0 + kk]; scr[kk * 33 + (lane & 31)] = v; }
    LDS_WAIT(); asm volatile("" ::: "memory");
    const int c = lane & 7;
#pragma unroll
    for (int j = 0; j < 4; ++j) { const int n = (lane >> 3) + 8 * j; const LAS float* s = scr + (8 * c) * 33 + n;
        v4u o;
        if (F16) { o.x = (unsigned)f2h(s[0 * 33]) | ((unsigned)f2h(s[1 * 33]) << 16); o.y = (unsigned)f2h(s[2 * 33]) | ((unsigned)f2h(s[3 * 33]) << 16);
                   o.z = (unsigned)f2h(s[4 * 33]) | ((unsigned)f2h(s[5 * 33]) << 16); o.w = (unsigned)f2h(s[6 * 33]) | ((unsigned)f2h(s[7 * 33]) << 16); }
        else { o.x = pk2(s[0 * 33], s[1 * 33]); o.y = pk2(s[2 * 33], s[3 * 33]); o.z = pk2(s[4 * 33], s[5 * 33]); o.w = pk2(s[6 * 33], s[7 * 33]); }
        *(GAS v4u*)(WT + (size_t)(n0 + n) * K + k0 + 8 * c) = o; }
    LDS_WAIT(); asm volatile("" ::: "memory");
}
struct Args { const void* in[15]; float* out; unsigned char* ws; float inv_a[8]; float inv_b[16]; int ph_lo, ph_hi; };

__device__ __forceinline__ void p0_prologue(Frame& F, const Args& A) {
    unsigned char* ws = A.ws;
    LAS float* scr = (LAS float*)(F.lds + F.wave * 16384);
    const int gw = blockIdx.x * NWAVES + F.wave, NGW = F.G * NWAVES, lane = F.lane;
    const float* attn_norm = (const float*)A.in[2]; const float* mlp_norm = (const float*)A.in[3];
    constexpr int I_AIN = 16 * 67, I_AOUT = 16 * 32, I_UP = 16 * 128, I_DN = 64 * 32, I_BIN = 16 * 21, I_QUP = 6 * 48, I_KVUP = 4 * 64, I_BOUT = 16 * 32;
    constexpr int NITEMS = I_AIN + I_AOUT + 2 * I_UP + 2 * I_DN + I_BIN + I_QUP + I_KVUP + I_BOUT;
    for (int it = gw; it < NITEMS; it += NGW) {
        int r = it;
        if (r < I_AIN) { p0_transpose_item<true>((const float*)A.in[4], 1024, A_IN, attn_norm, (bf16*)(ws + WS_WAIN), scr, r, lane); continue; } r -= I_AIN;
        if (r < I_AOUT) { p0_transpose_item<false>((const float*)A.in[5], 1024, 1024, nullptr, (bf16*)(ws + WS_WAOUT), scr, r, lane); continue; } r -= I_AOUT;
        if (r < I_UP) { p0_transpose_item<false>((const float*)A.in[12], 1024, 4096, mlp_norm, (bf16*)(ws + WS_WUP0), scr, r, lane); continue; } r -= I_UP;
        if (r < I_UP) { p0_transpose_item<false>((const float*)A.in[12] + (size_t)1024 * 4096, 1024, 4096, mlp_norm + 1024, (bf16*)(ws + WS_WUP1), scr, r, lane); continue; } r -= I_UP;
        if (r < I_DN) { p0_transpose_item<false>((const float*)A.in[13], 4096, 1024, nullptr, (bf16*)(ws + WS_WDN0), scr, r, lane); continue; } r -= I_DN;
        if (r < I_DN) { p0_transpose_item<false>((const float*)A.in[13] + (size_t)4096 * 1024, 4096, 1024, nullptr, (bf16*)(ws + WS_WDN1), scr, r, lane); continue; } r -= I_DN;
        if (r < I_BIN) { p0_transpose_item<false>((const float*)A.in[6], 1024, B_IN, attn_norm + 1024, (bf16*)(ws + WS_WBIN), scr, r, lane); continue; } r -= I_BIN;
        if (r < I_QUP) { p0_transpose_item<false>((const float*)A.in[9], QLORA, QUP, (const float*)A.in[7], (bf16*)(ws + WS_WQUP), scr, r, lane); continue; } r -= I_QUP;
        if (r < I_KVUP) { p0_transpose_item<false>((const float*)A.in[10], KVLORA, KVUP, (const float*)A.in[8], (bf16*)(ws + WS_WKVUP), scr, r, lane); continue; } r -= I_KVUP;
        p0_transpose_item<false>((const float*)A.in[11], 1024, 1024, nullptr, (bf16*)(ws + WS_WBOUT), scr, r, lane);
    }
    {   const int gt = gw * 64 + lane, NT = NGW * 64;
        GAS v4u* z1 = (GAS v4u*)(ws + WS_WAIN + (size_t)2144 * 1024 * 2); const int n1 = (A_INP - 2144) * 1024 * 2 / 16;
        for (int i = gt; i < n1; i += NT) z1[i] = (v4u){0u, 0u, 0u, 0u};
        GAS v4u* z2 = (GAS v4u*)(ws + WS_WBIN + (size_t)B_IN * 1024 * 2); const int n2 = (B_INP - B_IN) * 1024 * 2 / 16;
        for (int i = gt; i < n2; i += NT) z2[i] = (v4u){0u, 0u, 0u, 0u};
        const int* pos = (const int*)A.in[1];
        float* cA = (float*)(ws + WS_COSA); float* sA = (float*)(ws + WS_SINA); float* cB = (float*)(ws + WS_COSB); float* sB = (float*)(ws + WS_SINB);
        for (int i = gt; i < M * 8; i += NT) { const float ang = (float)pos[i >> 3] * A.inv_a[i & 7]; double rev = (double)ang * 0.15915494309189535; rev -= __builtin_rint(rev); const float fr = (float)rev;
            cA[i] = __builtin_amdgcn_cosf(fr); sA[i] = __builtin_amdgcn_sinf(fr); }
        for (int i = gt; i < M * 16; i += NT) { const float ang = (float)pos[i >> 4] * A.inv_b[i & 15]; double rev = (double)ang * 0.15915494309189535; rev -= __builtin_rint(rev); const float fr = (float)rev;
            cB[i] = __builtin_amdgcn_cosf(fr); sB[i] = __builtin_amdgcn_sinf(fr); }
    }
    const float* x = (const float*)A.in[0]; bf16* XB = (bf16*)(ws + WS_XB); float* SS = (float*)(ws + WS_SS);
    for (int m = gw; m < M; m += NGW) {
        const GAS f32x4* xr = (const GAS f32x4*)(x + (size_t)m * DM) + lane; f32x4 v[4]; float s = 0.f;
#pragma unroll
        for (int j = 0; j < 4; ++j) { v[j] = xr[64 * j]; s += (v[j].x * v[j].x + v[j].y * v[j].y) + (v[j].z * v[j].z + v[j].w * v[j].w); }
        s = wave_sum(s);
        GAS unsigned long long* o8 = (GAS unsigned long long*)(XB + (size_t)m * DM) + lane;
#pragma unroll
        for (int j = 0; j < 4; ++j) o8[64 * j] = (unsigned long long)((unsigned)f2h(v[j].x) | ((unsigned)f2h(v[j].y) << 16)) | ((unsigned long long)((unsigned)f2h(v[j].z) | ((unsigned)f2h(v[j].w) << 16)) << 32);
        if (lane < 16) SS[(size_t)m * 16 + lane] = (lane == 0) ? s : 0.f;
    }
}
__device__ __forceinline__ void p12_final_norm(Frame& F, const Args& A) {
    const int gw = blockIdx.x * NWAVES + F.wave, NGW = F.G * NWAVES, lane = F.lane;
    const float* g = (const float*)A.in[14]; const float* SS = (const float*)(A.ws + WS_SS);
    f32x4 gv[4];
#pragma unroll
    for (int j = 0; j < 4; ++j) gv[j] = ((const GAS f32x4*)g)[lane + 64 * j];
    for (int m = gw; m < M; m += NGW) {
        const float rs = pg8::rstd_from(SS + (size_t)m * 16, 4, 1.0f / 1024.0f);
        GAS f32x4* xr = (GAS f32x4*)(A.out + (size_t)m * DM) + lane;
#pragma unroll
        for (int j = 0; j < 4; ++j) { f32x4 v = xr[64 * j]; xr[64 * j] = v * rs * gv[j]; }
    }
}
namespace dsa {
typedef float f32x16 __attribute__((ext_vector_type(16)));
typedef _Float16 f16x8 __attribute__((ext_vector_type(8)));
typedef short s16x4 __attribute__((ext_vector_type(4)));
constexpr int KP = 144;
constexpr int MP = 65;
constexpr int LDS_MASK = 0, LDS_KV = 16896, KBYTES = 64 * KP, KV1 = KBYTES + 8192, KVBUF2 = 2 * KV1, LDS_Q = LDS_KV + 2 * KVBUF2, LDS_KI = LDS_KV, KIBUF = 256 * KP;
static_assert(64 * MP * 4 <= LDS_KV && LDS_Q + 8 * 4096 <= RING_BYTES && LDS_KI + 2 * KIBUF <= RING_BYTES, "dsa LDS map");
__device__ __forceinline__ unsigned sortable(float f) { const unsigned u = __builtin_bit_cast(unsigned, f); return (u & 0x80000000u) ? ~u : (u | 0x80000000u); }
__device__ __forceinline__ float xmax32(float m) { auto rr = __builtin_amdgcn_permlane32_swap(__float_as_uint(m), __float_as_uint(m), false, false); return fmaxf(__uint_as_float(rr[0]), __uint_as_float(rr[1])); }
__device__ __forceinline__ unsigned half_sum(unsigned v) {
#pragma unroll
    for (int o = 16; o >= 1; o >>= 1) v += (unsigned)__shfl_xor((int)v, o);
    return v;
}
__device__ __forceinline__ void cnt4(unsigned& cnt, unsigned a, unsigned b, unsigned c, unsigned d, unsigned cand) {
    unsigned long long m0, m1, m2, m3, co;
    asm volatile("v_cmp_ge_u32_e64 %1, %6, %10\n\tv_cmp_ge_u32_e64 %2, %7, %10\n\tv_cmp_ge_u32_e64 %3, %8, %10\n\tv_cmp_ge_u32_e64 %4, %9, %10\n\t"
                 "v_addc_co_u32_e64 %0, %5, 0, %0, %1\n\tv_addc_co_u32_e64 %0, %5, 0, %0, %2\n\tv_addc_co_u32_e64 %0, %5, 0, %0, %3\n\tv_addc_co_u32_e64 %0, %5, 0, %0, %4\n\ts_nop 1"
                 : "+v"(cnt), "=&s"(m0), "=&s"(m1), "=&s"(m2), "=&s"(m3), "=&s"(co) : "v"(a), "v"(b), "v"(c), "v"(d), "v"(cand));
}
__device__ __forceinline__ void index_select(LAS unsigned char* lds, LAS unsigned* maskQ, const bf16* PA, const float* WI, size_t row0, int qp0, int mp0, int tq, int nkt, int tid, int wid, int lane) {
    const int r32 = lane & 31, hh = lane >> 5;
    const int q0 = qp0 + 4 * wid, mrow0 = mp0 + 4 * wid;
    const int a_ = r32 & 3, hic = (r32 >> 2) & 1, bq = r32 >> 3; const int headA = a_ + 4 * (bq & 1), tlocA = 2 * hic + (bq >> 1);
    const bf16* ap = PA + (row0 + q0 + tlocA) * A_INP + 1536 + headA * 64 + 8 * hh;
    f16x8 qa[4];
#pragma unroll
    for (int ks = 0; ks < 4; ++ks) qa[ks] = *(const f16x8*)(ap + 16 * ks);
    float w[8];
    { const float* wq = WI + (row0 + q0 + 2 * hh + tq) * 8; const f32x4 wa = *(const f32x4*)wq, wb = *(const f32x4*)(wq + 4);
      w[0] = wa[0]; w[1] = wa[1]; w[2] = wa[2]; w[3] = wa[3]; w[4] = wb[0]; w[5] = wb[1]; w[6] = wb[2]; w[7] = wb[3]; }
    const int nch = (nkt + 7) >> 3;
    const int skey = tid >> 3, sc8 = tid & 7;
    const bf16* spc = PA + (row0 + skey) * A_INP + 2048 + sc8 * 8;
    v4u st[4];
#pragma unroll
    for (int i = 0; i < 4; ++i) st[i] = *(const v4u*)(spc + (size_t)(64 * i) * A_INP);
    LAS unsigned char* const stw = lds + LDS_KI + skey * KP + sc8 * 16;
    const LAS unsigned char* const krd = lds + LDS_KI + r32 * KP + hh * 16;
    unsigned sc[64];
    __syncthreads();
#pragma unroll
    for (int ch = 0; ch < 8; ++ch) {
        if (ch < nch) {
#pragma unroll
            for (int i = 0; i < 4; ++i) *(LAS v4u*)(stw + (ch & 1) * KIBUF + 64 * i * KP) = st[i];
            if (ch + 1 < nch) {
                spc += (size_t)256 * A_INP; asm volatile("" : "+v"(spc));
#pragma unroll
                for (int i = 0; i < 4; ++i) st[i] = *(const v4u*)(spc + (size_t)(64 * i) * A_INP); }
            __syncthreads();
#pragma unroll
            for (int k = 0; k < 8; ++k) {
                const int kt = 8 * ch + k;
                if (kt < nkt) {
                    const LAS unsigned char* kq = krd + (ch & 1) * KIBUF + 32 * k * KP;
                    f32x16 c = {};
#pragma unroll
                    for (int ks = 0; ks < 4; ++ks) c = __builtin_amdgcn_mfma_f32_32x32x16_f16(qa[ks], *(const LAS f16x8*)(kq + 32 * ks), c, 0, 0, 0);
                    float acc = 0.f;
                    if (tq == 0) {
#pragma unroll
                        for (int hd = 0; hd < 8; ++hd) acc = fmaf(w[hd], fmaxf(c[hd], 0.f), acc);
                    } else {
#pragma unroll
                        for (int hd = 0; hd < 8; ++hd) acc = fmaf(w[hd], fmaxf(c[hd + 8], 0.f), acc);
                    }
                    unsigned key = sortable(acc); asm volatile("" : "+v"(key)); sc[kt] = key;
                } else { sc[kt] = 0u; }
                __builtin_amdgcn_sched_barrier(0);
            }
        } else {
#pragma unroll
            for (int k = 0; k < 8; ++k) sc[8 * ch + k] = 0u;
        }
    }
    unsigned pre_lo = 0u, pre_hi = 0u, cge_lo = (unsigned)nkt * 32u, cge_hi = cge_lo; bool done_lo = false, done_hi = false;
    for (int bit = 31; bit >= 0; --bit) {
        const unsigned bm = 1u << bit;
        const unsigned cand = hh ? (pre_hi | bm) : (pre_lo | bm);
        unsigned cnt = 0u;
#pragma unroll
        for (int blk = 0; blk < 8; ++blk) if (nkt > 8 * blk) {
            cnt4(cnt, sc[8 * blk + 0], sc[8 * blk + 1], sc[8 * blk + 2], sc[8 * blk + 3], cand);
            cnt4(cnt, sc[8 * blk + 4], sc[8 * blk + 5], sc[8 * blk + 6], sc[8 * blk + 7], cand); }
        int v = (int)cnt;
        v += __builtin_amdgcn_update_dpp(0, v, 0xB1, 0xf, 0xf, true);
        v += __builtin_amdgcn_update_dpp(0, v, 0x4E, 0xf, 0xf, true);
        v += __builtin_amdgcn_update_dpp(0, v, 0x141, 0xf, 0xf, true);
        v += __builtin_amdgcn_update_dpp(0, v, 0x140, 0xf, 0xf, true);
        const unsigned n_lo = (unsigned)(__builtin_amdgcn_readlane(v, 0) + __builtin_amdgcn_readlane(v, 16));
        const unsigned n_hi = (unsigned)(__builtin_amdgcn_readlane(v, 32) + __builtin_amdgcn_readlane(v, 48));
        if (!done_lo && n_lo >= 256u) { pre_lo |= bm; cge_lo = n_lo; done_lo = (n_lo == 256u); }
        if (!done_hi && n_hi >= 256u) { pre_hi |= bm; cge_hi = n_hi; done_hi = (n_hi == 256u); }
        if (done_lo && done_hi) break;
    }
    const unsigned pre = hh ? pre_hi : pre_lo, cge = hh ? cge_hi : cge_lo;
    int ktc = 64; bool le = true;
    if (__any(cge > 256u)) {
        unsigned cnt = 0u;
#pragma unroll
        for (int kt = 0; kt < 64; ++kt) cnt += (sc[kt] > pre) ? 1u : 0u;
        cnt = half_sum(cnt);
        const int need = 256 - (int)cnt;
        int run = 0;
#pragma unroll
        for (int kt = 0; kt < 64; ++kt) {
            const unsigned long long b0 = __ballot(sc[kt] == pre);
            unsigned h0 = hh ? (unsigned)(b0 >> 32) : (unsigned)b0;
            const int n0 = __popc(h0);
            if (cge > 256u && run < need && run + n0 >= need) { for (int i = run + 1; i < need; ++i) h0 &= h0 - 1u; ktc = kt; le = r32 <= (__ffs((int)h0) - 1); }
            run += n0;
        }
    }
    LAS unsigned* const mq = maskQ + (mrow0 + tq) * MP;
#pragma unroll
    for (int kt = 0; kt < 64; ++kt) {
        if (kt < nkt) {
            const bool e0 = (kt < ktc) || (kt == ktc && le);
            const unsigned long long b0 = __ballot(sc[kt] > pre || (sc[kt] == pre && e0));
            if (lane == 0) { mq[kt] = (unsigned)b0; mq[2 * MP + kt] = (unsigned)(b0 >> 32); }
        }
    }
}
__device__ __forceinline__ void unit(LAS unsigned char* lds, const bf16* PA, const float* WI, bf16* OA, int b, int qblk) {
    int tid_ = threadIdx.x; asm volatile("" : "+v"(tid_));
    const int tid = tid_, lane = tid & 63, r32 = lane & 31, hh = lane >> 5; const int wid = __builtin_amdgcn_readfirstlane(tid >> 6);
    const size_t row0 = (size_t)b * SEQ;
    const int nkt = 2 * (qblk + 1), nk64 = qblk + 1;
    LAS unsigned* maskQ = (LAS unsigned*)(lds + LDS_MASK);
    __syncthreads();
    if (qblk < 4) { for (int i = tid; i < 64 * MP; i += 512) maskQ[i] = 0xFFFFFFFFu; }
    else {
#pragma unroll 1
        for (int p = 0; p < 4; ++p) index_select(lds, maskQ, PA, WI, row0, qblk * 64 + 32 * (p >> 1), 32 * (p >> 1), p & 1, nkt, tid, wid, lane);
    }
    const int qh = wid & 1, hp = (wid >> 1) & 1, gs = wid >> 2;
    const int qrow = qblk * 64 + 32 * qh + r32;
    const int skey = tid >> 3, sc8 = tid & 7;
    const unsigned kdst = LDS_KV + skey * KP + sc8 * 16, vdst = LDS_KV + KBYTES + (sc8 >> 2) * 4096 + (skey >> 3) * 512 + (skey & 7) * 64 + (sc8 & 3) * 16;
    const unsigned vb = (unsigned)(uintptr_t)(lds + LDS_KV + gs * KV1 + KBYTES) + ((lane >> 4) & 1) * 32 + (lane & 3) * 8 + (4 * hh + ((lane & 15) >> 2)) * 64;
    const LAS unsigned* mrow = maskQ + (32 * qh + r32) * MP;
#pragma unroll 1
    for (int gp = 0; gp < 2; ++gp) {
        const int hq0 = 4 * (2 * gp + gs) + 2 * hp;
        const bf16* qp = PA + (row0 + qrow) * A_INP + hq0 * 64 + 8 * hh;
        f16x8 qf[4];
        LAS unsigned char* const qpark = lds + LDS_Q + wid * 4096 + lane * 16;
        f16x8 q1t[4];
#pragma unroll
        for (int ks = 0; ks < 4; ++ks) { qf[ks] = *(const f16x8*)(qp + 16 * ks); q1t[ks] = *(const f16x8*)(qp + 64 + 16 * ks); }
        const bf16* kg = PA + (row0 + skey) * A_INP + 1024 + (2 * gp) * 64 + sc8 * 8;
        v4u kreg0 = *(const v4u*)kg, kreg1 = *(const v4u*)(kg + 64), vreg0 = *(const v4u*)(kg + 256), vreg1 = *(const v4u*)(kg + 320);
        f32x16 o00 = {}, o01 = {}, o10 = {}, o11 = {}; float mrun0 = -INFINITY, mrun1 = -INFINITY, lrun0 = 0.f, lrun1 = 0.f;
        __syncthreads();
#pragma unroll
        for (int ks = 0; ks < 4; ++ks) *(LAS f16x8*)(qpark + ks * 1024) = q1t[ks];
#pragma unroll 1
        for (int kt = 0; kt < nk64; ++kt) {
            const unsigned bo = (kt & 1) * KVBUF2;
            *(LAS v4u*)(lds + kdst + bo) = kreg0; *(LAS v4u*)(lds + kdst + bo + KV1) = kreg1; *(LAS v4u*)(lds + vdst + bo) = vreg0; *(LAS v4u*)(lds + vdst + bo + KV1) = vreg1;
            __syncthreads();
            const LAS unsigned char* kb = lds + LDS_KV + bo + gs * KV1;
            f32x16 p00 = {}, p01 = {}, p10 = {}, p11 = {};
#pragma unroll
            for (int ks = 0; ks < 4; ++ks) {
                const f16x8 k0 = *(const LAS f16x8*)(kb + r32 * KP + ks * 32 + hh * 16);
                const f16x8 k1 = *(const LAS f16x8*)(kb + (32 + r32) * KP + ks * 32 + hh * 16);
                const f16x8 q1 = *(const LAS f16x8*)(qpark + ks * 1024);
                p00 = __builtin_amdgcn_mfma_f32_32x32x16_f16(k0, qf[ks], p00, 0, 0, 0);
                p01 = __builtin_amdgcn_mfma_f32_32x32x16_f16(k1, qf[ks], p01, 0, 0, 0);
                p10 = __builtin_amdgcn_mfma_f32_32x32x16_f16(k0, q1, p10, 0, 0, 0);
                p11 = __builtin_amdgcn_mfma_f32_32x32x16_f16(k1, q1, p11, 0, 0, 0);
                if (ks == 1) __builtin_amdgcn_sched_barrier(0);
            }
            const int w0 = (int)(mrow[2 * kt] >> (4 * hh)), w1 = (int)(mrow[2 * kt + 1] >> (4 * hh));
            f16x8 pa0[4], pa1[4];
#define DSA_PKP(P, S, J) __builtin_bit_cast(unsigned, __builtin_amdgcn_cvt_pkrtz(P[8 * (S) + 2 * (J)], P[8 * (S) + 2 * (J) + 1]))
#define DSA_SOFTMAX(PA, PB, OA_, OB_, MRUN, LRUN, PAV) do { \
            float mx = fmaxf(PA[0], PB[0]); \
            _Pragma("unroll") for (int r = 1; r < 16; ++r) mx = fmaxf(fmaxf(mx, PA[r]), PB[r]); \
            mx = xmax32(mx); \
            const float mn = fmaxf(MRUN, mx); \
            if (__any(mn > MRUN)) { const float al = __builtin_amdgcn_exp2f(MRUN - mn); LRUN *= al; \
                _Pragma("unroll") for (int r = 0; r < 16; ++r) { OA_[r] *= al; OB_[r] *= al; } } \
            MRUN = mn; \
            float ls = 0.f; \
            _Pragma("unroll") for (int r = 0; r < 16; ++r) { const int cr = (r & 3) + 8 * (r >> 2); \
                PA[r] = __builtin_bit_cast(float, __builtin_bit_cast(int, __builtin_amdgcn_exp2f(PA[r] - mn)) & __builtin_amdgcn_sbfe(w0, cr, 1)); \
                PB[r] = __builtin_bit_cast(float, __builtin_bit_cast(int, __builtin_amdgcn_exp2f(PB[r] - mn)) & __builtin_amdgcn_sbfe(w1, cr, 1)); \
                ls += PA[r] + PB[r]; } \
            LRUN += ls; \
            _Pragma("unroll") for (int s2 = 0; s2 < 2; ++s2) { u32x4 x; \
                x.x = DSA_PKP(PA, s2, 0); x.y = DSA_PKP(PA, s2, 1); x.z = DSA_PKP(PA, s2, 2); x.w = DSA_PKP(PA, s2, 3); PAV[s2] = __builtin_bit_cast(f16x8, x); \
                x.x = DSA_PKP(PB, s2, 0); x.y = DSA_PKP(PB, s2, 1); x.z = DSA_PKP(PB, s2, 2); x.w = DSA_PKP(PB, s2, 3); PAV[2 + s2] = __builtin_bit_cast(f16x8, x); } \
            __builtin_amdgcn_sched_barrier(0); } while (0)
            DSA_SOFTMAX(p00, p01, o00, o01, mrun0, lrun0, pa0);
            DSA_SOFTMAX(p10, p11, o10, o11, mrun1, lrun1, pa1);
#undef DSA_SOFTMAX
#undef DSA_PKP
            if (kt + 1 < nk64) { const bf16* kn = kg + (size_t)(kt + 1) * 64 * A_INP; kreg0 = *(const v4u*)kn; kreg1 = *(const v4u*)(kn + 64); vreg0 = *(const v4u*)(kn + 256); vreg1 = *(const v4u*)(kn + 320); }
            const unsigned vbt = vb + bo;
#pragma unroll
            for (int d0 = 0; d0 < 2; ++d0) {
                s16x4 lo[4], hi4[4];
#pragma unroll
                for (int ks = 0; ks < 4; ++ks) {
                    asm volatile("ds_read_b64_tr_b16 %0,%1 offset:%c2" : "=&v"(lo[ks]) : "v"(vbt), "i"(d0 * 4096 + ks * 1024) : "memory");
                    asm volatile("ds_read_b64_tr_b16 %0,%1 offset:%c2" : "=&v"(hi4[ks]) : "v"(vbt), "i"(d0 * 4096 + ks * 1024 + 512) : "memory"); }
                asm volatile("s_waitcnt lgkmcnt(0)" ::: "memory"); __builtin_amdgcn_sched_barrier(0);
#define DSA_PK(k) __builtin_bit_cast(f16x8, (bf16x8){lo[k][0], lo[k][1], lo[k][2], lo[k][3], hi4[k][0], hi4[k][1], hi4[k][2], hi4[k][3]})
                if (d0 == 0) {
#pragma unroll
                    for (int k = 0; k < 4; ++k) { o00 = __builtin_amdgcn_mfma_f32_32x32x16_f16(DSA_PK(k), pa0[k], o00, 0, 0, 0); o10 = __builtin_amdgcn_mfma_f32_32x32x16_f16(DSA_PK(k), pa1[k], o10, 0, 0, 0); }
                } else {
#pragma unroll
                    for (int k = 0; k < 4; ++k) { o01 = __builtin_amdgcn_mfma_f32_32x32x16_f16(DSA_PK(k), pa0[k], o01, 0, 0, 0); o11 = __builtin_amdgcn_mfma_f32_32x32x16_f16(DSA_PK(k), pa1[k], o11, 0, 0, 0); }
                }
#undef DSA_PK
            }
        }
        lrun0 += __shfl_xor(lrun0, 32); lrun1 += __shfl_xor(lrun1, 32);
        const float inv0 = 1.0f / lrun0, inv1 = 1.0f / lrun1;
        bf16* op = OA + (row0 + qrow) * DM + hq0 * 64 + 4 * hh;
#pragma unroll
        for (int gq = 0; gq < 4; ++gq) {
            u32x2 x;
            x.x = pg8::cvt_pk_bf16(o00[4 * gq] * inv0, o00[4 * gq + 1] * inv0); x.y = pg8::cvt_pk_bf16(o00[4 * gq + 2] * inv0, o00[4 * gq + 3] * inv0); *(u32x2*)(op + 8 * gq) = x;
            x.x = pg8::cvt_pk_bf16(o01[4 * gq] * inv0, o01[4 * gq + 1] * inv0); x.y = pg8::cvt_pk_bf16(o01[4 * gq + 2] * inv0, o01[4 * gq + 3] * inv0); *(u32x2*)(op + 32 + 8 * gq) = x;
            x.x = pg8::cvt_pk_bf16(o10[4 * gq] * inv1, o10[4 * gq + 1] * inv1); x.y = pg8::cvt_pk_bf16(o10[4 * gq + 2] * inv1, o10[4 * gq + 3] * inv1); *(u32x2*)(op + 64 + 8 * gq) = x;
            x.x = pg8::cvt_pk_bf16(o11[4 * gq] * inv1, o11[4 * gq + 1] * inv1); x.y = pg8::cvt_pk_bf16(o11[4 * gq + 2] * inv1, o11[4 * gq + 3] * inv1); *(u32x2*)(op + 96 + 8 * gq) = x;
        }
    }
}
__device__ __forceinline__ void phase(Frame& F, const Args& A) {
    const bf16* PA = (const bf16*)(A.ws + WS_PA); const float* WI = (const float*)(A.ws + WS_WI); bf16* OA = (bf16*)(A.ws + WS_OA);
    for (int u = blockIdx.x; u < 256; u += F.G) { const int b = u >> 4, j = u & 15; unit(F.lds, PA, WI, OA, b, 31 - j); unit(F.lds, PA, WI, OA, b, j); }
}
}
namespace mla {
typedef float f32x16 __attribute__((ext_vector_type(16)));
typedef short s16x4 __attribute__((ext_vector_type(4)));
constexpr int KP = 208;
constexpr int LDS_K = 0, LDS_V = 64 * KP, BUFB = LDS_V + 8192, LDS_END = 2 * BUFB;
__device__ __forceinline__ float xmax32(float m) { auto rr = __builtin_amdgcn_permlane32_swap(__float_as_uint(m), __float_as_uint(m), false, false); return fmaxf(__uint_as_float(rr[0]), __uint_as_float(rr[1])); }
__device__ __forceinline__ void attn_unit(LAS unsigned char* lds, const bf16* QB, const bf16* KVB, const bf16* CB, bf16* OB, int b, int h, int qb) {
    const int tid = threadIdx.x, lane = tid & 63, r32 = lane & 31, hi = lane >> 5; const int wid = __builtin_amdgcn_readfirstlane(tid >> 6);
    const int c0 = qb * 4, cw = c0 + (wid >> 1), ntile = c0 + 4;
    const size_t row0 = (size_t)b * SEQ;
    const bf16* qp = QB + (row0 + (size_t)qb * 256 + wid * 32 + r32) * QUP + h * 96 + hi * 8;
    bf16x8 qf[6];
#pragma unroll
    for (int ks = 0; ks < 6; ++ks) qf[ks] = *(const bf16x8*)(qp + ks * 16);
    f32x16 o0 = {}, o1 = {}; float mrun = -INFINITY, lrun = 0.f;
    const unsigned vb = (unsigned)(uintptr_t)(lds + LDS_V) + ((lane >> 4) & 1) * 32 + (lane & 3) * 8 + (4 * hi + ((lane & 15) >> 2)) * 64;
    const int ka = tid / 12, kca = tid % 12, kb_ = (tid + 512) / 12, kcb = (tid + 512) % 12; const bool has2 = tid < 256;
    const bf16* ksa = (kca < 8) ? (KVB + (row0 + ka) * KVUP + h * 128 + kca * 8) : (CB + (row0 + ka) * B_INP + 640 + (kca - 8) * 8);
    const bf16* ksb = (kcb < 8) ? (KVB + (row0 + kb_) * KVUP + h * 128 + kcb * 8) : (CB + (row0 + kb_) * B_INP + 640 + (kcb - 8) * 8);
    const size_t stepa = (size_t)64 * ((kca < 8) ? KVUP : B_INP), stepb = (size_t)64 * ((kcb < 8) ? KVUP : B_INP);
    const bf16* vs = KVB + (row0 + (tid >> 3)) * KVUP + h * 128 + 64 + (tid & 7) * 8;
    const unsigned kda = LDS_K + ka * KP + kca * 16, kdb = LDS_K + kb_ * KP + kcb * 16;
    const unsigned vd = LDS_V + ((tid & 7) >> 2) * 4096 + ((tid >> 3) >> 3) * 512 + ((tid >> 3) & 7) * 64 + (tid & 3) * 16;
    v4u ra = *(const v4u*)ksa, rb = has2 ? *(const v4u*)ksb : (v4u){0u, 0u, 0u, 0u}, rv = *(const v4u*)vs;
    __syncthreads();
    for (int kt = 0; kt < ntile; ++kt) {
        const unsigned bo = (kt & 1) * BUFB;
        *(LAS v4u*)(lds + kda + bo) = ra; if (has2) *(LAS v4u*)(lds + kdb + bo) = rb; *(LAS v4u*)(lds + vd + bo) = rv;
        if (kt + 1 < ntile) { ra = *(const v4u*)(ksa + (size_t)(kt + 1) * stepa); if (has2) rb = *(const v4u*)(ksb + (size_t)(kt + 1) * stepb); rv = *(const v4u*)(vs + (size_t)(kt + 1) * 64 * KVUP); }
        __syncthreads();
        if (kt <= cw) {
            f32x16 p0 = {}, p1 = {};
#pragma unroll
            for (int ks = 0; ks < 6; ++ks) {
                const bf16x8 k0 = *(const LAS bf16x8*)(lds + bo + LDS_K + r32 * KP + ks * 32 + hi * 16);
                const bf16x8 k1 = *(const LAS bf16x8*)(lds + bo + LDS_K + (32 + r32) * KP + ks * 32 + hi * 16);
                p0 = __builtin_amdgcn_mfma_f32_32x32x16_bf16(k0, qf[ks], p0, 0, 0, 0);
                p1 = __builtin_amdgcn_mfma_f32_32x32x16_bf16(k1, qf[ks], p1, 0, 0, 0);
            }
            float mx = fmaxf(p0[0], p1[0]);
#pragma unroll
            for (int r = 1; r < 16; ++r) mx = fmaxf(mx, fmaxf(p0[r], p1[r]));
            mx = xmax32(mx);
            const float mn = fmaxf(mrun, mx);
            if (__any(mn > mrun)) { const float alpha = __builtin_amdgcn_exp2f(mrun - mn); lrun *= alpha;
#pragma unroll
                for (int r = 0; r < 16; ++r) { o0[r] *= alpha; o1[r] *= alpha; } }
            mrun = mn;
            float ls = 0.f;
#pragma unroll
            for (int r = 0; r < 16; ++r) { p0[r] = __builtin_amdgcn_exp2f(p0[r] - mn); p1[r] = __builtin_amdgcn_exp2f(p1[r] - mn); ls += p0[r] + p1[r]; }
            lrun += ls;
            const unsigned vbt = vb + bo;
            bf16x8 pa[4];
#pragma unroll
            for (int s = 0; s < 2; ++s) {
                u32x4 w0, w1;
                w0.x = pg8::cvt_pk_bf16(p0[8 * s + 0], p0[8 * s + 1]); w0.y = pg8::cvt_pk_bf16(p0[8 * s + 2], p0[8 * s + 3]); w0.z = pg8::cvt_pk_bf16(p0[8 * s + 4], p0[8 * s + 5]); w0.w = pg8::cvt_pk_bf16(p0[8 * s + 6], p0[8 * s + 7]);
                w1.x = pg8::cvt_pk_bf16(p1[8 * s + 0], p1[8 * s + 1]); w1.y = pg8::cvt_pk_bf16(p1[8 * s + 2], p1[8 * s + 3]); w1.z = pg8::cvt_pk_bf16(p1[8 * s + 4], p1[8 * s + 5]); w1.w = pg8::cvt_pk_bf16(p1[8 * s + 6], p1[8 * s + 7]);
                pa[s] = __builtin_bit_cast(bf16x8, w0); pa[2 + s] = __builtin_bit_cast(bf16x8, w1);
            }
#pragma unroll
            for (int d0 = 0; d0 < 2; ++d0) {
                s16x4 lo[4], hi4[4];
#pragma unroll
                for (int ks = 0; ks < 4; ++ks) {
                    asm volatile("ds_read_b64_tr_b16 %0,%1 offset:%c2" : "=&v"(lo[ks]) : "v"(vbt), "i"(d0 * 4096 + ks * 1024) : "memory");
                    asm volatile("ds_read_b64_tr_b16 %0,%1 offset:%c2" : "=&v"(hi4[ks]) : "v"(vbt), "i"(d0 * 4096 + ks * 1024 + 512) : "memory"); }
                asm volatile("s_waitcnt lgkmcnt(0)" ::: "memory"); __builtin_amdgcn_sched_barrier(0);
#define MLA_PK(k) (bf16x8){lo[k][0], lo[k][1], lo[k][2], lo[k][3], hi4[k][0], hi4[k][1], hi4[k][2], hi4[k][3]}
                if (d0 == 0) { o0 = __builtin_amdgcn_mfma_f32_32x32x16_bf16(MLA_PK(0), pa[0], o0, 0, 0, 0); o0 = __builtin_amdgcn_mfma_f32_32x32x16_bf16(MLA_PK(1), pa[1], o0, 0, 0, 0);
                               o0 = __builtin_amdgcn_mfma_f32_32x32x16_bf16(MLA_PK(2), pa[2], o0, 0, 0, 0); o0 = __builtin_amdgcn_mfma_f32_32x32x16_bf16(MLA_PK(3), pa[3], o0, 0, 0, 0); }
                else         { o1 = __builtin_amdgcn_mfma_f32_32x32x16_bf16(MLA_PK(0), pa[0], o1, 0, 0, 0); o1 = __builtin_amdgcn_mfma_f32_32x32x16_bf16(MLA_PK(1), pa[1], o1, 0, 0, 0);
                               o1 = __builtin_amdgcn_mfma_f32_32x32x16_bf16(MLA_PK(2), pa[2], o1, 0, 0, 0); o1 = __builtin_amdgcn_mfma_f32_32x32x16_bf16(MLA_PK(3), pa[3], o1, 0, 0, 0); }
#undef MLA_PK
            }
        }
    }
    lrun += __shfl_xor(lrun, 32);
    const float inv = 1.0f / lrun;
    bf16* op = OB + (row0 + (size_t)qb * 256 + wid * 32 + r32) * DM + h * 64 + 4 * hi;
#pragma unroll
    for (int g = 0; g < 4; ++g) {
        u32x2 w; w.x = pg8::cvt_pk_bf16(o0[4 * g] * inv, o0[4 * g + 1] * inv); w.y = pg8::cvt_pk_bf16(o0[4 * g + 2] * inv, o0[4 * g + 3] * inv); *(u32x2*)(op + 8 * g) = w;
        u32x2 z; z.x = pg8::cvt_pk_bf16(o1[4 * g] * inv, o1[4 * g + 1] * inv); z.y = pg8::cvt_pk_bf16(o1[4 * g + 2] * inv, o1[4 * g + 3] * inv); *(u32x2*)(op + 32 + 8 * g) = z;
    }
}
__device__ __forceinline__ void attn_phase(Frame& F, const Args& A) {
    const bf16* QB = (const bf16*)(A.ws + WS_QB); const bf16* KVB = (const bf16*)(A.ws + WS_KVB); const bf16* CB = (const bf16*)(A.ws + WS_CB); bf16* OB = (bf16*)(A.ws + WS_OB);
    for (int u = blockIdx.x; u < BATCH * 16 * 8; u += F.G) { const int bh = u & 255, qb = u >> 8; attn_unit(F.lds, QB, KVB, CB, OB, bh >> 4, bh & 15, qb); }
}
}
__global__ void __launch_bounds__(NWAVES * 64, 2) mk_fwd(Args args) {
    extern __shared__ __attribute__((aligned(16))) unsigned char lds_raw[];
    Frame F;
    F.lds = (LAS unsigned char*)lds_raw;
    F.MISC = (volatile LAS unsigned*)(F.lds + MISC_OFF);
    F.tid = threadIdx.x; F.lane = F.tid & 63; F.wave = __builtin_amdgcn_readfirstlane(F.tid >> 6);
    F.G = gridDim.x;
    unsigned char* ws = args.ws;
    F.ctl = (gu32*)(ws + WS_CTL);
    for (int u = F.tid; u < (LDS_BYTES - LDSCTL_OFF) / 4; u += NWAVES * 64) ((LAS unsigned*)(F.lds + LDSCTL_OFF))[u] = 0u;
    __syncthreads();
    XcdBarrier bar; bar.bar = (unsigned*)(F.ctl + CW_BAR); bar.x = 0; bar.st = nullptr;
    if (N_LAUNCHES == 1) bar = xcd_barrier_post((unsigned*)(F.ctl + CW_BAR), F.MISC + 8);
#define GRID_BAR() do { if (N_LAUNCHES == 1) xcd_barrier(bar); } while (0)
    const int lo = args.ph_lo, hi = args.ph_hi;
#ifndef PHMASK
#define PHMASK 0x1fff
#endif
#define IN(k) (((PHMASK >> (k)) & 1) && lo <= (k) && (k) < hi)
    bf16* const XB = (bf16*)(ws + WS_XB); float* const SS = (float*)(ws + WS_SS); float* const SSB = (float*)(ws + WS_SSB);
    const float* const cosA = (const float*)(ws + WS_COSA); const float* const sinA = (const float*)(ws + WS_SINA);
    const float* const cosB = (const float*)(ws + WS_COSB); const float* const sinB = (const float*)(ws + WS_SINB);
    const int bid = (int)blockIdx.x;

    if (IN(0)) { p0_prologue(F, args); GRID_BAR(); }
    if (IN(1)) {
        pg8::Gemm g{XB, (const bf16*)(ws + WS_WAIN), M, A_INP, DM, DM, DM}; pg8::StaticOrder S; S.init(M, A_INP, F.G, bid);
        pg8::EpiDsaIn E{(bf16*)(ws + WS_PA), (float*)(ws + WS_WI), SS, cosA, sinA, IDX_WSCALE, QSCALE_A};
        pg8::gemm_phase<pg8::EpiDsaIn, pg8::StaticOrder, true, true, true>(F.lds, g, S, E);
        GRID_BAR();
    }
    if (IN(2)) { dsa::phase(F, args); GRID_BAR(); }
#if defined(PROBE_DUP) && PROBE_DUP == 2
    if (IN(2)) { dsa::phase(F, args); GRID_BAR(); }
#endif
    if (IN(3)) {
        pg8::Gemm g{(const bf16*)(ws + WS_OA), (const bf16*)(ws + WS_WAOUT), M, DM, DM, DM, DM}; pg8::StaticOrder S; S.init(M, DM, F.G, bid);
        pg8::EpiResid E{(const float*)args.in[0], args.out, XB, SS};
        pg8::gemm_phase<pg8::EpiResid, pg8::StaticOrder, true, true, false>(F.lds, g, S, E);
        GRID_BAR();
    }
    if (IN(4)) {
        pg8::Gemm g{XB, (const bf16*)(ws + WS_WUP0), M, FF, DM, DM, DM}; pg8::StaticOrder S; S.init(M, FF, F.G, bid);
        pg8::EpiMlpUp E{(bf16*)(ws + WS_H), SS};
        pg8::gemm_phase<pg8::EpiMlpUp, pg8::StaticOrder, true, true, false>(F.lds, g, S, E);
        GRID_BAR();
    }
    if (IN(5)) {
        pg8::Gemm g{(const bf16*)(ws + WS_H), (const bf16*)(ws + WS_WDN0), M, DM, FF, FF, FF}; pg8::StaticOrder S; S.init(M, DM, F.G, bid);
        pg8::EpiResid E{args.out, args.out, XB, SS};
        pg8::gemm_phase<pg8::EpiResid, pg8::StaticOrder, true, true, false>(F.lds, g, S, E);
        GRID_BAR();
    }
    if (IN(6)) {
        pg8::Gemm g{XB, (const bf16*)(ws + WS_WBIN), M, B_INP, DM, DM, DM}; pg8::StaticOrder S; S.init(M, B_INP, F.G, bid);
        pg8::EpiMlaIn E{(bf16*)(ws + WS_CB), SSB, SS, cosB, sinB};
        pg8::gemm_phase<pg8::EpiMlaIn, pg8::StaticOrder, true, true, false>(F.lds, g, S, E);
        GRID_BAR();
    }
    if (IN(7)) {
#ifndef NO_QUP
        { pg8::Gemm g{(const bf16*)(ws + WS_CB), (const bf16*)(ws + WS_WQUP), M, QUP, QLORA, B_INP, QLORA}; pg8::StaticOrder S; S.init(M, QUP, F.G, bid);
          pg8::EpiQUp E{(bf16*)(ws + WS_QB), SSB, cosB, sinB, QSCALE_B};
          pg8::gemm_phase<pg8::EpiQUp, pg8::StaticOrder, true, true, false>(F.lds, g, S, E); }
#endif
#ifndef NO_KVUP
        { pg8::Gemm g{(const bf16*)(ws + WS_CB) + QLORA, (const bf16*)(ws + WS_WKVUP), M, KVUP, KVLORA, B_INP, KVLORA}; pg8::StaticOrder S; S.init(M, KVUP, F.G, bid);
          pg8::EpiKvUp E{(bf16*)(ws + WS_KVB), SSB};
          pg8::gemm_phase<pg8::EpiKvUp, pg8::StaticOrder, true, true, false>(F.lds, g, S, E); }
#endif
        GRID_BAR();
    }
    if (IN(8)) { mla::attn_phase(F, args); GRID_BAR(); }
#if defined(PROBE_DUP) && PROBE_DUP == 8
    if (IN(8)) { mla::attn_phase(F, args); GRID_BAR(); }
#endif
    if (IN(9)) {
        pg8::Gemm g{(const bf16*)(ws + WS_OB), (const bf16*)(ws + WS_WBOUT), M, DM, DM, DM, DM}; pg8::StaticOrder S; S.init(M, DM, F.G, bid);
        pg8::EpiResid E{args.out, args.out, XB, SS};
        pg8::gemm_phase<pg8::EpiResid, pg8::StaticOrder, true, true, false>(F.lds, g, S, E);
        GRID_BAR();
    }
    if (IN(10)) {
        pg8::Gemm g{XB, (const bf16*)(ws + WS_WUP1), M, FF, DM, DM, DM}; pg8::StaticOrder S; S.init(M, FF, F.G, bid);
        pg8::EpiMlpUp E{(bf16*)(ws + WS_H), SS};
        pg8::gemm_phase<pg8::EpiMlpUp, pg8::StaticOrder, true, true, false>(F.lds, g, S, E);
        GRID_BAR();
    }
    if (IN(11)) {
        pg8::Gemm g{(const bf16*)(ws + WS_H), (const bf16*)(ws + WS_WDN1), M, DM, FF, FF, FF}; pg8::StaticOrder S; S.init(M, DM, F.G, bid);
        pg8::EpiResid E{args.out, args.out, nullptr, SS};
        pg8::gemm_phase<pg8::EpiResid, pg8::StaticOrder, true, true, false>(F.lds, g, S, E);
        GRID_BAR();
    }
    if (IN(12)) { p12_final_norm(F, args); }
#undef IN
#undef GRID_BAR
}

extern "C" void kernel_launch(void* const* d_in, const int* in_sizes, int n_in, void* d_out, int out_size, void* d_ws, size_t ws_size, hipStream_t stream) {
    static int grid = 0;
    if (grid == 0) {
        if (n_in != 15 || in_sizes[0] != M * DM || out_size != M * DM || ws_size < WS_END) { fprintf(stderr, "kernel_launch: unexpected shapes / workspace (n_in %d, in0 %d, out %d, ws %zu); nothing launched\n", n_in, n_in > 0 ? in_sizes[0] : -1, out_size, ws_size); grid = -1; return; }
        int dev = 0, cus = 0, per_cu = 0;
        if (hipGetDevice(&dev) != hipSuccess || hipDeviceGetAttribute(&cus, hipDeviceAttributeMultiprocessorCount, dev) != hipSuccess) { grid = -1; return; }
        if (hipFuncSetAttribute((const void*)mk_fwd, hipFuncAttributeMaxDynamicSharedMemorySize, LDS_BYTES) != hipSuccess) { fprintf(stderr, "kernel_launch: hipFuncSetAttribute failed\n"); grid = -1; return; }
        if (hipOccupancyMaxActiveBlocksPerMultiprocessor(&per_cu, (const void*)mk_fwd, NWAVES * 64, LDS_BYTES) != hipSuccess || per_cu < 1) { fprintf(stderr, "kernel_launch: occupancy query reports %d blocks per CU\n", per_cu); }
        (void)hipGetLastError();
        grid = cus;
    }
    if (grid < 0) return;
    if (hipMemsetAsync((char*)d_ws + WS_CTL, 0, CTL_ZERO_BYTES, stream) != hipSuccess) return;
    Args a{};
    for (int i = 0; i < 15; ++i) a.in[i] = d_in[i];
    a.out = (float*)d_out; a.ws = (unsigned char*)d_ws;
    for (int i = 0; i < 8; ++i) a.inv_a[i] = (float)pow(500000.0, -(double)i / 8.0);
    for (int i = 0; i < 16; ++i) a.inv_b[i] = (float)pow(500000.0, -(double)i / 16.0);
    if (N_LAUNCHES == 1) { a.ph_lo = 0; a.ph_hi = N_PHASES; hipLaunchKernelGGL(mk_fwd, dim3(grid), dim3(NWAVES * 64), LDS_BYTES, stream, a); }
    else for (int li = 0; li < N_PHASES; ++li) { a.ph_lo = li; a.ph_hi = li + 1; hipLaunchKernelGGL(mk_fwd, dim3(grid), dim3(NWAVES * 64), LDS_BYTES, stream, a); }
    const hipError_t le = hipPeekAtLastError();
    if (le != hipSuccess) fprintf(stderr, "kernel_launch: launch failed: %s\n", hipGetErrorName(le));
}
```

```cpp
#include <hip/hip_runtime.h>
#include <cstdio>
#include <cstdint>
#include <cmath>
namespace pg8 {
#define PG8_LAS __attribute__((address_space(3)))
typedef unsigned short bf16_t;
typedef short bf16x8 __attribute__((ext_vector_type(8)));
typedef float f32x4 __attribute__((ext_vector_type(4)));
typedef unsigned u32x4 __attribute__((ext_vector_type(4)));
constexpr int BM = 256, BK = 64, HALF = 128, HTB = HALF * BK * 2  , STAGE_BYTES = 8 * HTB, NXCD = 8, WGM = 8;

__host__ __device__ __forceinline__ int lds_byte(int r, int c) { const int st = (r >> 4) * 2 + (c >> 5), rr = r & 15, cc = c & 31, ob = rr * 64 + cc * 2; return st * 1024 + (ob ^ (((ob >> 9) & 1) << 5)); }
__host__ __device__ __forceinline__ void stage_rc(int b, int& R, int& C) { const int st = b / 1024, sb = b % 1024, swz = sb ^ (((sb >> 9) & 1) << 5); R = (st >> 1) * 16 + swz / 64; C = (st & 1) * 32 + (swz % 64) / 2; }
__host__ __device__ __forceinline__ int perm32(int rho) { const int n = rho >> 4, i = rho & 15; return 8 * (i >> 2) + 4 * n + (i & 3); }

struct Unit { int pm, pn; };
struct Gemm { const bf16_t* A; const bf16_t* Bt; int M, N, K, lda, ldb; };

struct StaticOrder {
    int nM, nN, nwg, G, c;
    __host__ __device__ void init(int M, int N, int G_, int c_) { nM = M / BM; nN = N / BM; nwg = nM * nN; G = G_; c = c_; }
    __host__ __device__ bool next(int i, Unit& u) const {
        const long L = (long)i * G + c; if (L >= nwg) return false;
        int wgid = (int)L; { const int q = nwg / NXCD, r = nwg % NXCD, xcd = wgid % NXCD, off = wgid / NXCD; wgid = (xcd < r ? xcd * (q + 1) : r * (q + 1) + (xcd - r) * q) + off; }
        const int nig = WGM * nN, gid = wgid / nig, fm = gid * WGM, gsz = (nM - fm) < WGM ? (nM - fm) : WGM;
        u.pm = fm + ((wgid % nig) % gsz); u.pn = (wgid % nig) / gsz; return true;
    }
    __device__ __forceinline__ void a_ready(const Unit&) const {}
    __device__ __forceinline__ void done(const Unit&) const {}
};

__device__ __forceinline__ unsigned cvt_pk_bf16(float lo, float hi) { unsigned r; asm volatile("v_cvt_pk_bf16_f32 %0, %1, %2" : "=v"(r) : "v"(lo), "v"(hi)); return r; }
typedef _Float16 f16x8_t __attribute__((ext_vector_type(8)));
typedef _Float16 f16x2_t __attribute__((ext_vector_type(2)));
template <bool F16> __device__ __forceinline__ f32x4 mma16(bf16x8 a, bf16x8 b, f32x4 c) {
    if constexpr (F16) return __builtin_amdgcn_mfma_f32_16x16x32_f16(__builtin_bit_cast(f16x8_t, a), __builtin_bit_cast(f16x8_t, b), c, 0, 0, 0);
    else return __builtin_amdgcn_mfma_f32_16x16x32_bf16(a, b, c, 0, 0, 0);
}
__device__ __forceinline__ unsigned cvt_pk_f16(float lo, float hi) { f16x2_t t = {(_Float16)lo, (_Float16)hi}; return __builtin_bit_cast(unsigned, t); }
__device__ __forceinline__ u32x4 pack8_bf16(f32x4 a, f32x4 b) { u32x4 w; w.x = cvt_pk_bf16(a[0], a[1]); w.y = cvt_pk_bf16(a[2], a[3]); w.z = cvt_pk_bf16(b[0], b[1]); w.w = cvt_pk_bf16(b[2], b[3]); return w; }
__device__ __forceinline__ u32x4 pack8_f16(f32x4 a, f32x4 b) { u32x4 w; w.x = cvt_pk_f16(a[0], a[1]); w.y = cvt_pk_f16(a[2], a[3]); w.z = cvt_pk_f16(b[0], b[1]); w.w = cvt_pk_f16(b[2], b[3]); return w; }
typedef unsigned u32x2 __attribute__((ext_vector_type(2)));
__device__ __forceinline__ u32x2 pack4_bf16(f32x4 a) { u32x2 w; w.x = cvt_pk_bf16(a[0], a[1]); w.y = cvt_pk_bf16(a[2], a[3]); return w; }
__device__ __forceinline__ f32x4 shfl4(f32x4 v, int x) { f32x4 r; r[0] = __shfl_xor(v[0], x); r[1] = __shfl_xor(v[1], x); r[2] = __shfl_xor(v[2], x); r[3] = __shfl_xor(v[3], x); return r; }
__device__ __forceinline__ float sum4(f32x4 v) { return (v[0] + v[1]) + (v[2] + v[3]); }
__device__ __forceinline__ float dot4(f32x4 v) { return (v[0] * v[0] + v[1] * v[1]) + (v[2] * v[2] + v[3] * v[3]); }
constexpr float RMS_EPS = 1e-6f;
__device__ __forceinline__ float rstd_from(const float* p, int n4, float inv_cnt) {
    float s = 0.f;
#pragma unroll 4
    for (int i = 0; i < n4; ++i) s += sum4(((const f32x4*)p)[i]);
    return __builtin_amdgcn_rsqf(s * inv_cnt + RMS_EPS);
}

__device__ __forceinline__ void rstd8(float (&rs)[2][4], const float* p, int stride, int n4, float inv_cnt, int rowbase) {
#pragma unroll
    for (int ai = 0; ai < 2; ++ai)
#pragma unroll
        for (int m = 0; m < 4; ++m) rs[ai][m] = rstd_from(p + (size_t)(rowbase + ai * HALF + m * 16) * stride, n4, inv_cnt);
}
struct EpiDsaIn {
    static constexpr bool PERM = true, AFTER_DRAIN = false;
    bf16_t* PA; float* WI; const float* SS; const float* cosA; const float* sinA; float wscale, qscale;
    __device__ __forceinline__ void operator()(const f32x4 (&acc)[2][2][4][2], const Unit& u, int wr, int wc, int fr, int fq) const {
        const bool ropew = (wc & 1) == 0;
#pragma unroll
        for (int ai = 0; ai < 2; ++ai) {
#pragma unroll
          for (int mh = 0; mh < 2; ++mh) {
            f32x4 c0v[4], c1v[4], s0v[4], s1v[4]; float rsv[4];
#pragma unroll
            for (int m = 2 * mh; m < 2 * mh + 2; ++m) { const int row = u.pm * BM + ai * HALF + wr * 64 + m * 16 + fr; rsv[m] = rstd_from(SS + (size_t)row * 16, 4, 1.0f / 1024.0f);
                if (ropew) { c0v[m] = *(const f32x4*)(cosA + (size_t)row * 8); c1v[m] = *(const f32x4*)(cosA + (size_t)row * 8 + 4); s0v[m] = *(const f32x4*)(sinA + (size_t)row * 8); s1v[m] = *(const f32x4*)(sinA + (size_t)row * 8 + 4); } }
#pragma unroll
            for (int m = 2 * mh; m < 2 * mh + 2; ++m) {
                const int row = u.pm * BM + ai * HALF + wr * 64 + m * 16 + fr;
                const float rs = rsv[m];
                f32x4 c0 = {}, c1 = {}, s0 = {}, s1 = {}; if (ropew) { c0 = c0v[m]; c1 = c1v[m]; s0 = s0v[m]; s1 = s1v[m]; }
#pragma unroll
                for (int bj = 0; bj < 2; ++bj) {
                    const int cb = u.pn * BM + bj * HALF + wc * 32;
                    const int col8 = cb + 8 * fq;
                    f32x4 v0 = acc[ai][bj][m][0] * rs, v1 = acc[ai][bj][m][1] * rs;
                    const bool ropeg = ((cb & 63) == 0) && (cb < 1280 || (cb >= 1536 && cb < 2112));
                    if (ropeg) {
                        const f32x4 p0 = shfl4(v0, 16), p1 = shfl4(v1, 16);
                        if (fq == 0) { v0 = v0 * c0 - p0 * s0; v1 = v1 * c1 - p1 * s1; }
                        else if (fq == 1) { v0 = v0 * c0 + p0 * s0; v1 = v1 * c1 + p1 * s1; }
                    }
                    if (cb < 1024) { v0 = v0 * qscale; v1 = v1 * qscale; }
                    if (cb < 2112) *(u32x4*)(PA + (size_t)row * 2304 + col8) = pack8_f16(v0, v1);
                    else if (cb == 2112 && fq == 0) { *(f32x4*)(WI + (size_t)row * 8) = v0 * wscale; *(f32x4*)(WI + (size_t)row * 8 + 4) = v1 * wscale; }
                }
            }
          }
        }
    }
};
struct EpiResid {
    static constexpr bool PERM = true, AFTER_DRAIN = false;
    const float* base; float* out; bf16_t* XB; float* SS;
    __device__ __forceinline__ void operator()(const f32x4 (&acc)[2][2][4][2], const Unit& u, int wr, int wc, int fr, int fq) const {
#pragma unroll
        for (int ai = 0; ai < 2; ++ai) {
            f32x4 b0[4][2], b1[4][2];
#pragma unroll
            for (int m = 0; m < 4; ++m) { const int row = u.pm * BM + ai * HALF + wr * 64 + m * 16 + fr;
#pragma unroll
                for (int bj = 0; bj < 2; ++bj) { const float* bp = base + (size_t)row * 1024 + u.pn * BM + bj * HALF + wc * 32 + 8 * fq; b0[m][bj] = *(const f32x4*)bp; b1[m][bj] = *(const f32x4*)(bp + 4); } }
#pragma unroll
            for (int m = 0; m < 4; ++m) {
                const int row = u.pm * BM + ai * HALF + wr * 64 + m * 16 + fr;
                float ssq = 0.f;
#pragma unroll
                for (int bj = 0; bj < 2; ++bj) {
                    const int col8 = u.pn * BM + bj * HALF + wc * 32 + 8 * fq;
                    const f32x4 v0 = acc[ai][bj][m][0] + b0[m][bj], v1 = acc[ai][bj][m][1] + b1[m][bj];
                    float* op = out + (size_t)row * 1024 + col8;
                    *(f32x4*)op = v0; *(f32x4*)(op + 4) = v1;
                    if (XB) *(u32x4*)(XB + (size_t)row * 1024 + col8) = pack8_bf16(v0, v1);
                    ssq += dot4(v0) + dot4(v1);
                }
                ssq += __shfl_xor(ssq, 16); ssq += __shfl_xor(ssq, 32);
                if (fq == 0) SS[(size_t)row * 16 + u.pn * 4 + wc] = ssq;
            }
        }
    }
};
struct EpiMlpUp {
    static constexpr bool PERM = true, AFTER_DRAIN = false;
    bf16_t* H; const float* SS;
    __device__ __forceinline__ void operator()(const f32x4 (&acc)[2][2][4][2], const Unit& u, int wr, int wc, int fr, int fq) const {
        float rsv[2][4]; rstd8(rsv, SS, 16, 4, 1.0f / 1024.0f, u.pm * BM + wr * 64 + fr);
#pragma unroll
        for (int ai = 0; ai < 2; ++ai)
#pragma unroll
            for (int m = 0; m < 4; ++m) {
                const int row = u.pm * BM + ai * HALF + wr * 64 + m * 16 + fr;
                const float rs = rsv[ai][m];
#pragma unroll
                for (int bj = 0; bj < 2; ++bj) {
                    const int col8 = u.pn * BM + bj * HALF + wc * 32 + 8 * fq;
                    f32x4 v0 = acc[ai][bj][m][0] * rs, v1 = acc[ai][bj][m][1] * rs;
                    const f32x4 z = {0.f, 0.f, 0.f, 0.f};
                    v0 = __builtin_elementwise_max(v0, z); v1 = __builtin_elementwise_max(v1, z);
                    *(u32x4*)(H + (size_t)row * 4096 + col8) = pack8_bf16(v0 * v0, v1 * v1);
                }
            }
    }
};
struct EpiMlaIn {
    static constexpr bool PERM = false, AFTER_DRAIN = false;
    bf16_t* CB; float* SSB; const float* SS; const float* cosB; const float* sinB;
    __device__ __forceinline__ void operator()(const f32x4 (&acc)[2][2][4][2], const Unit& u, int wr, int wc, int fr, int fq) const {
#pragma unroll
        for (int ai = 0; ai < 2; ++ai) {
#pragma unroll
          for (int mh = 0; mh < 2; ++mh) {
            float rsv[4];
#pragma unroll
            for (int m = 2 * mh; m < 2 * mh + 2; ++m) rsv[m] = rstd_from(SS + (size_t)(u.pm * BM + ai * HALF + wr * 64 + m * 16 + fr) * 16, 4, 1.0f / 1024.0f);
#pragma unroll
            for (int m = 2 * mh; m < 2 * mh + 2; ++m) {
                const int row = u.pm * BM + ai * HALF + wr * 64 + m * 16 + fr;
                const float rs = rsv[m];
#pragma unroll
                for (int bj = 0; bj < 2; ++bj) {
                    const int cb = u.pn * BM + bj * HALF + wc * 32;
                    f32x4 v0 = acc[ai][bj][m][0] * rs, v1 = acc[ai][bj][m][1] * rs;
                    if (cb == 640) { const f32x4 c = *(const f32x4*)(cosB + (size_t)row * 16 + 4 * fq), sn = *(const f32x4*)(sinB + (size_t)row * 16 + 4 * fq);
                        const f32x4 o0 = v0 * c - v1 * sn, o1 = v1 * c + v0 * sn; v0 = o0; v1 = o1; }
                    if (cb < 672) { bf16_t* p = CB + (size_t)row * 768 + cb + 4 * fq; *(u32x2*)p = pack4_bf16(v0); *(u32x2*)(p + 16) = pack4_bf16(v1); }
                    if (cb < 640) {
                        float ssq = dot4(v0) + dot4(v1);
                        ssq += __shfl_xor(ssq, 16); ssq += __shfl_xor(ssq, 32);
                        if (fq == 0) SSB[(size_t)row * 24 + (cb >> 5)] = ssq;
                    }
                }
            }
          }
        }
    }
};
struct EpiQUp {
    static constexpr bool PERM = false, AFTER_DRAIN = false;
    bf16_t* QB; const float* SSB; const float* cosB; const float* sinB; float qscale;
    __device__ __forceinline__ void operator()(const f32x4 (&acc)[2][2][4][2], const Unit& u, int wr, int wc, int fr, int fq) const {
        float rsv[2][4]; rstd8(rsv, SSB, 24, 3, 1.0f / 384.0f, u.pm * BM + wr * 64 + fr);
#pragma unroll
        for (int ai = 0; ai < 2; ++ai) {
            f32x4 cv[4], sv[4];
#pragma unroll
            for (int m = 0; m < 4; ++m) { const int row = u.pm * BM + ai * HALF + wr * 64 + m * 16 + fr; cv[m] = *(const f32x4*)(cosB + (size_t)row * 16 + 4 * fq); sv[m] = *(const f32x4*)(sinB + (size_t)row * 16 + 4 * fq); }
#pragma unroll
            for (int m = 0; m < 4; ++m) {
                const int row = u.pm * BM + ai * HALF + wr * 64 + m * 16 + fr;
                const float rs = rsv[ai][m] * qscale;
                const f32x4 c = cv[m], s = sv[m];
#pragma unroll
                for (int bj = 0; bj < 2; ++bj) {
                    const int cb = u.pn * BM + bj * HALF + wc * 32;
                    f32x4 v0 = acc[ai][bj][m][0] * rs, v1 = acc[ai][bj][m][1] * rs;
                    if (((cb >> 5) % 3) == 2) { const f32x4 o0 = v0 * c - v1 * s, o1 = v1 * c + v0 * s; v0 = o0; v1 = o1; }
                    bf16_t* p = QB + (size_t)row * 1536 + cb + 4 * fq; *(u32x2*)p = pack4_bf16(v0); *(u32x2*)(p + 16) = pack4_bf16(v1);
                }
            }
        }
    }
};
struct EpiKvUp {
    static constexpr bool PERM = true, AFTER_DRAIN = false;
    bf16_t* KVB; const float* SSB;
    __device__ __forceinline__ void operator()(const f32x4 (&acc)[2][2][4][2], const Unit& u, int wr, int wc, int fr, int fq) const {
        float rsv[2][4]; rstd8(rsv, SSB + 12, 24, 2, 1.0f / 256.0f, u.pm * BM + wr * 64 + fr);
#pragma unroll
        for (int ai = 0; ai < 2; ++ai)
#pragma unroll
            for (int m = 0; m < 4; ++m) {
                const int row = u.pm * BM + ai * HALF + wr * 64 + m * 16 + fr;
                const float rs = rsv[ai][m];
#pragma unroll
                for (int bj = 0; bj < 2; ++bj) {
                    const int col8 = u.pn * BM + bj * HALF + wc * 32 + 8 * fq;
                    *(u32x4*)(KVB + (size_t)row * 2048 + col8) = pack8_bf16(acc[ai][bj][m][0] * rs, acc[ai][bj][m][1] * rs);
                }
            }
    }
};
template <class Epi, class Sched, bool ALIGN_EPI = false, bool SP2 = false, bool F16 = false>
__device__ __forceinline__ void gemm_phase(PG8_LAS unsigned char* lds, const Gemm g, const Sched& S, const Epi& E) {
    const int tid = threadIdx.x, wid = __builtin_amdgcn_readfirstlane(tid >> 6), lane = tid & 63, wr = wid >> 2, wc = wid & 3, fr = lane & 15, fq = lane >> 4;
    const int K = g.K, nt = K / BK;
    unsigned voffA[2], voffB[2];
#pragma unroll
    for (int i = 0; i < 2; ++i) { int R, C; stage_rc(tid * 16 + i * 8192, R, C); const int Rb = Epi::PERM ? ((R & ~31) + perm32(R & 31)) : R;
        voffA[i] = (unsigned)(R * g.lda + C) * 2u; voffB[i] = (unsigned)(Rb * g.ldb + C) * 2u; }
    const size_t kstep = (size_t)(BK * 2);
    const size_t hstepA = (size_t)HALF * g.lda * 2, hstepB = (size_t)HALF * g.ldb * 2;
    const size_t tstepA = 2 * hstepA, tstepB = 2 * hstepB;
    const unsigned ldsw = (unsigned)wid * 1024u;
    const int aoff = lds_byte(wr * 64 + fr, fq * 8), boff = lds_byte(wc * 32 + fr, fq * 8);
#define PG8_SA(b, h) (((b) * 2 + (h)) * HTB)
#define PG8_SB(b, h) ((4 + (b) * 2 + (h)) * HTB)
#define PG8_STAGE(bufoff, gbase, voff) do { _Pragma("unroll") for (int _i = 0; _i < 2; ++_i) \
        __builtin_amdgcn_global_load_lds((const unsigned*)((const char*)(gbase) + (voff)[_i]), (PG8_LAS unsigned*)(lds + (bufoff) + ldsw + _i * 8192), 16, 0, 0); } while (0)
#define PG8_LDA(dst, b, h) do { _Pragma("unroll") for (int m = 0; m < 4; ++m) _Pragma("unroll") for (int k = 0; k < 2; ++k) dst[m][k] = *(const PG8_LAS bf16x8*)(lds + PG8_SA(b, h) + aoff + m * 2048 + k * 1024); } while (0)
#define PG8_LDB(dst, b, h) do { _Pragma("unroll") for (int n = 0; n < 2; ++n) _Pragma("unroll") for (int k = 0; k < 2; ++k) dst[n][k] = *(const PG8_LAS bf16x8*)(lds + PG8_SB(b, h) + boff + n * 2048 + k * 1024); } while (0)
#define PG8_MMA(ai, bj, At, Bt) do { __builtin_amdgcn_s_setprio(1); _Pragma("unroll") for (int m = 0; m < 4; ++m) _Pragma("unroll") for (int n = 0; n < 2; ++n) _Pragma("unroll") for (int k = 0; k < 2; ++k) \
        acc[ai][bj][m][n] = mma16<F16>(Bt[n][k], At[m][k], acc[ai][bj][m][n]); __builtin_amdgcn_s_setprio(0); } while (0)
#define PG8_WAIT_V(n) asm volatile("s_waitcnt vmcnt(" #n ")" ::: "memory")
#define PG8_WAIT_L(n) asm volatile("s_waitcnt lgkmcnt(" #n ")" ::: "memory")
#define PG8_BAR __builtin_amdgcn_s_barrier()
#define PG8_SCHED __builtin_amdgcn_sched_barrier(0)
    Unit cur, nxt; int ui = 0;
    if (!S.next(0, cur)) return;
    f32x4 acc[2][2][4][2];
#pragma unroll
    for (int a = 0; a < 2; ++a)
#pragma unroll
        for (int b = 0; b < 2; ++b)
#pragma unroll
            for (int m = 0; m < 4; ++m)
#pragma unroll
                for (int n = 0; n < 2; ++n) acc[a][b][m][n] = (f32x4){0.f, 0.f, 0.f, 0.f};
    bf16x8 At[4][2], B0[2][2], B1[2][2];
    const char* cA = (const char*)g.A + (size_t)cur.pm * tstepA; const char* cB = (const char*)g.Bt + (size_t)cur.pn * tstepB;
    S.a_ready(cur);
    if constexpr (SP2) {
        PG8_STAGE(PG8_SB(0, 0), cB, voffB); PG8_STAGE(PG8_SB(0, 1), cB + hstepB, voffB); PG8_STAGE(PG8_SA(0, 0), cA, voffA); PG8_STAGE(PG8_SA(0, 1), cA + hstepA, voffA);
        if (wr == 1) PG8_BAR;
        PG8_WAIT_V(2); PG8_BAR;
        PG8_STAGE(PG8_SB(1, 0), cB + kstep, voffB); PG8_STAGE(PG8_SA(1, 0), cA + kstep, voffA); PG8_STAGE(PG8_SB(1, 1), cB + hstepB + kstep, voffB);
        PG8_WAIT_V(6); PG8_BAR;
    } else {
        PG8_STAGE(PG8_SB(0, 0), cB, voffB); PG8_STAGE(PG8_SA(0, 0), cA, voffA); PG8_STAGE(PG8_SB(0, 1), cB + hstepB, voffB); PG8_STAGE(PG8_SA(0, 1), cA + hstepA, voffA);
        if (wr == 1) PG8_BAR;
        PG8_WAIT_V(4); PG8_BAR;
        PG8_STAGE(PG8_SB(1, 0), cB + kstep, voffB); PG8_STAGE(PG8_SA(1, 0), cA + kstep, voffA); PG8_STAGE(PG8_SB(1, 1), cB + hstepB + kstep, voffB);
        PG8_WAIT_V(6); PG8_BAR;
    }
    for (;;) {
        const bool has_next = S.next(ui + 1, nxt);
        const char* nA = has_next ? (const char*)g.A + (size_t)nxt.pm * tstepA : cA; const char* nB = has_next ? (const char*)g.Bt + (size_t)nxt.pn * tstepB : cB;
#pragma nounroll
        for (int t = 0; t < nt; t += 2) {
            const bool last = (t == nt - 2);
            const char* a1 = cA + (size_t)(t + 1) * kstep;
            const char* a2 = last ? nA : cA + (size_t)(t + 2) * kstep; const char* b2 = last ? nB : cB + (size_t)(t + 2) * kstep;
            const char* a3 = a2 + kstep; const char* b3 = b2 + kstep;
            if (last && has_next) S.a_ready(nxt);
            if constexpr (SP2) {
            PG8_LDB(B0, 0, 0); PG8_LDB(B1, 0, 1); PG8_SCHED; PG8_LDA(At, 0, 0); PG8_STAGE(PG8_SA(1, 1), a1 + hstepA, voffA);
            PG8_WAIT_V(8); PG8_WAIT_L(0); PG8_BAR; PG8_MMA(0, 0, At, B0); PG8_MMA(0, 1, At, B1); PG8_BAR; PG8_SCHED;
            PG8_LDA(At, 0, 1); PG8_STAGE(PG8_SB(0, 0), b2, voffB); PG8_STAGE(PG8_SB(0, 1), b2 + hstepB, voffB); PG8_STAGE(PG8_SA(0, 0), a2, voffA);
            PG8_WAIT_V(8); PG8_WAIT_L(0); PG8_BAR; PG8_MMA(1, 0, At, B0); PG8_MMA(1, 1, At, B1); PG8_BAR; PG8_SCHED;
            PG8_LDB(B0, 1, 0); PG8_LDB(B1, 1, 1); PG8_SCHED; PG8_LDA(At, 1, 0); PG8_STAGE(PG8_SA(0, 1), a2 + hstepA, voffA);
            PG8_WAIT_V(8); PG8_WAIT_L(0); PG8_BAR; PG8_MMA(0, 0, At, B0); PG8_MMA(0, 1, At, B1); PG8_BAR; PG8_SCHED;
            PG8_LDA(At, 1, 1); PG8_STAGE(PG8_SB(1, 0), b3, voffB); PG8_STAGE(PG8_SB(1, 1), b3 + hstepB, voffB); PG8_STAGE(PG8_SA(1, 0), a3, voffA);
            PG8_WAIT_V(8); PG8_WAIT_L(0); PG8_BAR; PG8_MMA(1, 0, At, B0); PG8_MMA(1, 1, At, B1); PG8_BAR; PG8_SCHED;
            } else {
            PG8_LDB(B0, 0, 0); PG8_SCHED; PG8_LDA(At, 0, 0); PG8_STAGE(PG8_SA(1, 1), a1 + hstepA, voffA);
            PG8_WAIT_L(8); PG8_BAR; PG8_WAIT_L(0); PG8_MMA(0, 0, At, B0); PG8_BAR; PG8_SCHED;
            PG8_LDB(B1, 0, 1); PG8_STAGE(PG8_SB(0, 0), b2, voffB);
            PG8_BAR; PG8_WAIT_L(0); PG8_MMA(0, 1, At, B1); PG8_BAR;
            PG8_LDA(At, 0, 1); PG8_STAGE(PG8_SA(0, 0), a2, voffA);
            PG8_BAR; PG8_WAIT_L(0); PG8_MMA(1, 0, At, B0); PG8_BAR; PG8_SCHED;
            PG8_STAGE(PG8_SB(0, 1), b2 + hstepB, voffB);
            PG8_WAIT_V(6); PG8_BAR; PG8_MMA(1, 1, At, B1); PG8_BAR;
            PG8_LDB(B0, 1, 0); PG8_SCHED; PG8_LDA(At, 1, 0); PG8_STAGE(PG8_SA(0, 1), a2 + hstepA, voffA);
            PG8_WAIT_L(8); PG8_BAR; PG8_WAIT_L(0); PG8_MMA(0, 0, At, B0); PG8_BAR; PG8_SCHED;
            PG8_LDB(B1, 1, 1); PG8_STAGE(PG8_SB(1, 0), b3, voffB);
            PG8_BAR; PG8_WAIT_L(0); PG8_MMA(0, 1, At, B1); PG8_BAR;
            PG8_LDA(At, 1, 1); PG8_STAGE(PG8_SA(1, 0), a3, voffA);
            PG8_BAR; PG8_WAIT_L(0); PG8_MMA(1, 0, At, B0); PG8_BAR; PG8_SCHED;
            PG8_STAGE(PG8_SB(1, 1), b3 + hstepB, voffB);
            PG8_WAIT_V(6); PG8_BAR; PG8_MMA(1, 1, At, B1); PG8_BAR;
            }
        }
        if constexpr (ALIGN_EPI) { if (wr == 0) PG8_BAR; }
        if constexpr (!Epi::AFTER_DRAIN) { E(acc, cur, wr, wc, fr, fq); S.done(cur); }
        if (!has_next) break;
#pragma unroll
        for (int a = 0; a < 2; ++a)
#pragma unroll
            for (int b = 0; b < 2; ++b)
#pragma unroll
                for (int m = 0; m < 4; ++m)
#pragma unroll
                    for (int n = 0; n < 2; ++n) acc[a][b][m][n] = (f32x4){0.f, 0.f, 0.f, 0.f};
        cur = nxt; cA = nA; cB = nB; ++ui;
        if constexpr (ALIGN_EPI) { if (wr == 1) PG8_BAR; }
    }
    PG8_WAIT_V(0);
    if constexpr (!ALIGN_EPI) { if (wr == 0) PG8_BAR; }
    PG8_BAR;
    if constexpr (Epi::AFTER_DRAIN) { E.fused(acc, cur, wr, wc, fr, fq, lds, wid, lane); S.done(cur); }
#undef PG8_SA
#undef PG8_SB
#undef PG8_STAGE
#undef PG8_LDA
#undef PG8_LDB
#undef PG8_MMA
#undef PG8_WAIT_V
#undef PG8_WAIT_L
#undef PG8_BAR
#undef PG8_SCHED
}
}
constexpr int NWAVES = 8;
#ifndef MK_N_LAUNCHES
#define MK_N_LAUNCHES 1
#endif
constexpr int N_PHASES = 13;
constexpr int N_LAUNCHES = MK_N_LAUNCHES;
constexpr int BATCH = 16, SEQ = 2048, DM = 1024, M = BATCH * SEQ, FF = 4096;
constexpr int A_IN = 2120, A_INP = 2304, B_IN = 672, B_INP = 768, QUP = 1536, KVUP = 2048, QLORA = 384, KVLORA = 256;
constexpr size_t MiB = 1u << 20;
constexpr size_t WS_CTL = 0, CTL_ZERO_BYTES = 64 * 1024;
constexpr size_t WS_WAIN = 1 * MiB, WS_WAOUT = 6 * MiB, WS_WUP0 = 8 * MiB, WS_WUP1 = 16 * MiB, WS_WDN0 = 24 * MiB, WS_WDN1 = 32 * MiB;
constexpr size_t WS_WBIN = 40 * MiB, WS_WQUP = 42 * MiB, WS_WKVUP = 44 * MiB, WS_WBOUT = 46 * MiB;
constexpr size_t WS_COSA = 48 * MiB, WS_SINA = 49 * MiB, WS_COSB = 50 * MiB, WS_SINB = 52 * MiB;
constexpr size_t WS_SS = 54 * MiB, WS_SSB = 56 * MiB, WS_WI = 59 * MiB;
constexpr size_t WS_XB = 64 * MiB;
constexpr size_t WS_BIG = 128 * MiB;
constexpr size_t WS_PA = WS_BIG, WS_OA = WS_BIG + 144 * MiB;
constexpr size_t WS_H = WS_BIG;
constexpr size_t WS_CB = WS_BIG, WS_QB = WS_BIG + 48 * MiB, WS_OB = WS_BIG + 144 * MiB;
constexpr size_t WS_KVB = 384 * MiB, WS_END = 512 * MiB;
static_assert(WS_WAIN + (size_t)A_INP * DM * 2 <= WS_WAOUT && WS_WBIN + (size_t)B_INP * DM * 2 <= WS_WQUP && WS_WQUP + (size_t)QUP * QLORA * 2 <= WS_WKVUP && WS_WKVUP + (size_t)KVUP * KVLORA * 2 <= WS_WBOUT, "weights map");
static_assert(WS_SSB + (size_t)M * 24 * 4 <= WS_WI && WS_WI + (size_t)M * 8 * 4 <= WS_XB && WS_PA + (size_t)M * A_INP * 2 <= WS_OA && WS_OA + (size_t)M * DM * 2 <= WS_KVB && WS_QB + (size_t)M * QUP * 2 <= WS_OB, "activation map");
constexpr int CW_BAR = 1024;
constexpr int RING_BYTES = 131072, LDSCTL_OFF = RING_BYTES, MISC_OFF = LDSCTL_OFF + 320, LDS_BYTES = 147456;
constexpr float IDX_WSCALE = 0.044194173824159216f;
constexpr float QSCALE_A = 0.125f * 1.4426950408889634f;
constexpr float QSCALE_B = 0.10206207261596577f * 1.4426950408889634f;

#define GAS __attribute__((address_space(1)))
#define LAS __attribute__((address_space(3)))
typedef unsigned short bf16;
typedef unsigned v4u __attribute__((ext_vector_type(4)));
typedef float f32x4 __attribute__((ext_vector_type(4)));
typedef short bf16x8 __attribute__((ext_vector_type(8)));
typedef GAS unsigned gu32;
typedef GAS unsigned long long gu64;
#define RLX_AGENT __ATOMIC_RELAXED, __HIP_MEMORY_SCOPE_AGENT
#define LDS_WAIT() asm volatile("s_waitcnt lgkmcnt(0)" ::: "memory")
#define VM_WAIT() asm volatile("s_waitcnt vmcnt(0)" ::: "memory")
__device__ __forceinline__ unsigned long long rt() { return __builtin_amdgcn_s_memrealtime(); }
__device__ __forceinline__ unsigned f2bf(float f) { unsigned u = __builtin_bit_cast(unsigned, f); return (u + 0x7fffu + ((u >> 16) & 1u)) >> 16; }
__device__ __forceinline__ unsigned pk2(float lo, float hi) { return f2bf(lo) | (f2bf(hi) << 16); }

#define XB_TMO      128
#define XB_XCNT(j)  (256  + 64 * (j))
#define XB_XSUB(j)  (1280 + 64 * (j))
#define XB_XGEN(j)  (2304 + 64 * (j))
#define XB_TOP      3328
#define XB_TOPGEN   3392
#define XCD_BAR_WORDS 3456
#define XB_SPIN_CAP (1u << 18)

__device__ __forceinline__ unsigned xb_ld(unsigned* p)              { return __hip_atomic_load(p, __ATOMIC_RELAXED, __HIP_MEMORY_SCOPE_AGENT); }
__device__ __forceinline__ unsigned xb_add(unsigned* p, unsigned v) { return __hip_atomic_fetch_add(p, v, __ATOMIC_RELAXED, __HIP_MEMORY_SCOPE_AGENT); }
__device__ __forceinline__ unsigned xb_xcc_id() { return (unsigned)__builtin_amdgcn_s_getreg((3 << 11) | 20) & 0xFu; }
#define XB_SPIN(cond, bar) do { unsigned _sp = 0; while (cond) { __builtin_amdgcn_s_sleep(1); \
    if ((++_sp & 255u) == 0u) { if (xb_ld(&(bar)[XB_TMO])) break; if (_sp > XB_SPIN_CAP) { atomicAdd(&(bar)[XB_TMO], 1u); break; } } } } while (0)

struct XcdBarrier {
    unsigned* bar; unsigned x;
    volatile LAS unsigned* st;
};

__device__ __forceinline__ XcdBarrier xcd_barrier_post(unsigned* bar, volatile LAS unsigned* st) {
    XcdBarrier b; b.bar = bar; b.x = xb_xcc_id(); b.st = st;
    if (threadIdx.x == 0) (void)xb_add(&bar[XB_XCNT(b.x)], 1u);
    return b;
}
__device__ __forceinline__ void xcd_barrier_complete(unsigned* bar, unsigned x, unsigned& nloc, unsigned& nx) {
    const unsigned G = gridDim.x * gridDim.y * gridDim.z;
    unsigned sum, cnt, mine, sp = 0u;
    for (;;) {
        sum = 0u; cnt = 0u; mine = 0u;
#pragma unroll
        for (unsigned j = 0; j < 16; ++j) { const unsigned c = xb_ld(&bar[XB_XCNT(j)]); sum += c; cnt += (c > 0u) ? 1u : 0u; mine = (j == x) ? c : mine; }
        if (sum == G) break;
        __builtin_amdgcn_s_sleep(1);
        if ((++sp & 255u) == 0u) { if (xb_ld(&bar[XB_TMO])) break; if (sp > XB_SPIN_CAP) { atomicAdd(&bar[XB_TMO], 1u); break; } }
    }
    nloc = mine > 0u ? mine : 1u; nx = cnt > 0u ? cnt : 1u;
}

__device__ __forceinline__ void xcd_barrier(const XcdBarrier& b) {
    asm volatile("s_waitcnt vmcnt(0)" ::: "memory");
    __syncthreads();
    if (threadIdx.x == 0) {
        unsigned* bar = b.bar;
        __builtin_amdgcn_s_waitcnt(0);
        unsigned nloc = b.st[0], nx = b.st[1];
        if (nloc == 0u) { xcd_barrier_complete(bar, b.x, nloc, nx); b.st[0] = nloc; b.st[1] = nx; }
        const unsigned old = xb_add(&bar[XB_XSUB(b.x)], 1u);
        const unsigned gen = old / nloc;
        if (old + 1u == (gen + 1u) * nloc) {
            __builtin_amdgcn_fence(__ATOMIC_RELEASE, "agent");
            asm volatile("s_waitcnt vmcnt(0)" ::: "memory");
            const unsigned og = xb_add(&bar[XB_TOP], 1u);
            const unsigned tg = og / nx;
            if (og + 1u == (tg + 1u) * nx) xb_add(&bar[XB_TOPGEN], 1u);
            else XB_SPIN(xb_ld(&bar[XB_TOPGEN]) == tg, bar);
            __builtin_amdgcn_fence(__ATOMIC_ACQUIRE, "agent");
            xb_add(&bar[XB_XGEN(b.x)], 1u);
            asm volatile("s_waitcnt vmcnt(0)" ::: "memory");
        } else {
            XB_SPIN(xb_ld(&bar[XB_XGEN(b.x)]) == gen, bar);
            __builtin_amdgcn_fence(__ATOMIC_ACQUIRE, "agent");
            asm volatile("s_waitcnt vmcnt(0)" ::: "memory");
        }
    }
    __syncthreads();
}
using pg8::u32x4; using pg8::u32x2;
struct Frame {
    LAS unsigned char* lds;
    volatile LAS unsigned* MISC;
    gu32* ctl;
    int tid, lane, wave, G;
};
__device__ __forceinline__ float wave_sum(float v) {
#pragma unroll
    for (int o = 1; o < 64; o <<= 1) v += __shfl_xor(v, o);
    return v;
}
typedef _Float16 half_t;
__device__ __forceinline__ unsigned short f2h(float f) { half_t h = (half_t)f; return __builtin_bit_cast(unsigned short, h); }
__device__ __forceinline__ float h2f(unsigned short u) { return (float)__builtin_bit_cast(half_t, u); }
__device__ __forceinline__ float bf2f(unsigned short u) { return __builtin_bit_cast(float, (unsigned)u << 16); }

template <bool F16>
__device__ __forceinline__ void p0_transpose_item(const float* W, int K, int N, const float* gain, bf16* WT, LAS float* scr, int item, int lane) {
    const int nblk = (N + 31) / 32, kb = item / nblk, nb = item % nblk, k0 = 64 * kb, n0 = 32 * nb;
#pragma unroll 8
    for (int i = 0; i < 32; ++i) { const int kk = 2 * i + (lane >> 5); const int n = n0 + (lane & 31);
        float v = (n < N) ? W[(size_t)(k0 + kk) * N + n] : 0.f; if (gain) v *= gain[k0 + kk]; scr[kk * 33 + (lane & 31)] = v; }
    LDS_WAIT(); asm volatile("" ::: "memory");
    const int c = lane & 7;
#pragma unroll
    for (int j = 0; j < 4; ++j) { const int n = (lane >> 3) + 8 * j; const LAS float* s = scr + (8 * c) * 33 + n;
        v4u o;
        if (F16) { o.x = (unsigned)f2h(s[0 * 33]) | ((unsigned)f2h(s[1 * 33]) << 16); o.y = (unsigned)f2h(s[2 * 33]) | ((unsigned)f2h(s[3 * 33]) << 16);
                   o.z = (unsigned)f2h(s[4 * 33]) | ((unsigned)f2h(s[5 * 33]) << 16); o.w = (unsigned)f2h(s[6 * 33]) | ((unsigned)f2h(s[7 * 33]) << 16); }
        else { o.x = pk2(s[0 * 33], s[1 * 33]); o.y = pk2(s[2 * 33], s[3 * 33]); o.z = pk2(s[4 * 33], s[5 * 33]); o.w = pk2(s[6 * 33], s[7 * 33]); }
        *(GAS v4u*)(WT + (size_t)(n0 + n) * K + k0 + 8 * c) = o; }
    LDS_WAIT(); asm volatile("" ::: "memory");
}
struct Args { const void* in[15]; float* out; unsigned char* ws; float inv_a[8]; float inv_b[16]; int ph_lo, ph_hi; };

__device__ __forceinline__ void p0_prologue(Frame& F, const Args& A) {
    unsigned char* ws = A.ws;
    LAS float* scr = (LAS float*)(F.lds + F.wave * 16384);
    const int gw = blockIdx.x * NWAVES + F.wave, NGW = F.G * NWAVES, lane = F.lane;
    const float* attn_norm = (const float*)A.in[2]; const float* mlp_norm = (const float*)A.in[3];
    constexpr int I_AIN = 16 * 67, I_AOUT = 16 * 32, I_UP = 16 * 128, I_DN = 64 * 32, I_BIN = 16 * 21, I_QUP = 6 * 48, I_KVUP = 4 * 64, I_BOUT = 16 * 32;
    constexpr int NITEMS = I_AIN + I_AOUT + 2 * I_UP + 2 * I_DN + I_BIN + I_QUP + I_KVUP + I_BOUT;
    for (int it = gw; it < NITEMS; it += NGW) {
        int r = it;
        if (r < I_AIN) { p0_transpose_item<true>((const float*)A.in[4], 1024, A_IN, attn_norm, (bf16*)(ws + WS_WAIN), scr, r, lane); continue; } r -= I_AIN;
        if (r < I_AOUT) { p0_transpose_item<false>((const float*)A.in[5], 1024, 1024, nullptr, (bf16*)(ws + WS_WAOUT), scr, r, lane); continue; } r -= I_AOUT;
        if (r < I_UP) { p0_transpose_item<false>((const float*)A.in[12], 1024, 4096, mlp_norm, (bf16*)(ws + WS_WUP0), scr, r, lane); continue; } r -= I_UP;
        if (r < I_UP) { p0_transpose_item<false>((const float*)A.in[12] + (size_t)1024 * 4096, 1024, 4096, mlp_norm + 1024, (bf16*)(ws + WS_WUP1), scr, r, lane); continue; } r -= I_UP;
        if (r < I_DN) { p0_transpose_item<false>((const float*)A.in[13], 4096, 1024, nullptr, (bf16*)(ws + WS_WDN0), scr, r, lane); continue; } r -= I_DN;
        if (r < I_DN) { p0_transpose_item<false>((const float*)A.in[13] + (size_t)4096 * 1024, 4096, 1024, nullptr, (bf16*)(ws + WS_WDN1), scr, r, lane); continue; } r -= I_DN;
        if (r < I_BIN) { p0_transpose_item<false>((const float*)A.in[6], 1024, B_IN, attn_norm + 1024, (bf16*)(ws + WS_WBIN), scr, r, lane); continue; } r -= I_BIN;
        if (r < I_QUP) { p0_transpose_item<false>((const float*)A.in[9], QLORA, QUP, (const float*)A.in[7], (bf16*)(ws + WS_WQUP), scr, r, lane); continue; } r -= I_QUP;
        if (r < I_KVUP) { p0_transpose_item<false>((const float*)A.in[10], KVLORA, KVUP, (const float*)A.in[8], (bf16*)(ws + WS_WKVUP), scr, r, lane); continue; } r -= I_KVUP;
        p0_transpose_item<false>((const float*)A.in[11], 1024, 1024, nullptr, (bf16*)(ws + WS_WBOUT), scr, r, lane);
    }
    {   const int gt = gw * 64 + lane, NT = NGW * 64;
        GAS v4u* z1 = (GAS v4u*)(ws + WS_WAIN + (size_t)2144 * 1024 * 2); const int n1 = (A_INP - 2144) * 1024 * 2 / 16;
        for (int i = gt; i < n1; i += NT) z1[i] = (v4u){0u, 0u, 0u, 0u};
        GAS v4u* z2 = (GAS v4u*)(ws + WS_WBIN + (size_t)B_IN * 1024 * 2); const int n2 = (B_INP - B_IN) * 1024 * 2 / 16;
        for (int i = gt; i < n2; i += NT) z2[i] = (v4u){0u, 0u, 0u, 0u};
        const int* pos = (const int*)A.in[1];
        float* cA = (float*)(ws + WS_COSA); float* sA = (float*)(ws + WS_SINA); float* cB = (float*)(ws + WS_COSB); float* sB = (float*)(ws + WS_SINB);
        for (int i = gt; i < M * 8; i += NT) { const float ang = (float)pos[i >> 3] * A.inv_a[i & 7]; double rev = (double)ang * 0.15915494309189535; rev -= __builtin_rint(rev); const float fr = (float)rev;
            cA[i] = __builtin_amdgcn_cosf(fr); sA[i] = __builtin_amdgcn_sinf(fr); }
        for (int i = gt; i < M * 16; i += NT) { const float ang = (float)pos[i >> 4] * A.inv_b[i & 15]; double rev = (double)ang * 0.15915494309189535; rev -= __builtin_rint(rev); const float fr = (float)rev;
            cB[i] = __builtin_amdgcn_cosf(fr); sB[i] = __builtin_amdgcn_sinf(fr); }
    }
    const float* x = (const float*)A.in[0]; bf16* XB = (bf16*)(ws + WS_XB); float* SS = (float*)(ws + WS_SS);
    for (int m0 = gw; m0 < M; m0 += 2 * NGW) {
        f32x4 v[2][4]; float sq[2];
#pragma unroll
        for (int e = 0; e < 2; ++e) { const int m = (m0 + e * NGW < M) ? m0 + e * NGW : m0; const GAS f32x4* xr = (const GAS f32x4*)(x + (size_t)m * DM) + lane;
#pragma unroll
            for (int j = 0; j < 4; ++j) v[e][j] = xr[64 * j]; }
#pragma unroll
        for (int e = 0; e < 2; ++e) { float s = 0.f;
#pragma unroll
            for (int j = 0; j < 4; ++j) s += (v[e][j].x * v[e][j].x + v[e][j].y * v[e][j].y) + (v[e][j].z * v[e][j].z + v[e][j].w * v[e][j].w);
            sq[e] = wave_sum(s); }
#pragma unroll
        for (int e = 0; e < 2; ++e) { const int m = m0 + e * NGW; if (m < M) {
            GAS unsigned long long* o8 = (GAS unsigned long long*)(XB + (size_t)m * DM) + lane;
#pragma unroll
            for (int j = 0; j < 4; ++j) o8[64 * j] = (unsigned long long)((unsigned)f2h(v[e][j].x) | ((unsigned)f2h(v[e][j].y) << 16)) | ((unsigned long long)((unsigned)f2h(v[e][j].z) | ((unsigned)f2h(v[e][j].w) << 16)) << 32);
            if (lane < 16) SS[(size_t)m * 16 + lane] = (lane == 0) ? sq[e] : 0.f; } }
    }
}
__device__ __forceinline__ void p12_final_norm(Frame& F, const Args& A) {
    const int gw = blockIdx.x * NWAVES + F.wave, NGW = F.G * NWAVES, lane = F.lane;
    const float* g = (const float*)A.in[14]; const float* SS = (const float*)(A.ws + WS_SS);
    f32x4 gv[4];
#pragma unroll
    for (int j = 0; j < 4; ++j) gv[j] = ((const GAS f32x4*)g)[lane + 64 * j];
    for (int m = gw; m < M; m += 2 * NGW) {
        const int m2 = m + NGW;
        const bool has2 = m2 < M;
        GAS f32x4* xr = (GAS f32x4*)(A.out + (size_t)m * DM) + lane; GAS f32x4* xr2 = (GAS f32x4*)(A.out + (size_t)(has2 ? m2 : m) * DM) + lane;
        f32x4 v[4], u[4];
#pragma unroll
        for (int j = 0; j < 4; ++j) { v[j] = xr[64 * j]; u[j] = xr2[64 * j]; }
        const float rs = pg8::rstd_from(SS + (size_t)m * 16, 4, 1.0f / 1024.0f), rs2 = pg8::rstd_from(SS + (size_t)(has2 ? m2 : m) * 16, 4, 1.0f / 1024.0f);
#pragma unroll
        for (int j = 0; j < 4; ++j) xr[64 * j] = v[j] * rs * gv[j];
        if (has2) {
#pragma unroll
            for (int j = 0; j < 4; ++j) xr2[64 * j] = u[j] * rs2 * gv[j]; }
    }
}
namespace dsa {
typedef float f32x16 __attribute__((ext_vector_type(16)));
typedef _Float16 f16x8 __attribute__((ext_vector_type(8)));
typedef short s16x4 __attribute__((ext_vector_type(4)));
constexpr int KP = 144;
constexpr int MP = 65;
constexpr int LDS_MASK = 0, LDS_KV = 16896, KBYTES = 64 * KP, KV1 = KBYTES + 8192, KVBUF2 = 2 * KV1, LDS_Q = LDS_KV + 2 * KVBUF2, LDS_KI = LDS_KV, KIBUF = 256 * KP;
static_assert(64 * MP * 4 <= LDS_KV && LDS_Q + 8 * 4096 <= RING_BYTES && LDS_KI + 2 * KIBUF <= RING_BYTES, "dsa LDS map");
__device__ __forceinline__ unsigned sortable(float f) { const unsigned u = __builtin_bit_cast(unsigned, f); return (u & 0x80000000u) ? ~u : (u | 0x80000000u); }
__device__ __forceinline__ float xmax32(float m) { auto rr = __builtin_amdgcn_permlane32_swap(__float_as_uint(m), __float_as_uint(m), false, false); return fmaxf(__uint_as_float(rr[0]), __uint_as_float(rr[1])); }
__device__ __forceinline__ unsigned half_sum(unsigned v) {
#pragma unroll
    for (int o = 16; o >= 1; o >>= 1) v += (unsigned)__shfl_xor((int)v, o);
    return v;
}
__device__ __forceinline__ void cnt4(unsigned& cnt, unsigned a, unsigned b, unsigned c, unsigned d, unsigned cand) {
    unsigned long long m0, m1, m2, m3, co;
    asm volatile("v_cmp_ge_u32_e64 %1, %6, %10\n\tv_cmp_ge_u32_e64 %2, %7, %10\n\tv_cmp_ge_u32_e64 %3, %8, %10\n\tv_cmp_ge_u32_e64 %4, %9, %10\n\t"
                 "v_addc_co_u32_e64 %0, %5, 0, %0, %1\n\tv_addc_co_u32_e64 %0, %5, 0, %0, %2\n\tv_addc_co_u32_e64 %0, %5, 0, %0, %3\n\tv_addc_co_u32_e64 %0, %5, 0, %0, %4\n\ts_nop 1"
                 : "+v"(cnt), "=&s"(m0), "=&s"(m1), "=&s"(m2), "=&s"(m3), "=&s"(co) : "v"(a), "v"(b), "v"(c), "v"(d), "v"(cand));
}
__device__ __forceinline__ void index_select(LAS unsigned char* lds, LAS unsigned* maskQ, const bf16* PA, const float* WI, unsigned* scr, size_t row0, int qp0, int mp0, int nkt, int tid, int wid, int lane) {
    const int r32 = lane & 31, hh = lane >> 5;
    const int q0 = qp0 + 4 * wid, mrow0 = mp0 + 4 * wid;
    const int a_ = r32 & 3, hic = (r32 >> 2) & 1, bq = r32 >> 3; const int headA = a_ + 4 * (bq & 1), tlocA = 2 * hic + (bq >> 1);
    const bf16* ap = PA + (row0 + q0 + tlocA) * A_INP + 1536 + headA * 64 + 8 * hh;
    f16x8 qa[4];
#pragma unroll
    for (int ks = 0; ks < 4; ++ks) qa[ks] = *(const f16x8*)(ap + 16 * ks);
    float w[2][8];
#pragma unroll
    for (int tq = 0; tq < 2; ++tq) { const float* wq = WI + (row0 + q0 + 2 * hh + tq) * 8; const f32x4 wa = *(const f32x4*)wq, wb = *(const f32x4*)(wq + 4);
      w[tq][0] = wa[0]; w[tq][1] = wa[1]; w[tq][2] = wa[2]; w[tq][3] = wa[3]; w[tq][4] = wb[0]; w[tq][5] = wb[1]; w[tq][6] = wb[2]; w[tq][7] = wb[3]; }
    const int nch = (nkt + 7) >> 3;
    const int skey = tid >> 3, sc8 = tid & 7;
    const bf16* spc = PA + (row0 + skey) * A_INP + 2048 + sc8 * 8;
    v4u st[4];
#pragma unroll
    for (int i = 0; i < 4; ++i) st[i] = *(const v4u*)(spc + (size_t)(64 * i) * A_INP);
    LAS unsigned char* const stw = lds + LDS_KI + skey * KP + sc8 * 16;
    const LAS unsigned char* const krd = lds + LDS_KI + r32 * KP + hh * 16;
    unsigned* const scl = scr + lane;
    unsigned sc[64];
    __syncthreads();
#pragma unroll
    for (int ch = 0; ch < 8; ++ch) {
        if (ch < nch) {
#pragma unroll
            for (int i = 0; i < 4; ++i) *(LAS v4u*)(stw + (ch & 1) * KIBUF + 64 * i * KP) = st[i];
            if (ch + 1 < nch) {
                spc += (size_t)256 * A_INP; asm volatile("" : "+v"(spc));
#pragma unroll
                for (int i = 0; i < 4; ++i) st[i] = *(const v4u*)(spc + (size_t)(64 * i) * A_INP); }
            __syncthreads();
#pragma unroll
            for (int k = 0; k < 8; ++k) {
                const int kt = 8 * ch + k;
                if (kt < nkt) {
                    const LAS unsigned char* kq = krd + (ch & 1) * KIBUF + 32 * k * KP;
                    f32x16 c = {};
#pragma unroll
                    for (int ks = 0; ks < 4; ++ks) c = __builtin_amdgcn_mfma_f32_32x32x16_f16(qa[ks], *(const LAS f16x8*)(kq + 32 * ks), c, 0, 0, 0);
                    float acc0 = 0.f, acc1 = 0.f;
#pragma unroll
                    for (int hd = 0; hd < 8; ++hd) { acc0 = fmaf(w[0][hd], fmaxf(c[hd], 0.f), acc0); acc1 = fmaf(w[1][hd], fmaxf(c[hd + 8], 0.f), acc1); }
                    unsigned key = sortable(acc0); asm volatile("" : "+v"(key)); sc[kt] = key;
                    scl[kt * 64] = sortable(acc1);
                } else { sc[kt] = 0u; }
                __builtin_amdgcn_sched_barrier(0);
            }
        } else {
#pragma unroll
            for (int k = 0; k < 8; ++k) sc[8 * ch + k] = 0u;
        }
    }
#pragma unroll 1
  for (int tq = 0; tq < 2; ++tq) {
    if (tq == 1) {
#pragma unroll
        for (int kt = 0; kt < 64; ++kt) { if (kt < nkt) sc[kt] = scl[kt * 64]; }
    }
    unsigned pre_lo = 0u, pre_hi = 0u, cge_lo = (unsigned)nkt * 32u, cge_hi = cge_lo; bool done_lo = false, done_hi = false;
    for (int bit = 31; bit >= 0; --bit) {
        const unsigned bm = 1u << bit;
        const unsigned cand = hh ? (pre_hi | bm) : (pre_lo | bm);
        unsigned cnt = 0u;
#pragma unroll
        for (int blk = 0; blk < 8; ++blk) if (nkt > 8 * blk) {
            cnt4(cnt, sc[8 * blk + 0], sc[8 * blk + 1], sc[8 * blk + 2], sc[8 * blk + 3], cand);
            cnt4(cnt, sc[8 * blk + 4], sc[8 * blk + 5], sc[8 * blk + 6], sc[8 * blk + 7], cand); }
        int v = (int)cnt;
        v += __builtin_amdgcn_update_dpp(0, v, 0xB1, 0xf, 0xf, true);
        v += __builtin_amdgcn_update_dpp(0, v, 0x4E, 0xf, 0xf, true);
        v += __builtin_amdgcn_update_dpp(0, v, 0x141, 0xf, 0xf, true);
        v += __builtin_amdgcn_update_dpp(0, v, 0x140, 0xf, 0xf, true);
        const unsigned n_lo = (unsigned)(__builtin_amdgcn_readlane(v, 0) + __builtin_amdgcn_readlane(v, 16));
        const unsigned n_hi = (unsigned)(__builtin_amdgcn_readlane(v, 32) + __builtin_amdgcn_readlane(v, 48));
        if (!done_lo && n_lo >= 256u) { pre_lo |= bm; cge_lo = n_lo; done_lo = (n_lo == 256u); }
        if (!done_hi && n_hi >= 256u) { pre_hi |= bm; cge_hi = n_hi; done_hi = (n_hi == 256u); }
        if (done_lo && done_hi) break;
    }
    const unsigned pre = hh ? pre_hi : pre_lo, cge = hh ? cge_hi : cge_lo;
    int ktc = 64; bool le = true;
    if (__any(cge > 256u)) {
        unsigned cnt = 0u;
#pragma unroll
        for (int kt = 0; kt < 64; ++kt) cnt += (sc[kt] > pre) ? 1u : 0u;
        cnt = half_sum(cnt);
        const int need = 256 - (int)cnt;
        int run = 0;
#pragma unroll
        for (int kt = 0; kt < 64; ++kt) {
            const unsigned long long b0 = __ballot(sc[kt] == pre);
            unsigned h0 = hh ? (unsigned)(b0 >> 32) : (unsigned)b0;
            const int n0 = __popc(h0);
            if (cge > 256u && run < need && run + n0 >= need) { for (int i = run + 1; i < need; ++i) h0 &= h0 - 1u; ktc = kt; le = r32 <= (__ffs((int)h0) - 1); }
            run += n0;
        }
    }
    LAS unsigned* const mq = maskQ + (mrow0 + tq) * MP;
#pragma unroll
    for (int kt = 0; kt < 64; ++kt) {
        if (kt < nkt) {
            const bool e0 = (kt < ktc) || (kt == ktc && le);
            const unsigned long long b0 = __ballot(sc[kt] > pre || (sc[kt] == pre && e0));
            if (lane == 0) { mq[kt] = (unsigned)b0; mq[2 * MP + kt] = (unsigned)(b0 >> 32); }
        }
    }
  }
}
__device__ __forceinline__ void unit(LAS unsigned char* lds, const bf16* PA, const float* WI, bf16* OA, unsigned* scr_unit, int b, int qblk) {
    int tid_ = threadIdx.x; asm volatile("" : "+v"(tid_));
    const int tid = tid_, lane = tid & 63, r32 = lane & 31, hh = lane >> 5; const int wid = __builtin_amdgcn_readfirstlane(tid >> 6);
    const size_t row0 = (size_t)b * SEQ;
    const int nkt = 2 * (qblk + 1), nk64 = qblk + 1;
    LAS unsigned* maskQ = (LAS unsigned*)(lds + LDS_MASK);
    __syncthreads();
    if (qblk < 4) { for (int i = tid; i < 64 * MP; i += 512) maskQ[i] = 0xFFFFFFFFu; }
    else {
#pragma unroll 1
        for (int p = 0; p < 2; ++p) index_select(lds, maskQ, PA, WI, scr_unit + (size_t)(p * 8 + wid) * 4096, row0, qblk * 64 + 32 * p, 32 * p, nkt, tid, wid, lane);
    }
    const int qh = wid & 1, hp = (wid >> 1) & 1, gs = wid >> 2;
    const int qrow = qblk * 64 + 32 * qh + r32;
    const int skey = tid >> 3, sc8 = tid & 7;
    const unsigned kdst = LDS_KV + skey * KP + sc8 * 16, vdst = LDS_KV + KBYTES + (sc8 >> 2) * 4096 + (skey >> 3) * 512 + (skey & 7) * 64 + (sc8 & 3) * 16;
    const unsigned vb = (unsigned)(uintptr_t)(lds + LDS_KV + gs * KV1 + KBYTES) + ((lane >> 4) & 1) * 32 + (lane & 3) * 8 + (4 * hh + ((lane & 15) >> 2)) * 64;
    const LAS unsigned* mrow = maskQ + (32 * qh + r32) * MP;
#pragma unroll 1
    for (int gp = 0; gp < 2; ++gp) {
        const int hq0 = 4 * (2 * gp + gs) + 2 * hp;
        const bf16* qp = PA + (row0 + qrow) * A_INP + hq0 * 64 + 8 * hh;
        f16x8 qf[4];
        LAS unsigned char* const qpark = lds + LDS_Q + wid * 4096 + lane * 16;
        f16x8 q1t[4];
#pragma unroll
        for (int ks = 0; ks < 4; ++ks) { qf[ks] = *(const f16x8*)(qp + 16 * ks); q1t[ks] = *(const f16x8*)(qp + 64 + 16 * ks); }
        const bf16* kg = PA + (row0 + skey) * A_INP + 1024 + (2 * gp) * 64 + sc8 * 8;
        v4u kreg0 = *(const v4u*)kg, kreg1 = *(const v4u*)(kg + 64), vreg0 = *(const v4u*)(kg + 256), vreg1 = *(const v4u*)(kg + 320);
        f32x16 o00 = {}, o01 = {}, o10 = {}, o11 = {}; float mrun0 = -INFINITY, mrun1 = -INFINITY, lrun0 = 0.f, lrun1 = 0.f;
        __syncthreads();
#pragma unroll
        for (int ks = 0; ks < 4; ++ks) *(LAS f16x8*)(qpark + ks * 1024) = q1t[ks];
#pragma unroll 1
        for (int kt = 0; kt < nk64; ++kt) {
            const unsigned bo = (kt & 1) * KVBUF2;
            *(LAS v4u*)(lds + kdst + bo) = kreg0; *(LAS v4u*)(lds + kdst + bo + KV1) = kreg1; *(LAS v4u*)(lds + vdst + bo) = vreg0; *(LAS v4u*)(lds + vdst + bo + KV1) = vreg1;
            __syncthreads();
            const LAS unsigned char* kb = lds + LDS_KV + bo + gs * KV1;
            f32x16 p00 = {}, p01 = {}, p10 = {}, p11 = {};
#pragma unroll
            for (int ks = 0; ks < 4; ++ks) {
                const f16x8 k0 = *(const LAS f16x8*)(kb + r32 * KP + ks * 32 + hh * 16);
                const f16x8 k1 = *(const LAS f16x8*)(kb + (32 + r32) * KP + ks * 32 + hh * 16);
                const f16x8 q1 = *(const LAS f16x8*)(qpark + ks * 1024);
                p00 = __builtin_amdgcn_mfma_f32_32x32x16_f16(k0, qf[ks], p00, 0, 0, 0);
                p01 = __builtin_amdgcn_mfma_f32_32x32x16_f16(k1, qf[ks], p01, 0, 0, 0);
                p10 = __builtin_amdgcn_mfma_f32_32x32x16_f16(k0, q1, p10, 0, 0, 0);
                p11 = __builtin_amdgcn_mfma_f32_32x32x16_f16(k1, q1, p11, 0, 0, 0);
                if (ks == 1) __builtin_amdgcn_sched_barrier(0);
            }
            const int w0 = (int)(mrow[2 * kt] >> (4 * hh)), w1 = (int)(mrow[2 * kt + 1] >> (4 * hh));
            f16x8 pa0[4], pa1[4];
#define DSA_PKP(P, S, J) __builtin_bit_cast(unsigned, __builtin_amdgcn_cvt_pkrtz(P[8 * (S) + 2 * (J)], P[8 * (S) + 2 * (J) + 1]))
#define DSA_SOFTMAX(PA, PB, OA_, OB_, MRUN, LRUN, PAV) do { \
            float mx = fmaxf(PA[0], PB[0]); \
            _Pragma("unroll") for (int r = 1; r < 16; ++r) mx = fmaxf(fmaxf(mx, PA[r]), PB[r]); \
            mx = xmax32(mx); \
            const float mn = fmaxf(MRUN, mx); \
            if (__any(mn > MRUN)) { const float al = __builtin_amdgcn_exp2f(MRUN - mn); LRUN *= al; \
                _Pragma("unroll") for (int r = 0; r < 16; ++r) { OA_[r] *= al; OB_[r] *= al; } } \
            MRUN = mn; \
            float ls = 0.f; \
            _Pragma("unroll") for (int r = 0; r < 16; ++r) { const int cr = (r & 3) + 8 * (r >> 2); \
                PA[r] = __builtin_bit_cast(float, __builtin_bit_cast(int, __builtin_amdgcn_exp2f(PA[r] - mn)) & __builtin_amdgcn_sbfe(w0, cr, 1)); \
                PB[r] = __builtin_bit_cast(float, __builtin_bit_cast(int, __builtin_amdgcn_exp2f(PB[r] - mn)) & __builtin_amdgcn_sbfe(w1, cr, 1)); \
                ls += PA[r] + PB[r]; } \
            LRUN += ls; \
            _Pragma("unroll") for (int s2 = 0; s2 < 2; ++s2) { u32x4 x; \
                x.x = DSA_PKP(PA, s2, 0); x.y = DSA_PKP(PA, s2, 1); x.z = DSA_PKP(PA, s2, 2); x.w = DSA_PKP(PA, s2, 3); PAV[s2] = __builtin_bit_cast(f16x8, x); \
                x.x = DSA_PKP(PB, s2, 0); x.y = DSA_PKP(PB, s2, 1); x.z = DSA_PKP(PB, s2, 2); x.w = DSA_PKP(PB, s2, 3); PAV[2 + s2] = __builtin_bit_cast(f16x8, x); } \
            __builtin_amdgcn_sched_barrier(0); } while (0)
            DSA_SOFTMAX(p00, p01, o00, o01, mrun0, lrun0, pa0);
            DSA_SOFTMAX(p10, p11, o10, o11, mrun1, lrun1, pa1);
#undef DSA_SOFTMAX
#undef DSA_PKP
            if (kt + 1 < nk64) { const bf16* kn = kg + (size_t)(kt + 1) * 64 * A_INP; kreg0 = *(const v4u*)kn; kreg1 = *(const v4u*)(kn + 64); vreg0 = *(const v4u*)(kn + 256); vreg1 = *(const v4u*)(kn + 320); }
            const unsigned vbt = vb + bo;
#pragma unroll
            for (int d0 = 0; d0 < 2; ++d0) {
                s16x4 lo[4], hi4[4];
#pragma unroll
                for (int ks = 0; ks < 4; ++ks) {
                    asm volatile("ds_read_b64_tr_b16 %0,%1 offset:%c2" : "=&v"(lo[ks]) : "v"(vbt), "i"(d0 * 4096 + ks * 1024) : "memory");
                    asm volatile("ds_read_b64_tr_b16 %0,%1 offset:%c2" : "=&v"(hi4[ks]) : "v"(vbt), "i"(d0 * 4096 + ks * 1024 + 512) : "memory"); }
                asm volatile("s_waitcnt lgkmcnt(0)" ::: "memory"); __builtin_amdgcn_sched_barrier(0);
#define DSA_PK(k) __builtin_bit_cast(f16x8, (bf16x8){lo[k][0], lo[k][1], lo[k][2], lo[k][3], hi4[k][0], hi4[k][1], hi4[k][2], hi4[k][3]})
                if (d0 == 0) {
#pragma unroll
                    for (int k = 0; k < 4; ++k) { o00 = __builtin_amdgcn_mfma_f32_32x32x16_f16(DSA_PK(k), pa0[k], o00, 0, 0, 0); o10 = __builtin_amdgcn_mfma_f32_32x32x16_f16(DSA_PK(k), pa1[k], o10, 0, 0, 0); }
                } else {
#pragma unroll
                    for (int k = 0; k < 4; ++k) { o01 = __builtin_amdgcn_mfma_f32_32x32x16_f16(DSA_PK(k), pa0[k], o01, 0, 0, 0); o11 = __builtin_amdgcn_mfma_f32_32x32x16_f16(DSA_PK(k), pa1[k], o11, 0, 0, 0); }
                }
#undef DSA_PK
            }
        }
        lrun0 += __shfl_xor(lrun0, 32); lrun1 += __shfl_xor(lrun1, 32);
        const float inv0 = 1.0f / lrun0, inv1 = 1.0f / lrun1;
        bf16* op = OA + (row0 + qrow) * DM + hq0 * 64 + 4 * hh;
#pragma unroll
        for (int gq = 0; gq < 4; ++gq) {
            u32x2 x;
            x.x = pg8::cvt_pk_bf16(o00[4 * gq] * inv0, o00[4 * gq + 1] * inv0); x.y = pg8::cvt_pk_bf16(o00[4 * gq + 2] * inv0, o00[4 * gq + 3] * inv0); *(u32x2*)(op + 8 * gq) = x;
            x.x = pg8::cvt_pk_bf16(o01[4 * gq] * inv0, o01[4 * gq + 1] * inv0); x.y = pg8::cvt_pk_bf16(o01[4 * gq + 2] * inv0, o01[4 * gq + 3] * inv0); *(u32x2*)(op + 32 + 8 * gq) = x;
            x.x = pg8::cvt_pk_bf16(o10[4 * gq] * inv1, o10[4 * gq + 1] * inv1); x.y = pg8::cvt_pk_bf16(o10[4 * gq + 2] * inv1, o10[4 * gq + 3] * inv1); *(u32x2*)(op + 64 + 8 * gq) = x;
            x.x = pg8::cvt_pk_bf16(o11[4 * gq] * inv1, o11[4 * gq + 1] * inv1); x.y = pg8::cvt_pk_bf16(o11[4 * gq + 2] * inv1, o11[4 * gq + 3] * inv1); *(u32x2*)(op + 96 + 8 * gq) = x;
        }
    }
}
__device__ __forceinline__ void phase(Frame& F, const Args& A) {
    const bf16* PA = (const bf16*)(A.ws + WS_PA); const float* WI = (const float*)(A.ws + WS_WI); bf16* OA = (bf16*)(A.ws + WS_OA);
    unsigned* scr = (unsigned*)(A.ws + WS_KVB);
    for (int u = blockIdx.x; u < 256; u += F.G) { const int b = u >> 4, j = u & 15; unit(F.lds, PA, WI, OA, scr + (size_t)(2 * u) * 65536, b, 31 - j); unit(F.lds, PA, WI, OA, scr + (size_t)(2 * u + 1) * 65536, b, j); }
}
}
namespace mla {
typedef float f32x16 __attribute__((ext_vector_type(16)));
typedef short s16x4 __attribute__((ext_vector_type(4)));
constexpr int KP = 208;
constexpr int LDS_K = 0, LDS_V = 64 * KP, BUFB = LDS_V + 8192, LDS_END = 2 * BUFB;
__device__ __forceinline__ float xmax32(float m) { auto rr = __builtin_amdgcn_permlane32_swap(__float_as_uint(m), __float_as_uint(m), false, false); return fmaxf(__uint_as_float(rr[0]), __uint_as_float(rr[1])); }
__device__ __forceinline__ void attn_unit(LAS unsigned char* lds, const bf16* QB, const bf16* KVB, const bf16* CB, bf16* OB, int b, int h, int qb) {
    const int tid = threadIdx.x, lane = tid & 63, r32 = lane & 31, hi = lane >> 5; const int wid = __builtin_amdgcn_readfirstlane(tid >> 6);
    const int c0 = qb * 4, cw = c0 + (wid >> 1), ntile = c0 + 4;
    const size_t row0 = (size_t)b * SEQ;
    const bf16* qp = QB + (row0 + (size_t)qb * 256 + wid * 32 + r32) * QUP + h * 96 + hi * 8;
    bf16x8 qf[6];
#pragma unroll
    for (int ks = 0; ks < 6; ++ks) qf[ks] = *(const bf16x8*)(qp + ks * 16);
    f32x16 o0 = {}, o1 = {}; float mrun = -INFINITY, lrun = 0.f;
    const unsigned vb = (unsigned)(uintptr_t)(lds + LDS_V) + ((lane >> 4) & 1) * 32 + (lane & 3) * 8 + (4 * hi + ((lane & 15) >> 2)) * 64;
    const int ka = tid / 12, kca = tid % 12, kb_ = (tid + 512) / 12, kcb = (tid + 512) % 12; const bool has2 = tid < 256;
    const bf16* ksa = (kca < 8) ? (KVB + (row0 + ka) * KVUP + h * 128 + kca * 8) : (CB + (row0 + ka) * B_INP + 640 + (kca - 8) * 8);
    const bf16* ksb = (kcb < 8) ? (KVB + (row0 + kb_) * KVUP + h * 128 + kcb * 8) : (CB + (row0 + kb_) * B_INP + 640 + (kcb - 8) * 8);
    const size_t stepa = (size_t)64 * ((kca < 8) ? KVUP : B_INP), stepb = (size_t)64 * ((kcb < 8) ? KVUP : B_INP);
    const bf16* vs = KVB + (row0 + (tid >> 3)) * KVUP + h * 128 + 64 + (tid & 7) * 8;
    const unsigned kda = LDS_K + ka * KP + kca * 16, kdb = LDS_K + kb_ * KP + kcb * 16;
    const unsigned vd = LDS_V + ((tid & 7) >> 2) * 4096 + ((tid >> 3) >> 3) * 512 + ((tid >> 3) & 7) * 64 + (tid & 3) * 16;
    v4u ra = *(const v4u*)ksa, rb = has2 ? *(const v4u*)ksb : (v4u){0u, 0u, 0u, 0u}, rv = *(const v4u*)vs;
    __syncthreads();
    for (int kt = 0; kt < ntile; ++kt) {
        const unsigned bo = (kt & 1) * BUFB;
        *(LAS v4u*)(lds + kda + bo) = ra; if (has2) *(LAS v4u*)(lds + kdb + bo) = rb; *(LAS v4u*)(lds + vd + bo) = rv;
        if (kt + 1 < ntile) { ra = *(const v4u*)(ksa + (size_t)(kt + 1) * stepa); if (has2) rb = *(const v4u*)(ksb + (size_t)(kt + 1) * stepb); rv = *(const v4u*)(vs + (size_t)(kt + 1) * 64 * KVUP); }
        __syncthreads();
        if (kt <= cw) {
            f32x16 p0 = {}, p1 = {};
#pragma unroll
            for (int ks = 0; ks < 6; ++ks) {
                const bf16x8 k0 = *(const LAS bf16x8*)(lds + bo + LDS_K + r32 * KP + ks * 32 + hi * 16);
                const bf16x8 k1 = *(const LAS bf16x8*)(lds + bo + LDS_K + (32 + r32) * KP + ks * 32 + hi * 16);
                p0 = __builtin_amdgcn_mfma_f32_32x32x16_bf16(k0, qf[ks], p0, 0, 0, 0);
                p1 = __builtin_amdgcn_mfma_f32_32x32x16_bf16(k1, qf[ks], p1, 0, 0, 0);
            }
            float mx = fmaxf(p0[0], p1[0]);
#pragma unroll
            for (int r = 1; r < 16; ++r) mx = fmaxf(mx, fmaxf(p0[r], p1[r]));
            mx = xmax32(mx);
            const float mn = fmaxf(mrun, mx);
            if (__any(mn > mrun)) { const float alpha = __builtin_amdgcn_exp2f(mrun - mn); lrun *= alpha;
#pragma unroll
                for (int r = 0; r < 16; ++r) { o0[r] *= alpha; o1[r] *= alpha; } }
            mrun = mn;
            float ls = 0.f;
#pragma unroll
            for (int r = 0; r < 16; ++r) { p0[r] = __builtin_amdgcn_exp2f(p0[r] - mn); p1[r] = __builtin_amdgcn_exp2f(p1[r] - mn); ls += p0[r] + p1[r]; }
            lrun += ls;
            const unsigned vbt = vb + bo;
            bf16x8 pa[4];
#pragma unroll
            for (int s = 0; s < 2; ++s) {
                u32x4 w0, w1;
                w0.x = pg8::cvt_pk_bf16(p0[8 * s + 0], p0[8 * s + 1]); w0.y = pg8::cvt_pk_bf16(p0[8 * s + 2], p0[8 * s + 3]); w0.z = pg8::cvt_pk_bf16(p0[8 * s + 4], p0[8 * s + 5]); w0.w = pg8::cvt_pk_bf16(p0[8 * s + 6], p0[8 * s + 7]);
                w1.x = pg8::cvt_pk_bf16(p1[8 * s + 0], p1[8 * s + 1]); w1.y = pg8::cvt_pk_bf16(p1[8 * s + 2], p1[8 * s + 3]); w1.z = pg8::cvt_pk_bf16(p1[8 * s + 4], p1[8 * s + 5]); w1.w = pg8::cvt_pk_bf16(p1[8 * s + 6], p1[8 * s + 7]);
                pa[s] = __builtin_bit_cast(bf16x8, w0); pa[2 + s] = __builtin_bit_cast(bf16x8, w1);
            }
#pragma unroll
            for (int d0 = 0; d0 < 2; ++d0) {
                s16x4 lo[4], hi4[4];
#pragma unroll
                for (int ks = 0; ks < 4; ++ks) {
                    asm volatile("ds_read_b64_tr_b16 %0,%1 offset:%c2" : "=&v"(lo[ks]) : "v"(vbt), "i"(d0 * 4096 + ks * 1024) : "memory");
                    asm volatile("ds_read_b64_tr_b16 %0,%1 offset:%c2" : "=&v"(hi4[ks]) : "v"(vbt), "i"(d0 * 4096 + ks * 1024 + 512) : "memory"); }
                asm volatile("s_waitcnt lgkmcnt(0)" ::: "memory"); __builtin_amdgcn_sched_barrier(0);
#define MLA_PK(k) (bf16x8){lo[k][0], lo[k][1], lo[k][2], lo[k][3], hi4[k][0], hi4[k][1], hi4[k][2], hi4[k][3]}
                if (d0 == 0) { o0 = __builtin_amdgcn_mfma_f32_32x32x16_bf16(MLA_PK(0), pa[0], o0, 0, 0, 0); o0 = __builtin_amdgcn_mfma_f32_32x32x16_bf16(MLA_PK(1), pa[1], o0, 0, 0, 0);
                               o0 = __builtin_amdgcn_mfma_f32_32x32x16_bf16(MLA_PK(2), pa[2], o0, 0, 0, 0); o0 = __builtin_amdgcn_mfma_f32_32x32x16_bf16(MLA_PK(3), pa[3], o0, 0, 0, 0); }
                else         { o1 = __builtin_amdgcn_mfma_f32_32x32x16_bf16(MLA_PK(0), pa[0], o1, 0, 0, 0); o1 = __builtin_amdgcn_mfma_f32_32x32x16_bf16(MLA_PK(1), pa[1], o1, 0, 0, 0);
                               o1 = __builtin_amdgcn_mfma_f32_32x32x16_bf16(MLA_PK(2), pa[2], o1, 0, 0, 0); o1 = __builtin_amdgcn_mfma_f32_32x32x16_bf16(MLA_PK(3), pa[3], o1, 0, 0, 0); }
#undef MLA_PK
            }
        }
    }
    lrun += __shfl_xor(lrun, 32);
    const float inv = 1.0f / lrun;
    bf16* op = OB + (row0 + (size_t)qb * 256 + wid * 32 + r32) * DM + h * 64 + 4 * hi;
#pragma unroll
    for (int g = 0; g < 4; ++g) {
        u32x2 w; w.x = pg8::cvt_pk_bf16(o0[4 * g] * inv, o0[4 * g + 1] * inv); w.y = pg8::cvt_pk_bf16(o0[4 * g + 2] * inv, o0[4 * g + 3] * inv); *(u32x2*)(op + 8 * g) = w;
        u32x2 z; z.x = pg8::cvt_pk_bf16(o1[4 * g] * inv, o1[4 * g + 1] * inv); z.y = pg8::cvt_pk_bf16(o1[4 * g + 2] * inv, o1[4 * g + 3] * inv); *(u32x2*)(op + 32 + 8 * g) = z;
    }
}
__device__ __forceinline__ void attn_phase(Frame& F, const Args& A) {
    const bf16* QB = (const bf16*)(A.ws + WS_QB); const bf16* KVB = (const bf16*)(A.ws + WS_KVB); const bf16* CB = (const bf16*)(A.ws + WS_CB); bf16* OB = (bf16*)(A.ws + WS_OB);
    for (int u = blockIdx.x; u < BATCH * 16 * 8; u += F.G) { const int bh = u & 255, qb = u >> 8; attn_unit(F.lds, QB, KVB, CB, OB, bh >> 4, bh & 15, qb); }
}
}
__global__ void __launch_bounds__(NWAVES * 64, 2) mk_fwd(Args args) {
    extern __shared__ __attribute__((aligned(16))) unsigned char lds_raw[];
    Frame F;
    F.lds = (LAS unsigned char*)lds_raw;
    F.MISC = (volatile LAS unsigned*)(F.lds + MISC_OFF);
    F.tid = threadIdx.x; F.lane = F.tid & 63; F.wave = __builtin_amdgcn_readfirstlane(F.tid >> 6);
    F.G = gridDim.x;
    unsigned char* ws = args.ws;
    F.ctl = (gu32*)(ws + WS_CTL);
    for (int u = F.tid; u < (LDS_BYTES - LDSCTL_OFF) / 4; u += NWAVES * 64) ((LAS unsigned*)(F.lds + LDSCTL_OFF))[u] = 0u;
    __syncthreads();
    XcdBarrier bar; bar.bar = (unsigned*)(F.ctl + CW_BAR); bar.x = 0; bar.st = nullptr;
    if (N_LAUNCHES == 1) bar = xcd_barrier_post((unsigned*)(F.ctl + CW_BAR), F.MISC + 8);
#define GRID_BAR() do { if (N_LAUNCHES == 1) xcd_barrier(bar); } while (0)
    const int lo = args.ph_lo, hi = args.ph_hi;
#ifndef PHMASK
#define PHMASK 0x1fff
#endif
#define IN(k) (((PHMASK >> (k)) & 1) && lo <= (k) && (k) < hi)
    bf16* const XB = (bf16*)(ws + WS_XB); float* const SS = (float*)(ws + WS_SS); float* const SSB = (float*)(ws + WS_SSB);
    const float* const cosA = (const float*)(ws + WS_COSA); const float* const sinA = (const float*)(ws + WS_SINA);
    const float* const cosB = (const float*)(ws + WS_COSB); const float* const sinB = (const float*)(ws + WS_SINB);
    const int bid = (int)blockIdx.x;

    if (IN(0)) { p0_prologue(F, args); GRID_BAR(); }
    if (IN(1)) {
        pg8::Gemm g{XB, (const bf16*)(ws + WS_WAIN), M, A_INP, DM, DM, DM}; pg8::StaticOrder S; S.init(M, A_INP, F.G, bid);
        pg8::EpiDsaIn E{(bf16*)(ws + WS_PA), (float*)(ws + WS_WI), SS, cosA, sinA, IDX_WSCALE, QSCALE_A};
        pg8::gemm_phase<pg8::EpiDsaIn, pg8::StaticOrder, true, true, true>(F.lds, g, S, E);
        GRID_BAR();
    }
    if (IN(2)) { if (F.wave >= 4) __builtin_amdgcn_s_setprio(1); dsa::phase(F, args); __builtin_amdgcn_s_setprio(0); GRID_BAR(); }
#if defined(PROBE_DUP) && PROBE_DUP == 2
    if (IN(2)) { if (F.wave >= 4) __builtin_amdgcn_s_setprio(1); dsa::phase(F, args); __builtin_amdgcn_s_setprio(0); GRID_BAR(); }
#endif
    if (IN(3)) {
        pg8::Gemm g{(const bf16*)(ws + WS_OA), (const bf16*)(ws + WS_WAOUT), M, DM, DM, DM, DM}; pg8::StaticOrder S; S.init(M, DM, F.G, bid);
        pg8::EpiResid E{(const float*)args.in[0], args.out, XB, SS};
        pg8::gemm_phase<pg8::EpiResid, pg8::StaticOrder, true, true, false>(F.lds, g, S, E);
        GRID_BAR();
    }
    if (IN(4)) {
        pg8::Gemm g{XB, (const bf16*)(ws + WS_WUP0), M, FF, DM, DM, DM}; pg8::StaticOrder S; S.init(M, FF, F.G, bid);
        pg8::EpiMlpUp E{(bf16*)(ws + WS_H), SS};
        pg8::gemm_phase<pg8::EpiMlpUp, pg8::StaticOrder, true, true, false>(F.lds, g, S, E);
        GRID_BAR();
    }
    if (IN(5)) {
        pg8::Gemm g{(const bf16*)(ws + WS_H), (const bf16*)(ws + WS_WDN0), M, DM, FF, FF, FF}; pg8::StaticOrder S; S.init(M, DM, F.G, bid);
        pg8::EpiResid E{args.out, args.out, XB, SS};
        pg8::gemm_phase<pg8::EpiResid, pg8::StaticOrder, true, true, false>(F.lds, g, S, E);
        GRID_BAR();
    }
    if (IN(6)) {
        pg8::Gemm g{XB, (const bf16*)(ws + WS_WBIN), M, B_INP, DM, DM, DM}; pg8::StaticOrder S; S.init(M, B_INP, F.G, bid);
        pg8::EpiMlaIn E{(bf16*)(ws + WS_CB), SSB, SS, cosB, sinB};
        pg8::gemm_phase<pg8::EpiMlaIn, pg8::StaticOrder, true, true, false>(F.lds, g, S, E);
        GRID_BAR();
    }
    if (IN(7)) {
#ifndef NO_QUP
        { pg8::Gemm g{(const bf16*)(ws + WS_CB), (const bf16*)(ws + WS_WQUP), M, QUP, QLORA, B_INP, QLORA}; pg8::StaticOrder S; S.init(M, QUP, F.G, bid);
          pg8::EpiQUp E{(bf16*)(ws + WS_QB), SSB, cosB, sinB, QSCALE_B};
          pg8::gemm_phase<pg8::EpiQUp, pg8::StaticOrder, true, true, false>(F.lds, g, S, E); }
#endif
#ifndef NO_KVUP
        { pg8::Gemm g{(const bf16*)(ws + WS_CB) + QLORA, (const bf16*)(ws + WS_WKVUP), M, KVUP, KVLORA, B_INP, KVLORA}; pg8::StaticOrder S; S.init(M, KVUP, F.G, bid);
          pg8::EpiKvUp E{(bf16*)(ws + WS_KVB), SSB};
          pg8::gemm_phase<pg8::EpiKvUp, pg8::StaticOrder, true, true, false>(F.lds, g, S, E); }
#endif
        GRID_BAR();
    }
    if (IN(8)) { if (F.wave >= 4) __builtin_amdgcn_s_setprio(1); mla::attn_phase(F, args); __builtin_amdgcn_s_setprio(0); GRID_BAR(); }
#if defined(PROBE_DUP) && PROBE_DUP == 8
    if (IN(8)) { if (F.wave >= 4) __builtin_amdgcn_s_setprio(1); mla::attn_phase(F, args); __builtin_amdgcn_s_setprio(0); GRID_BAR(); }
#endif
    if (IN(9)) {
        pg8::Gemm g{(const bf16*)(ws + WS_OB), (const bf16*)(ws + WS_WBOUT), M, DM, DM, DM, DM}; pg8::StaticOrder S; S.init(M, DM, F.G, bid);
        pg8::EpiResid E{args.out, args.out, XB, SS};
        pg8::gemm_phase<pg8::EpiResid, pg8::StaticOrder, true, true, false>(F.lds, g, S, E);
        GRID_BAR();
    }
    if (IN(10)) {
        pg8::Gemm g{XB, (const bf16*)(ws + WS_WUP1), M, FF, DM, DM, DM}; pg8::StaticOrder S; S.init(M, FF, F.G, bid);
        pg8::EpiMlpUp E{(bf16*)(ws + WS_H), SS};
        pg8::gemm_phase<pg8::EpiMlpUp, pg8::StaticOrder, true, true, false>(F.lds, g, S, E);
        GRID_BAR();
    }
    if (IN(11)) {
        pg8::Gemm g{(const bf16*)(ws + WS_H), (const bf16*)(ws + WS_WDN1), M, DM, FF, FF, FF}; pg8::StaticOrder S; S.init(M, DM, F.G, bid);
        pg8::EpiResid E{args.out, args.out, nullptr, SS};
        pg8::gemm_phase<pg8::EpiResid, pg8::StaticOrder, true, true, false>(F.lds, g, S, E);
        GRID_BAR();
    }
    if (IN(12)) { p12_final_norm(F, args); }
#undef IN
#undef GRID_BAR
}

extern "C" void kernel_launch(void* const* d_in, const int* in_sizes, int n_in, void* d_out, int out_size, void* d_ws, size_t ws_size, hipStream_t stream) {
    static int grid = 0;
    if (grid == 0) {
        if (n_in != 15 || in_sizes[0] != M * DM || out_size != M * DM || ws_size < WS_END) { fprintf(stderr, "kernel_launch: unexpected shapes / workspace (n_in %d, in0 %d, out %d, ws %zu); nothing launched\n", n_in, n_in > 0 ? in_sizes[0] : -1, out_size, ws_size); grid = -1; return; }
        int dev = 0, cus = 0, per_cu = 0;
        if (hipGetDevice(&dev) != hipSuccess || hipDeviceGetAttribute(&cus, hipDeviceAttributeMultiprocessorCount, dev) != hipSuccess) { grid = -1; return; }
        if (hipFuncSetAttribute((const void*)mk_fwd, hipFuncAttributeMaxDynamicSharedMemorySize, LDS_BYTES) != hipSuccess) { fprintf(stderr, "kernel_launch: hipFuncSetAttribute failed\n"); grid = -1; return; }
        if (hipOccupancyMaxActiveBlocksPerMultiprocessor(&per_cu, (const void*)mk_fwd, NWAVES * 64, LDS_BYTES) != hipSuccess || per_cu < 1) { fprintf(stderr, "kernel_launch: occupancy query reports %d blocks per CU\n", per_cu); }
        (void)hipGetLastError();
        grid = cus;
    }
    if (grid < 0) return;
    if (hipMemsetAsync((char*)d_ws + WS_CTL, 0, CTL_ZERO_BYTES, stream) != hipSuccess) return;
    Args a{};
    for (int i = 0; i < 15; ++i) a.in[i] = d_in[i];
    a.out = (float*)d_out; a.ws = (unsigned char*)d_ws;
    for (int i = 0; i < 8; ++i) a.inv_a[i] = (float)pow(500000.0, -(double)i / 8.0);
    for (int i = 0; i < 16; ++i) a.inv_b[i] = (float)pow(500000.0, -(double)i / 16.0);
    if (N_LAUNCHES == 1) { a.ph_lo = 0; a.ph_hi = N_PHASES; hipLaunchKernelGGL(mk_fwd, dim3(grid), dim3(NWAVES * 64), LDS_BYTES, stream, a); }
    else for (int li = 0; li < N_PHASES; ++li) { a.ph_lo = li; a.ph_hi = li + 1; hipLaunchKernelGGL(mk_fwd, dim3(grid), dim3(NWAVES * 64), LDS_BYTES, stream, a); }
    const hipError_t le = hipPeekAtLastError();
    if (le != hipSuccess) fprintf(stderr, "kernel_launch: launch failed: %s\n", hipGetErrorName(le));
}
```

```cpp
#include <hip/hip_runtime.h>
#include <cstdio>
#include <cstdint>
#include <cmath>
namespace pg8 {
#define PG8_LAS __attribute__((address_space(3)))
typedef unsigned short bf16_t;
typedef short bf16x8 __attribute__((ext_vector_type(8)));
typedef float f32x4 __attribute__((ext_vector_type(4)));
typedef unsigned u32x4 __attribute__((ext_vector_type(4)));
constexpr int BM = 256, BK = 64, HALF = 128, HTB = HALF * BK * 2  , STAGE_BYTES = 8 * HTB, NXCD = 8, WGM = 8;

__host__ __device__ __forceinline__ int lds_byte(int r, int c) { const int st = (r >> 4) * 2 + (c >> 5), rr = r & 15, cc = c & 31, ob = rr * 64 + cc * 2; return st * 1024 + (ob ^ (((ob >> 9) & 1) << 5)); }
__host__ __device__ __forceinline__ void stage_rc(int b, int& R, int& C) { const int st = b / 1024, sb = b % 1024, swz = sb ^ (((sb >> 9) & 1) << 5); R = (st >> 1) * 16 + swz / 64; C = (st & 1) * 32 + (swz % 64) / 2; }
__host__ __device__ __forceinline__ int perm32(int rho) { const int n = rho >> 4, i = rho & 15; return 8 * (i >> 2) + 4 * n + (i & 3); }

struct Unit { int pm, pn; };
struct Gemm { const bf16_t* A; const bf16_t* Bt; int M, N, K, lda, ldb; };

struct StaticOrder {
    int nM, nN, nwg, G, c;
    __host__ __device__ void init(int M, int N, int G_, int c_) { nM = M / BM; nN = N / BM; nwg = nM * nN; G = G_; c = c_; }
    __host__ __device__ bool next(int i, Unit& u) const {
        const long L = (long)i * G + c; if (L >= nwg) return false;
        int wgid = (int)L; { const int q = nwg / NXCD, r = nwg % NXCD, xcd = wgid % NXCD, off = wgid / NXCD; wgid = (xcd < r ? xcd * (q + 1) : r * (q + 1) + (xcd - r) * q) + off; }
        const int nig = WGM * nN, gid = wgid / nig, fm = gid * WGM, gsz = (nM - fm) < WGM ? (nM - fm) : WGM;
        u.pm = fm + ((wgid % nig) % gsz); u.pn = (wgid % nig) / gsz; return true;
    }
    __device__ __forceinline__ void a_ready(const Unit&) const {}
    __device__ __forceinline__ void done(const Unit&) const {}
};

__device__ __forceinline__ unsigned cvt_pk_bf16(float lo, float hi) { unsigned r; asm volatile("v_cvt_pk_bf16_f32 %0, %1, %2" : "=v"(r) : "v"(lo), "v"(hi)); return r; }
typedef _Float16 f16x8_t __attribute__((ext_vector_type(8)));
typedef _Float16 f16x2_t __attribute__((ext_vector_type(2)));
template <bool F16> __device__ __forceinline__ f32x4 mma16(bf16x8 a, bf16x8 b, f32x4 c) {
    if constexpr (F16) return __builtin_amdgcn_mfma_f32_16x16x32_f16(__builtin_bit_cast(f16x8_t, a), __builtin_bit_cast(f16x8_t, b), c, 0, 0, 0);
    else return __builtin_amdgcn_mfma_f32_16x16x32_bf16(a, b, c, 0, 0, 0);
}
__device__ __forceinline__ unsigned cvt_pk_f16(float lo, float hi) { f16x2_t t = {(_Float16)lo, (_Float16)hi}; return __builtin_bit_cast(unsigned, t); }
__device__ __forceinline__ u32x4 pack8_bf16(f32x4 a, f32x4 b) { u32x4 w; w.x = cvt_pk_bf16(a[0], a[1]); w.y = cvt_pk_bf16(a[2], a[3]); w.z = cvt_pk_bf16(b[0], b[1]); w.w = cvt_pk_bf16(b[2], b[3]); return w; }
__device__ __forceinline__ u32x4 pack8_f16(f32x4 a, f32x4 b) { u32x4 w; w.x = cvt_pk_f16(a[0], a[1]); w.y = cvt_pk_f16(a[2], a[3]); w.z = cvt_pk_f16(b[0], b[1]); w.w = cvt_pk_f16(b[2], b[3]); return w; }
typedef unsigned u32x2 __attribute__((ext_vector_type(2)));
__device__ __forceinline__ u32x2 pack4_bf16(f32x4 a) { u32x2 w; w.x = cvt_pk_bf16(a[0], a[1]); w.y = cvt_pk_bf16(a[2], a[3]); return w; }
__device__ __forceinline__ f32x4 shfl4(f32x4 v, int x) { f32x4 r; r[0] = __shfl_xor(v[0], x); r[1] = __shfl_xor(v[1], x); r[2] = __shfl_xor(v[2], x); r[3] = __shfl_xor(v[3], x); return r; }
__device__ __forceinline__ float sum4(f32x4 v) { return (v[0] + v[1]) + (v[2] + v[3]); }
__device__ __forceinline__ float dot4(f32x4 v) { return (v[0] * v[0] + v[1] * v[1]) + (v[2] * v[2] + v[3] * v[3]); }
constexpr float RMS_EPS = 1e-6f;
__device__ __forceinline__ float rstd_from(const float* p, int n4, float inv_cnt) {
    float s = 0.f;
#pragma unroll 4
    for (int i = 0; i < n4; ++i) s += sum4(((const f32x4*)p)[i]);
    return __builtin_amdgcn_rsqf(s * inv_cnt + RMS_EPS);
}

__device__ __forceinline__ void rstd8(float (&rs)[2][4], const float* p, int stride, int n4, float inv_cnt, int rowbase) {
#pragma unroll
    for (int ai = 0; ai < 2; ++ai)
#pragma unroll
        for (int m = 0; m < 4; ++m) rs[ai][m] = rstd_from(p + (size_t)(rowbase + ai * HALF + m * 16) * stride, n4, inv_cnt);
}
struct EpiDsaIn {
    static constexpr bool PERM = true, AFTER_DRAIN = false;
    bf16_t* PA; float* WI; const float* SS; const float* cosA; const float* sinA; float wscale, qscale;
    __device__ __forceinline__ void operator()(const f32x4 (&acc)[2][2][4][2], const Unit& u, int wr, int wc, int fr, int fq) const {
        const bool ropew = (wc & 1) == 0;
#pragma unroll
        for (int ai = 0; ai < 2; ++ai) {
#pragma unroll
          for (int mh = 0; mh < 2; ++mh) {
            f32x4 c0v[4], c1v[4], s0v[4], s1v[4]; float rsv[4];
#pragma unroll
            for (int m = 2 * mh; m < 2 * mh + 2; ++m) { const int row = u.pm * BM + ai * HALF + wr * 64 + m * 16 + fr; rsv[m] = rstd_from(SS + (size_t)row * 16, 4, 1.0f / 1024.0f);
                if (ropew) { c0v[m] = *(const f32x4*)(cosA + (size_t)row * 8); c1v[m] = *(const f32x4*)(cosA + (size_t)row * 8 + 4); s0v[m] = *(const f32x4*)(sinA + (size_t)row * 8); s1v[m] = *(const f32x4*)(sinA + (size_t)row * 8 + 4); } }
#pragma unroll
            for (int m = 2 * mh; m < 2 * mh + 2; ++m) {
                const int row = u.pm * BM + ai * HALF + wr * 64 + m * 16 + fr;
                const float rs = rsv[m];
                f32x4 c0 = {}, c1 = {}, s0 = {}, s1 = {}; if (ropew) { c0 = c0v[m]; c1 = c1v[m]; s0 = s0v[m]; s1 = s1v[m]; }
#pragma unroll
                for (int bj = 0; bj < 2; ++bj) {
                    const int cb = u.pn * BM + bj * HALF + wc * 32;
                    const int col8 = cb + 8 * fq;
                    f32x4 v0 = acc[ai][bj][m][0] * rs, v1 = acc[ai][bj][m][1] * rs;
                    const bool ropeg = ((cb & 63) == 0) && (cb < 1280 || (cb >= 1536 && cb < 2112));
                    if (ropeg) {
                        const f32x4 p0 = shfl4(v0, 16), p1 = shfl4(v1, 16);
                        if (fq == 0) { v0 = v0 * c0 - p0 * s0; v1 = v1 * c1 - p1 * s1; }
                        else if (fq == 1) { v0 = v0 * c0 + p0 * s0; v1 = v1 * c1 + p1 * s1; }
                    }
                    if (cb < 1024) { v0 = v0 * qscale; v1 = v1 * qscale; }
                    if (cb < 2112) *(u32x4*)(PA + (size_t)row * 2304 + col8) = pack8_f16(v0, v1);
                    else if (cb == 2112 && fq == 0) { *(f32x4*)(WI + (size_t)row * 8) = v0 * wscale; *(f32x4*)(WI + (size_t)row * 8 + 4) = v1 * wscale; }
                }
            }
          }
        }
    }
};
struct EpiResid {
    static constexpr bool PERM = true, AFTER_DRAIN = false;
    const float* base; float* out; bf16_t* XB; float* SS;
    __device__ __forceinline__ void operator()(const f32x4 (&acc)[2][2][4][2], const Unit& u, int wr, int wc, int fr, int fq) const {
#pragma unroll
        for (int ai = 0; ai < 2; ++ai) {
            f32x4 b0[4][2], b1[4][2];
#pragma unroll
            for (int m = 0; m < 4; ++m) { const int row = u.pm * BM + ai * HALF + wr * 64 + m * 16 + fr;
#pragma unroll
                for (int bj = 0; bj < 2; ++bj) { const float* bp = base + (size_t)row * 1024 + u.pn * BM + bj * HALF + wc * 32 + 8 * fq; b0[m][bj] = *(const f32x4*)bp; b1[m][bj] = *(const f32x4*)(bp + 4); } }
#pragma unroll
            for (int m = 0; m < 4; ++m) {
                const int row = u.pm * BM + ai * HALF + wr * 64 + m * 16 + fr;
                float ssq = 0.f;
#pragma unroll
                for (int bj = 0; bj < 2; ++bj) {
                    const int col8 = u.pn * BM + bj * HALF + wc * 32 + 8 * fq;
                    const f32x4 v0 = acc[ai][bj][m][0] + b0[m][bj], v1 = acc[ai][bj][m][1] + b1[m][bj];
                    float* op = out + (size_t)row * 1024 + col8;
                    *(f32x4*)op = v0; *(f32x4*)(op + 4) = v1;
                    if (XB) *(u32x4*)(XB + (size_t)row * 1024 + col8) = pack8_bf16(v0, v1);
                    ssq += dot4(v0) + dot4(v1);
                }
                ssq += __shfl_xor(ssq, 16); ssq += __shfl_xor(ssq, 32);
                if (fq == 0) SS[(size_t)row * 16 + u.pn * 4 + wc] = ssq;
            }
        }
    }
};
struct EpiMlpUp {
    static constexpr bool PERM = true, AFTER_DRAIN = false;
    bf16_t* H; const float* SS;
    __device__ __forceinline__ void operator()(const f32x4 (&acc)[2][2][4][2], const Unit& u, int wr, int wc, int fr, int fq) const {
        float rsv[2][4]; rstd8(rsv, SS, 16, 4, 1.0f / 1024.0f, u.pm * BM + wr * 64 + fr);
#pragma unroll
        for (int ai = 0; ai < 2; ++ai)
#pragma unroll
            for (int m = 0; m < 4; ++m) {
                const int row = u.pm * BM + ai * HALF + wr * 64 + m * 16 + fr;
                const float rs = rsv[ai][m];
#pragma unroll
                for (int bj = 0; bj < 2; ++bj) {
                    const int col8 = u.pn * BM + bj * HALF + wc * 32 + 8 * fq;
                    f32x4 v0 = acc[ai][bj][m][0] * rs, v1 = acc[ai][bj][m][1] * rs;
                    const f32x4 z = {0.f, 0.f, 0.f, 0.f};
                    v0 = __builtin_elementwise_max(v0, z); v1 = __builtin_elementwise_max(v1, z);
                    *(u32x4*)(H + (size_t)row * 4096 + col8) = pack8_bf16(v0 * v0, v1 * v1);
                }
            }
    }
};
struct EpiMlaIn {
    static constexpr bool PERM = false, AFTER_DRAIN = false;
    bf16_t* CB; float* SSB; const float* SS; const float* cosB; const float* sinB;
    __device__ __forceinline__ void operator()(const f32x4 (&acc)[2][2][4][2], const Unit& u, int wr, int wc, int fr, int fq) const {
#pragma unroll
        for (int ai = 0; ai < 2; ++ai) {
#pragma unroll
          for (int mh = 0; mh < 2; ++mh) {
            float rsv[4];
#pragma unroll
            for (int m = 2 * mh; m < 2 * mh + 2; ++m) rsv[m] = rstd_from(SS + (size_t)(u.pm * BM + ai * HALF + wr * 64 + m * 16 + fr) * 16, 4, 1.0f / 1024.0f);
#pragma unroll
            for (int m = 2 * mh; m < 2 * mh + 2; ++m) {
                const int row = u.pm * BM + ai * HALF + wr * 64 + m * 16 + fr;
                const float rs = rsv[m];
#pragma unroll
                for (int bj = 0; bj < 2; ++bj) {
                    const int cb = u.pn * BM + bj * HALF + wc * 32;
                    f32x4 v0 = acc[ai][bj][m][0] * rs, v1 = acc[ai][bj][m][1] * rs;
                    if (cb == 640) { const f32x4 c = *(const f32x4*)(cosB + (size_t)row * 16 + 4 * fq), sn = *(const f32x4*)(sinB + (size_t)row * 16 + 4 * fq);
                        const f32x4 o0 = v0 * c - v1 * sn, o1 = v1 * c + v0 * sn; v0 = o0; v1 = o1; }
                    if (cb < 672) { bf16_t* p = CB + (size_t)row * 768 + cb + 4 * fq; *(u32x2*)p = pack4_bf16(v0); *(u32x2*)(p + 16) = pack4_bf16(v1); }
                    if (cb < 640) {
                        float ssq = dot4(v0) + dot4(v1);
                        ssq += __shfl_xor(ssq, 16); ssq += __shfl_xor(ssq, 32);
                        if (fq == 0) SSB[(size_t)row * 24 + (cb >> 5)] = ssq;
                    }
                }
            }
          }
        }
    }
};
struct EpiQUp {
    static constexpr bool PERM = false, AFTER_DRAIN = false;
    bf16_t* QB; const float* SSB; const float* cosB; const float* sinB; float qscale;
    __device__ __forceinline__ void operator()(const f32x4 (&acc)[2][2][4][2], const Unit& u, int wr, int wc, int fr, int fq) const {
        float rsv[2][4]; rstd8(rsv, SSB, 24, 3, 1.0f / 384.0f, u.pm * BM + wr * 64 + fr);
#pragma unroll
        for (int ai = 0; ai < 2; ++ai) {
            f32x4 cv[4], sv[4];
#pragma unroll
            for (int m = 0; m < 4; ++m) { const int row = u.pm * BM + ai * HALF + wr * 64 + m * 16 + fr; cv[m] = *(const f32x4*)(cosB + (size_t)row * 16 + 4 * fq); sv[m] = *(const f32x4*)(sinB + (size_t)row * 16 + 4 * fq); }
#pragma unroll
            for (int m = 0; m < 4; ++m) {
                const int row = u.pm * BM + ai * HALF + wr * 64 + m * 16 + fr;
                const float rs = rsv[ai][m] * qscale;
                const f32x4 c = cv[m], s = sv[m];
#pragma unroll
                for (int bj = 0; bj < 2; ++bj) {
                    const int cb = u.pn * BM + bj * HALF + wc * 32;
                    f32x4 v0 = acc[ai][bj][m][0] * rs, v1 = acc[ai][bj][m][1] * rs;
                    if (((cb >> 5) % 3) == 2) { const f32x4 o0 = v0 * c - v1 * s, o1 = v1 * c + v0 * s; v0 = o0; v1 = o1; }
                    bf16_t* p = QB + (size_t)row * 1536 + cb + 4 * fq; *(u32x2*)p = pack4_bf16(v0); *(u32x2*)(p + 16) = pack4_bf16(v1);
                }
            }
        }
    }
};
struct EpiKvUp {
    static constexpr bool PERM = true, AFTER_DRAIN = false;
    bf16_t* KVB; const float* SSB;
    __device__ __forceinline__ void operator()(const f32x4 (&acc)[2][2][4][2], const Unit& u, int wr, int wc, int fr, int fq) const {
        float rsv[2][4]; rstd8(rsv, SSB + 12, 24, 2, 1.0f / 256.0f, u.pm * BM + wr * 64 + fr);
#pragma unroll
        for (int ai = 0; ai < 2; ++ai)
#pragma unroll
            for (int m = 0; m < 4; ++m) {
                const int row = u.pm * BM + ai * HALF + wr * 64 + m * 16 + fr;
                const float rs = rsv[ai][m];
#pragma unroll
                for (int bj = 0; bj < 2; ++bj) {
                    const int col8 = u.pn * BM + bj * HALF + wc * 32 + 8 * fq;
                    *(u32x4*)(KVB + (size_t)row * 2048 + col8) = pack8_bf16(acc[ai][bj][m][0] * rs, acc[ai][bj][m][1] * rs);
                }
            }
    }
};
template <class Epi, class Sched, bool ALIGN_EPI = false, bool SP2 = false, bool F16 = false>
__device__ __forceinline__ void gemm_phase(PG8_LAS unsigned char* lds, const Gemm g, const Sched& S, const Epi& E) {
    const int tid = threadIdx.x, wid = __builtin_amdgcn_readfirstlane(tid >> 6), lane = tid & 63, wr = wid >> 2, wc = wid & 3, fr = lane & 15, fq = lane >> 4;
    const int K = g.K, nt = K / BK;
    unsigned voffA[2], voffB[2];
#pragma unroll
    for (int i = 0; i < 2; ++i) { int R, C; stage_rc(tid * 16 + i * 8192, R, C); const int Rb = Epi::PERM ? ((R & ~31) + perm32(R & 31)) : R;
        voffA[i] = (unsigned)(R * g.lda + C) * 2u; voffB[i] = (unsigned)(Rb * g.ldb + C) * 2u; }
    const size_t kstep = (size_t)(BK * 2);
    const size_t hstepA = (size_t)HALF * g.lda * 2, hstepB = (size_t)HALF * g.ldb * 2;
    const size_t tstepA = 2 * hstepA, tstepB = 2 * hstepB;
    const unsigned ldsw = (unsigned)wid * 1024u;
    const int aoff = lds_byte(wr * 64 + fr, fq * 8), boff = lds_byte(wc * 32 + fr, fq * 8);
#define PG8_SA(b, h) (((b) * 2 + (h)) * HTB)
#define PG8_SB(b, h) ((4 + (b) * 2 + (h)) * HTB)
#define PG8_STAGE(bufoff, gbase, voff) do { _Pragma("unroll") for (int _i = 0; _i < 2; ++_i) \
        __builtin_amdgcn_global_load_lds((const unsigned*)((const char*)(gbase) + (voff)[_i]), (PG8_LAS unsigned*)(lds + (bufoff) + ldsw + _i * 8192), 16, 0, 0); } while (0)
#define PG8_LDA(dst, b, h) do { _Pragma("unroll") for (int m = 0; m < 4; ++m) _Pragma("unroll") for (int k = 0; k < 2; ++k) dst[m][k] = *(const PG8_LAS bf16x8*)(lds + PG8_SA(b, h) + aoff + m * 2048 + k * 1024); } while (0)
#define PG8_LDB(dst, b, h) do { _Pragma("unroll") for (int n = 0; n < 2; ++n) _Pragma("unroll") for (int k = 0; k < 2; ++k) dst[n][k] = *(const PG8_LAS bf16x8*)(lds + PG8_SB(b, h) + boff + n * 2048 + k * 1024); } while (0)
#define PG8_MMA(ai, bj, At, Bt) do { __builtin_amdgcn_s_setprio(1); _Pragma("unroll") for (int m = 0; m < 4; ++m) _Pragma("unroll") for (int n = 0; n < 2; ++n) _Pragma("unroll") for (int k = 0; k < 2; ++k) \
        acc[ai][bj][m][n] = mma16<F16>(Bt[n][k], At[m][k], acc[ai][bj][m][n]); __builtin_amdgcn_s_setprio(0); } while (0)
#define PG8_WAIT_V(n) asm volatile("s_waitcnt vmcnt(" #n ")" ::: "memory")
#define PG8_WAIT_L(n) asm volatile("s_waitcnt lgkmcnt(" #n ")" ::: "memory")
#define PG8_BAR __builtin_amdgcn_s_barrier()
#define PG8_SCHED __builtin_amdgcn_sched_barrier(0)
    Unit cur, nxt; int ui = 0;
    if (!S.next(0, cur)) return;
    f32x4 acc[2][2][4][2];
#pragma unroll
    for (int a = 0; a < 2; ++a)
#pragma unroll
        for (int b = 0; b < 2; ++b)
#pragma unroll
            for (int m = 0; m < 4; ++m)
#pragma unroll
                for (int n = 0; n < 2; ++n) acc[a][b][m][n] = (f32x4){0.f, 0.f, 0.f, 0.f};
    bf16x8 At[4][2], B0[2][2], B1[2][2];
    const char* cA = (const char*)g.A + (size_t)cur.pm * tstepA; const char* cB = (const char*)g.Bt + (size_t)cur.pn * tstepB;
    S.a_ready(cur);
    if constexpr (SP2) {
        PG8_STAGE(PG8_SB(0, 0), cB, voffB); PG8_STAGE(PG8_SB(0, 1), cB + hstepB, voffB); PG8_STAGE(PG8_SA(0, 0), cA, voffA); PG8_STAGE(PG8_SA(0, 1), cA + hstepA, voffA);
        if (wr == 1) PG8_BAR;
        PG8_WAIT_V(2); PG8_BAR;
        PG8_STAGE(PG8_SB(1, 0), cB + kstep, voffB); PG8_STAGE(PG8_SA(1, 0), cA + kstep, voffA); PG8_STAGE(PG8_SB(1, 1), cB + hstepB + kstep, voffB);
        PG8_WAIT_V(6); PG8_BAR;
    } else {
        PG8_STAGE(PG8_SB(0, 0), cB, voffB); PG8_STAGE(PG8_SA(0, 0), cA, voffA); PG8_STAGE(PG8_SB(0, 1), cB + hstepB, voffB); PG8_STAGE(PG8_SA(0, 1), cA + hstepA, voffA);
        if (wr == 1) PG8_BAR;
        PG8_WAIT_V(4); PG8_BAR;
        PG8_STAGE(PG8_SB(1, 0), cB + kstep, voffB); PG8_STAGE(PG8_SA(1, 0), cA + kstep, voffA); PG8_STAGE(PG8_SB(1, 1), cB + hstepB + kstep, voffB);
        PG8_WAIT_V(6); PG8_BAR;
    }
    for (;;) {
        const bool has_next = S.next(ui + 1, nxt);
        const char* nA = has_next ? (const char*)g.A + (size_t)nxt.pm * tstepA : cA; const char* nB = has_next ? (const char*)g.Bt + (size_t)nxt.pn * tstepB : cB;
#pragma nounroll
        for (int t = 0; t < nt; t += 2) {
            const bool last = (t == nt - 2);
            const char* a1 = cA + (size_t)(t + 1) * kstep;
            const char* a2 = last ? nA : cA + (size_t)(t + 2) * kstep; const char* b2 = last ? nB : cB + (size_t)(t + 2) * kstep;
            const char* a3 = a2 + kstep; const char* b3 = b2 + kstep;
            if (last && has_next) S.a_ready(nxt);
            if constexpr (SP2) {
            PG8_LDB(B0, 0, 0); PG8_LDB(B1, 0, 1); PG8_SCHED; PG8_LDA(At, 0, 0); PG8_STAGE(PG8_SA(1, 1), a1 + hstepA, voffA);
            PG8_WAIT_V(8); PG8_WAIT_L(0); PG8_BAR; PG8_MMA(0, 0, At, B0); PG8_MMA(0, 1, At, B1); PG8_BAR; PG8_SCHED;
            PG8_LDA(At, 0, 1); PG8_STAGE(PG8_SB(0, 0), b2, voffB); PG8_STAGE(PG8_SB(0, 1), b2 + hstepB, voffB); PG8_STAGE(PG8_SA(0, 0), a2, voffA);
            PG8_WAIT_V(8); PG8_WAIT_L(0); PG8_BAR; PG8_MMA(1, 0, At, B0); PG8_MMA(1, 1, At, B1); PG8_BAR; PG8_SCHED;
            PG8_LDB(B0, 1, 0); PG8_LDB(B1, 1, 1); PG8_SCHED; PG8_LDA(At, 1, 0); PG8_STAGE(PG8_SA(0, 1), a2 + hstepA, voffA);
            PG8_WAIT_V(8); PG8_WAIT_L(0); PG8_BAR; PG8_MMA(0, 0, At, B0); PG8_MMA(0, 1, At, B1); PG8_BAR; PG8_SCHED;
            PG8_LDA(At, 1, 1); PG8_STAGE(PG8_SB(1, 0), b3, voffB); PG8_STAGE(PG8_SB(1, 1), b3 + hstepB, voffB); PG8_STAGE(PG8_SA(1, 0), a3, voffA);
            PG8_WAIT_V(8); PG8_WAIT_L(0); PG8_BAR; PG8_MMA(1, 0, At, B0); PG8_MMA(1, 1, At, B1); PG8_BAR; PG8_SCHED;
            } else {
            PG8_LDB(B0, 0, 0); PG8_SCHED; PG8_LDA(At, 0, 0); PG8_STAGE(PG8_SA(1, 1), a1 + hstepA, voffA);
            PG8_WAIT_L(8); PG8_BAR; PG8_WAIT_L(0); PG8_MMA(0, 0, At, B0); PG8_BAR; PG8_SCHED;
            PG8_LDB(B1, 0, 1); PG8_STAGE(PG8_SB(0, 0), b2, voffB);
            PG8_BAR; PG8_WAIT_L(0); PG8_MMA(0, 1, At, B1); PG8_BAR;
            PG8_LDA(At, 0, 1); PG8_STAGE(PG8_SA(0, 0), a2, voffA);
            PG8_BAR; PG8_WAIT_L(0); PG8_MMA(1, 0, At, B0); PG8_BAR; PG8_SCHED;
            PG8_STAGE(PG8_SB(0, 1), b2 + hstepB, voffB);
            PG8_WAIT_V(6); PG8_BAR; PG8_MMA(1, 1, At, B1); PG8_BAR;
            PG8_LDB(B0, 1, 0); PG8_SCHED; PG8_LDA(At, 1, 0); PG8_STAGE(PG8_SA(0, 1), a2 + hstepA, voffA);
            PG8_WAIT_L(8); PG8_BAR; PG8_WAIT_L(0); PG8_MMA(0, 0, At, B0); PG8_BAR; PG8_SCHED;
            PG8_LDB(B1, 1, 1); PG8_STAGE(PG8_SB(1, 0), b3, voffB);
            PG8_BAR; PG8_WAIT_L(0); PG8_MMA(0, 1, At, B1); PG8_BAR;
            PG8_LDA(At, 1, 1); PG8_STAGE(PG8_SA(1, 0), a3, voffA);
            PG8_BAR; PG8_WAIT_L(0); PG8_MMA(1, 0, At, B0); PG8_BAR; PG8_SCHED;
            PG8_STAGE(PG8_SB(1, 1), b3 + hstepB, voffB);
            PG8_WAIT_V(6); PG8_BAR; PG8_MMA(1, 1, At, B1); PG8_BAR;
            }
        }
        if constexpr (ALIGN_EPI) { if (wr == 0) PG8_BAR; }
        if constexpr (!Epi::AFTER_DRAIN) { E(acc, cur, wr, wc, fr, fq); S.done(cur); }
        if (!has_next) break;
#pragma unroll
        for (int a = 0; a < 2; ++a)
#pragma unroll
            for (int b = 0; b < 2; ++b)
#pragma unroll
                for (int m = 0; m < 4; ++m)
#pragma unroll
                    for (int n = 0; n < 2; ++n) acc[a][b][m][n] = (f32x4){0.f, 0.f, 0.f, 0.f};
        cur = nxt; cA = nA; cB = nB; ++ui;
        if constexpr (ALIGN_EPI) { if (wr == 1) PG8_BAR; }
    }
    PG8_WAIT_V(0);
    if constexpr (!ALIGN_EPI) { if (wr == 0) PG8_BAR; }
    PG8_BAR;
    if constexpr (Epi::AFTER_DRAIN) { E.fused(acc, cur, wr, wc, fr, fq, lds, wid, lane); S.done(cur); }
#undef PG8_SA
#undef PG8_SB
#undef PG8_STAGE
#undef PG8_LDA
#undef PG8_LDB
#undef PG8_MMA
#undef PG8_WAIT_V
#undef PG8_WAIT_L
#undef PG8_BAR
#undef PG8_SCHED
}
}
constexpr int NWAVES = 8;
#ifndef MK_N_LAUNCHES
#define MK_N_LAUNCHES 1
#endif
constexpr int N_PHASES = 13;
constexpr int N_LAUNCHES = MK_N_LAUNCHES;
constexpr int BATCH = 16, SEQ = 2048, DM = 1024, M = BATCH * SEQ, FF = 4096;
constexpr int A_IN = 2120, A_INP = 2304, B_IN = 672, B_INP = 768, QUP = 1536, KVUP = 2048, QLORA = 384, KVLORA = 256;
constexpr size_t MiB = 1u << 20;
constexpr size_t WS_CTL = 0, CTL_ZERO_BYTES = 64 * 1024;
constexpr size_t WS_WAIN = 1 * MiB, WS_WAOUT = 6 * MiB, WS_WUP0 = 8 * MiB, WS_WUP1 = 16 * MiB, WS_WDN0 = 24 * MiB, WS_WDN1 = 32 * MiB;
constexpr size_t WS_WBIN = 40 * MiB, WS_WQUP = 42 * MiB, WS_WKVUP = 44 * MiB, WS_WBOUT = 46 * MiB;
constexpr size_t WS_COSA = 48 * MiB, WS_SINA = 49 * MiB, WS_COSB = 50 * MiB, WS_SINB = 52 * MiB;
constexpr size_t WS_SS = 54 * MiB, WS_SSB = 56 * MiB, WS_WI = 59 * MiB;
constexpr size_t WS_XB = 64 * MiB;
constexpr size_t WS_BIG = 128 * MiB;
constexpr size_t WS_PA = WS_BIG, WS_OA = WS_BIG + 144 * MiB;
constexpr size_t WS_H = WS_BIG;
constexpr size_t WS_CB = WS_BIG, WS_QB = WS_BIG + 48 * MiB, WS_OB = WS_BIG + 144 * MiB;
constexpr size_t WS_KVB = 384 * MiB, WS_END = 512 * MiB;
static_assert(WS_WAIN + (size_t)A_INP * DM * 2 <= WS_WAOUT && WS_WBIN + (size_t)B_INP * DM * 2 <= WS_WQUP && WS_WQUP + (size_t)QUP * QLORA * 2 <= WS_WKVUP && WS_WKVUP + (size_t)KVUP * KVLORA * 2 <= WS_WBOUT, "weights map");
static_assert(WS_SSB + (size_t)M * 24 * 4 <= WS_WI && WS_WI + (size_t)M * 8 * 4 <= WS_XB && WS_PA + (size_t)M * A_INP * 2 <= WS_OA && WS_OA + (size_t)M * DM * 2 <= WS_KVB && WS_QB + (size_t)M * QUP * 2 <= WS_OB, "activation map");
constexpr int CW_BAR = 1024;
constexpr int RING_BYTES = 131072, LDSCTL_OFF = RING_BYTES, MISC_OFF = LDSCTL_OFF + 320, LDS_BYTES = 147456;
constexpr float IDX_WSCALE = 0.044194173824159216f;
constexpr float SM_THR = 4.0f;
constexpr float QSCALE_A = 0.125f * 1.4426950408889634f;
constexpr float QSCALE_B = 0.10206207261596577f * 1.4426950408889634f;

#define GAS __attribute__((address_space(1)))
#define LAS __attribute__((address_space(3)))
typedef unsigned short bf16;
typedef unsigned v4u __attribute__((ext_vector_type(4)));
typedef float f32x4 __attribute__((ext_vector_type(4)));
typedef short bf16x8 __attribute__((ext_vector_type(8)));
typedef GAS unsigned gu32;
typedef GAS unsigned long long gu64;
#define RLX_AGENT __ATOMIC_RELAXED, __HIP_MEMORY_SCOPE_AGENT
#define LDS_WAIT() asm volatile("s_waitcnt lgkmcnt(0)" ::: "memory")
#define VM_WAIT() asm volatile("s_waitcnt vmcnt(0)" ::: "memory")
__device__ __forceinline__ unsigned long long rt() { return __builtin_amdgcn_s_memrealtime(); }
__device__ __forceinline__ unsigned f2bf(float f) { unsigned u = __builtin_bit_cast(unsigned, f); return (u + 0x7fffu + ((u >> 16) & 1u)) >> 16; }
__device__ __forceinline__ unsigned pk2(float lo, float hi) { return f2bf(lo) | (f2bf(hi) << 16); }

#define XB_TMO      128
#define XB_XCNT(j)  (256  + 64 * (j))
#define XB_XSUB(j)  (1280 + 64 * (j))
#define XB_XGEN(j)  (2304 + 64 * (j))
#define XB_TOP      3328
#define XB_TOPGEN   3392
#define XCD_BAR_WORDS 3456
#define XB_SPIN_CAP (1u << 18)

__device__ __forceinline__ unsigned xb_ld(unsigned* p)              { return __hip_atomic_load(p, __ATOMIC_RELAXED, __HIP_MEMORY_SCOPE_AGENT); }
__device__ __forceinline__ unsigned xb_add(unsigned* p, unsigned v) { return __hip_atomic_fetch_add(p, v, __ATOMIC_RELAXED, __HIP_MEMORY_SCOPE_AGENT); }
__device__ __forceinline__ unsigned xb_xcc_id() { return (unsigned)__builtin_amdgcn_s_getreg((3 << 11) | 20) & 0xFu; }
#define XB_SPIN(cond, bar) do { unsigned _sp = 0; while (cond) { __builtin_amdgcn_s_sleep(1); \
    if ((++_sp & 255u) == 0u) { if (xb_ld(&(bar)[XB_TMO])) break; if (_sp > XB_SPIN_CAP) { atomicAdd(&(bar)[XB_TMO], 1u); break; } } } } while (0)

struct XcdBarrier {
    unsigned* bar; unsigned x;
    volatile LAS unsigned* st;
};

__device__ __forceinline__ XcdBarrier xcd_barrier_post(unsigned* bar, volatile LAS unsigned* st) {
    XcdBarrier b; b.bar = bar; b.x = xb_xcc_id(); b.st = st;
    if (threadIdx.x == 0) (void)xb_add(&bar[XB_XCNT(b.x)], 1u);
    return b;
}
__device__ __forceinline__ void xcd_barrier_complete(unsigned* bar, unsigned x, unsigned& nloc, unsigned& nx) {
    const unsigned G = gridDim.x * gridDim.y * gridDim.z;
    unsigned sum, cnt, mine, sp = 0u;
    for (;;) {
        sum = 0u; cnt = 0u; mine = 0u;
#pragma unroll
        for (unsigned j = 0; j < 16; ++j) { const unsigned c = xb_ld(&bar[XB_XCNT(j)]); sum += c; cnt += (c > 0u) ? 1u : 0u; mine = (j == x) ? c : mine; }
        if (sum == G) break;
        __builtin_amdgcn_s_sleep(1);
        if ((++sp & 255u) == 0u) { if (xb_ld(&bar[XB_TMO])) break; if (sp > XB_SPIN_CAP) { atomicAdd(&bar[XB_TMO], 1u); break; } }
    }
    nloc = mine > 0u ? mine : 1u; nx = cnt > 0u ? cnt : 1u;
}

__device__ __forceinline__ void xcd_barrier(const XcdBarrier& b) {
    asm volatile("s_waitcnt vmcnt(0)" ::: "memory");
    __syncthreads();
    if (threadIdx.x == 0) {
        unsigned* bar = b.bar;
        __builtin_amdgcn_s_waitcnt(0);
        unsigned nloc = b.st[0], nx = b.st[1];
        if (nloc == 0u) { xcd_barrier_complete(bar, b.x, nloc, nx); b.st[0] = nloc; b.st[1] = nx; }
        const unsigned old = xb_add(&bar[XB_XSUB(b.x)], 1u);
        const unsigned gen = old / nloc;
        if (old + 1u == (gen + 1u) * nloc) {
            __builtin_amdgcn_fence(__ATOMIC_RELEASE, "agent");
            asm volatile("s_waitcnt vmcnt(0)" ::: "memory");
            const unsigned og = xb_add(&bar[XB_TOP], 1u);
            const unsigned tg = og / nx;
            if (og + 1u == (tg + 1u) * nx) xb_add(&bar[XB_TOPGEN], 1u);
            else XB_SPIN(xb_ld(&bar[XB_TOPGEN]) == tg, bar);
            __builtin_amdgcn_fence(__ATOMIC_ACQUIRE, "agent");
            xb_add(&bar[XB_XGEN(b.x)], 1u);
            asm volatile("s_waitcnt vmcnt(0)" ::: "memory");
        } else {
            XB_SPIN(xb_ld(&bar[XB_XGEN(b.x)]) == gen, bar);
            __builtin_amdgcn_fence(__ATOMIC_ACQUIRE, "agent");
            asm volatile("s_waitcnt vmcnt(0)" ::: "memory");
        }
    }
    __syncthreads();
}
using pg8::u32x4; using pg8::u32x2;
struct Frame {
    LAS unsigned char* lds;
    volatile LAS unsigned* MISC;
    gu32* ctl;
    int tid, lane, wave, G;
};
__device__ __forceinline__ float wave_sum(float v) {
#pragma unroll
    for (int o = 1; o < 64; o <<= 1) v += __shfl_xor(v, o);
    return v;
}
typedef _Float16 half_t;
__device__ __forceinline__ unsigned short f2h(float f) { half_t h = (half_t)f; return __builtin_bit_cast(unsigned short, h); }
__device__ __forceinline__ float h2f(unsigned short u) { return (float)__builtin_bit_cast(half_t, u); }
__device__ __forceinline__ float bf2f(unsigned short u) { return __builtin_bit_cast(float, (unsigned)u << 16); }

template <bool F16>
__device__ __forceinline__ void p0_transpose_item(const float* W, int K, int N, const float* gain, bf16* WT, LAS float* scr, int item, int lane) {
    const int nblk = (N + 31) / 32, kb = item / nblk, nb = item % nblk, k0 = 64 * kb, n0 = 32 * nb;
#pragma unroll 8
    for (int i = 0; i < 32; ++i) { const int kk = 2 * i + (lane >> 5); const int n = n0 + (lane & 31);
        float v = (n < N) ? W[(size_t)(k0 + kk) * N + n] : 0.f; if (gain) v *= gain[k0 + kk]; scr[kk * 33 + (lane & 31)] = v; }
    LDS_WAIT(); asm volatile("" ::: "memory");
    const int c = lane & 7;
#pragma unroll
    for (int j = 0; j < 4; ++j) { const int n = (lane >> 3) + 8 * j; const LAS float* s = scr + (8 * c) * 33 + n;
        v4u o;
        if (F16) { o.x = (unsigned)f2h(s[0 * 33]) | ((unsigned)f2h(s[1 * 33]) << 16); o.y = (unsigned)f2h(s[2 * 33]) | ((unsigned)f2h(s[3 * 33]) << 16);
                   o.z = (unsigned)f2h(s[4 * 33]) | ((unsigned)f2h(s[5 * 33]) << 16); o.w = (unsigned)f2h(s[6 * 33]) | ((unsigned)f2h(s[7 * 33]) << 16); }
        else { o.x = pk2(s[0 * 33], s[1 * 33]); o.y = pk2(s[2 * 33], s[3 * 33]); o.z = pk2(s[4 * 33], s[5 * 33]); o.w = pk2(s[6 * 33], s[7 * 33]); }
        *(GAS v4u*)(WT + (size_t)(n0 + n) * K + k0 + 8 * c) = o; }
    LDS_WAIT(); asm volatile("" ::: "memory");
}
struct Args { const void* in[15]; float* out; unsigned char* ws; float inv_a[8]; float inv_b[16]; int ph_lo, ph_hi; };

__device__ __forceinline__ void p0_prologue(Frame& F, const Args& A) {
    unsigned char* ws = A.ws;
    LAS float* scr = (LAS float*)(F.lds + F.wave * 16384);
    const int gw = blockIdx.x * NWAVES + F.wave, NGW = F.G * NWAVES, lane = F.lane;
    const float* attn_norm = (const float*)A.in[2]; const float* mlp_norm = (const float*)A.in[3];
    constexpr int I_AIN = 16 * 67, I_AOUT = 16 * 32, I_UP = 16 * 128, I_DN = 64 * 32, I_BIN = 16 * 21, I_QUP = 6 * 48, I_KVUP = 4 * 64, I_BOUT = 16 * 32;
    constexpr int NITEMS = I_AIN + I_AOUT + 2 * I_UP + 2 * I_DN + I_BIN + I_QUP + I_KVUP + I_BOUT;
    for (int it = gw; it < NITEMS; it += NGW) {
        int r = it;
        if (r < I_AIN) { p0_transpose_item<true>((const float*)A.in[4], 1024, A_IN, attn_norm, (bf16*)(ws + WS_WAIN), scr, r, lane); continue; } r -= I_AIN;
        if (r < I_AOUT) { p0_transpose_item<false>((const float*)A.in[5], 1024, 1024, nullptr, (bf16*)(ws + WS_WAOUT), scr, r, lane); continue; } r -= I_AOUT;
        if (r < I_UP) { p0_transpose_item<false>((const float*)A.in[12], 1024, 4096, mlp_norm, (bf16*)(ws + WS_WUP0), scr, r, lane); continue; } r -= I_UP;
        if (r < I_UP) { p0_transpose_item<false>((const float*)A.in[12] + (size_t)1024 * 4096, 1024, 4096, mlp_norm + 1024, (bf16*)(ws + WS_WUP1), scr, r, lane); continue; } r -= I_UP;
        if (r < I_DN) { p0_transpose_item<false>((const float*)A.in[13], 4096, 1024, nullptr, (bf16*)(ws + WS_WDN0), scr, r, lane); continue; } r -= I_DN;
        if (r < I_DN) { p0_transpose_item<false>((const float*)A.in[13] + (size_t)4096 * 1024, 4096, 1024, nullptr, (bf16*)(ws + WS_WDN1), scr, r, lane); continue; } r -= I_DN;
        if (r < I_BIN) { p0_transpose_item<false>((const float*)A.in[6], 1024, B_IN, attn_norm + 1024, (bf16*)(ws + WS_WBIN), scr, r, lane); continue; } r -= I_BIN;
        if (r < I_QUP) { p0_transpose_item<false>((const float*)A.in[9], QLORA, QUP, (const float*)A.in[7], (bf16*)(ws + WS_WQUP), scr, r, lane); continue; } r -= I_QUP;
        if (r < I_KVUP) { p0_transpose_item<false>((const float*)A.in[10], KVLORA, KVUP, (const float*)A.in[8], (bf16*)(ws + WS_WKVUP), scr, r, lane); continue; } r -= I_KVUP;
        p0_transpose_item<false>((const float*)A.in[11], 1024, 1024, nullptr, (bf16*)(ws + WS_WBOUT), scr, r, lane);
    }
    {   const int gt = gw * 64 + lane, NT = NGW * 64;
        GAS v4u* z1 = (GAS v4u*)(ws + WS_WAIN + (size_t)2144 * 1024 * 2); const int n1 = (A_INP - 2144) * 1024 * 2 / 16;
        for (int i = gt; i < n1; i += NT) z1[i] = (v4u){0u, 0u, 0u, 0u};
        GAS v4u* z2 = (GAS v4u*)(ws + WS_WBIN + (size_t)B_IN * 1024 * 2); const int n2 = (B_INP - B_IN) * 1024 * 2 / 16;
        for (int i = gt; i < n2; i += NT) z2[i] = (v4u){0u, 0u, 0u, 0u};
        const int* pos = (const int*)A.in[1];
        float* cA = (float*)(ws + WS_COSA); float* sA = (float*)(ws + WS_SINA); float* cB = (float*)(ws + WS_COSB); float* sB = (float*)(ws + WS_SINB);
        for (int i = gt; i < M * 8; i += NT) { const float ang = (float)pos[i >> 3] * A.inv_a[i & 7]; double rev = (double)ang * 0.15915494309189535; rev -= __builtin_rint(rev); const float fr = (float)rev;
            cA[i] = __builtin_amdgcn_cosf(fr); sA[i] = __builtin_amdgcn_sinf(fr); }
        for (int i = gt; i < M * 16; i += NT) { const float ang = (float)pos[i >> 4] * A.inv_b[i & 15]; double rev = (double)ang * 0.15915494309189535; rev -= __builtin_rint(rev); const float fr = (float)rev;
            cB[i] = __builtin_amdgcn_cosf(fr); sB[i] = __builtin_amdgcn_sinf(fr); }
    }
    const float* x = (const float*)A.in[0]; bf16* XB = (bf16*)(ws + WS_XB); float* SS = (float*)(ws + WS_SS);
    for (int m0 = gw; m0 < M; m0 += 2 * NGW) {
        f32x4 v[2][4]; float sq[2];
#pragma unroll
        for (int e = 0; e < 2; ++e) { const int m = (m0 + e * NGW < M) ? m0 + e * NGW : m0; const GAS f32x4* xr = (const GAS f32x4*)(x + (size_t)m * DM) + lane;
#pragma unroll
            for (int j = 0; j < 4; ++j) v[e][j] = xr[64 * j]; }
#pragma unroll
        for (int e = 0; e < 2; ++e) { float s = 0.f;
#pragma unroll
            for (int j = 0; j < 4; ++j) s += (v[e][j].x * v[e][j].x + v[e][j].y * v[e][j].y) + (v[e][j].z * v[e][j].z + v[e][j].w * v[e][j].w);
            sq[e] = wave_sum(s); }
#pragma unroll
        for (int e = 0; e < 2; ++e) { const int m = m0 + e * NGW; if (m < M) {
            GAS unsigned long long* o8 = (GAS unsigned long long*)(XB + (size_t)m * DM) + lane;
#pragma unroll
            for (int j = 0; j < 4; ++j) o8[64 * j] = (unsigned long long)((unsigned)f2h(v[e][j].x) | ((unsigned)f2h(v[e][j].y) << 16)) | ((unsigned long long)((unsigned)f2h(v[e][j].z) | ((unsigned)f2h(v[e][j].w) << 16)) << 32);
            if (lane < 16) SS[(size_t)m * 16 + lane] = (lane == 0) ? sq[e] : 0.f; } }
    }
}
__device__ __forceinline__ void p12_final_norm(Frame& F, const Args& A) {
    const int gw = blockIdx.x * NWAVES + F.wave, NGW = F.G * NWAVES, lane = F.lane;
    const float* g = (const float*)A.in[14]; const float* SS = (const float*)(A.ws + WS_SS);
    f32x4 gv[4];
#pragma unroll
    for (int j = 0; j < 4; ++j) gv[j] = ((const GAS f32x4*)g)[lane + 64 * j];
    for (int m = gw; m < M; m += 2 * NGW) {
        const int m2 = m + NGW;
        const bool has2 = m2 < M;
        GAS f32x4* xr = (GAS f32x4*)(A.out + (size_t)m * DM) + lane; GAS f32x4* xr2 = (GAS f32x4*)(A.out + (size_t)(has2 ? m2 : m) * DM) + lane;
        f32x4 v[4], u[4];
#pragma unroll
        for (int j = 0; j < 4; ++j) { v[j] = xr[64 * j]; u[j] = xr2[64 * j]; }
        const float rs = pg8::rstd_from(SS + (size_t)m * 16, 4, 1.0f / 1024.0f), rs2 = pg8::rstd_from(SS + (size_t)(has2 ? m2 : m) * 16, 4, 1.0f / 1024.0f);
#pragma unroll
        for (int j = 0; j < 4; ++j) xr[64 * j] = v[j] * rs * gv[j];
        if (has2) {
#pragma unroll
            for (int j = 0; j < 4; ++j) xr2[64 * j] = u[j] * rs2 * gv[j]; }
    }
}
namespace dsa {
typedef float f32x16 __attribute__((ext_vector_type(16)));
typedef _Float16 f16x8 __attribute__((ext_vector_type(8)));
typedef short s16x4 __attribute__((ext_vector_type(4)));
constexpr int KP = 144;
constexpr int MP = 65;
constexpr int LDS_MASK = 0, LDS_KV = 16896, KBYTES = 64 * KP, KV1 = KBYTES + 8192, KVBUF2 = 2 * KV1, LDS_Q = LDS_KV + 2 * KVBUF2, LDS_KI = LDS_KV, KIBUF = 256 * KP;
static_assert(64 * MP * 4 <= LDS_KV && LDS_Q + 8 * 4096 <= RING_BYTES && LDS_KI + 2 * KIBUF <= RING_BYTES, "dsa LDS map");
__device__ __forceinline__ unsigned sortable(float f) { const unsigned u = __builtin_bit_cast(unsigned, f); return (u & 0x80000000u) ? ~u : (u | 0x80000000u); }
__device__ __forceinline__ float xmax32(float m) { auto rr = __builtin_amdgcn_permlane32_swap(__float_as_uint(m), __float_as_uint(m), false, false); return fmaxf(__uint_as_float(rr[0]), __uint_as_float(rr[1])); }
__device__ __forceinline__ unsigned half_sum(unsigned v) {
#pragma unroll
    for (int o = 16; o >= 1; o >>= 1) v += (unsigned)__shfl_xor((int)v, o);
    return v;
}
__device__ __forceinline__ void cnt4(unsigned& cnt, unsigned a, unsigned b, unsigned c, unsigned d, unsigned cand) {
    unsigned long long m0, m1, m2, m3, co;
    asm volatile("v_cmp_ge_u32_e64 %1, %6, %10\n\tv_cmp_ge_u32_e64 %2, %7, %10\n\tv_cmp_ge_u32_e64 %3, %8, %10\n\tv_cmp_ge_u32_e64 %4, %9, %10\n\t"
                 "v_addc_co_u32_e64 %0, %5, 0, %0, %1\n\tv_addc_co_u32_e64 %0, %5, 0, %0, %2\n\tv_addc_co_u32_e64 %0, %5, 0, %0, %3\n\tv_addc_co_u32_e64 %0, %5, 0, %0, %4\n\ts_nop 1"
                 : "+v"(cnt), "=&s"(m0), "=&s"(m1), "=&s"(m2), "=&s"(m3), "=&s"(co) : "v"(a), "v"(b), "v"(c), "v"(d), "v"(cand));
}
__device__ __forceinline__ void index_select(LAS unsigned char* lds, LAS unsigned* maskQ, const bf16* PA, const float* WI, unsigned* scr, size_t row0, int qp0, int mp0, int nkt, int tid, int wid, int lane) {
    const int r32 = lane & 31, hh = lane >> 5;
    const int q0 = qp0 + 4 * wid, mrow0 = mp0 + 4 * wid;
    const int a_ = r32 & 3, hic = (r32 >> 2) & 1, bq = r32 >> 3; const int headA = a_ + 4 * (bq & 1), tlocA = 2 * hic + (bq >> 1);
    const bf16* ap = PA + (row0 + q0 + tlocA) * A_INP + 1536 + headA * 64 + 8 * hh;
    f16x8 qa[4];
#pragma unroll
    for (int ks = 0; ks < 4; ++ks) qa[ks] = *(const f16x8*)(ap + 16 * ks);
    float w[2][8];
#pragma unroll
    for (int tq = 0; tq < 2; ++tq) { const float* wq = WI + (row0 + q0 + 2 * hh + tq) * 8; const f32x4 wa = *(const f32x4*)wq, wb = *(const f32x4*)(wq + 4);
      w[tq][0] = wa[0]; w[tq][1] = wa[1]; w[tq][2] = wa[2]; w[tq][3] = wa[3]; w[tq][4] = wb[0]; w[tq][5] = wb[1]; w[tq][6] = wb[2]; w[tq][7] = wb[3]; }
    const int nch = (nkt + 7) >> 3;
    const int skey = tid >> 3, sc8 = tid & 7;
    const bf16* spc = PA + (row0 + skey) * A_INP + 2048 + sc8 * 8;
    v4u st[4];
#pragma unroll
    for (int i = 0; i < 4; ++i) st[i] = *(const v4u*)(spc + (size_t)(64 * i) * A_INP);
    LAS unsigned char* const stw = lds + LDS_KI + skey * KP + sc8 * 16;
    const LAS unsigned char* const krd = lds + LDS_KI + r32 * KP + hh * 16;
    unsigned* const scl = scr + lane;
    unsigned sc[64];
    __syncthreads();
#pragma unroll
    for (int ch = 0; ch < 8; ++ch) {
        if (ch < nch) {
#pragma unroll
            for (int i = 0; i < 4; ++i) *(LAS v4u*)(stw + (ch & 1) * KIBUF + 64 * i * KP) = st[i];
            if (ch + 1 < nch) {
                spc += (size_t)256 * A_INP; asm volatile("" : "+v"(spc));
#pragma unroll
                for (int i = 0; i < 4; ++i) st[i] = *(const v4u*)(spc + (size_t)(64 * i) * A_INP); }
            __syncthreads();
#pragma unroll
            for (int k = 0; k < 8; ++k) {
                const int kt = 8 * ch + k;
                if (kt < nkt) {
                    const LAS unsigned char* kq = krd + (ch & 1) * KIBUF + 32 * k * KP;
                    f32x16 c = {};
#pragma unroll
                    for (int ks = 0; ks < 4; ++ks) c = __builtin_amdgcn_mfma_f32_32x32x16_f16(qa[ks], *(const LAS f16x8*)(kq + 32 * ks), c, 0, 0, 0);
                    float acc0 = 0.f, acc1 = 0.f;
#pragma unroll
                    for (int hd = 0; hd < 8; ++hd) { acc0 = fmaf(w[0][hd], fmaxf(c[hd], 0.f), acc0); acc1 = fmaf(w[1][hd], fmaxf(c[hd + 8], 0.f), acc1); }
                    unsigned key = sortable(acc0); asm volatile("" : "+v"(key)); sc[kt] = key;
                    scl[kt * 64] = sortable(acc1);
                } else { sc[kt] = 0u; }
                __builtin_amdgcn_sched_barrier(0);
            }
        } else {
#pragma unroll
            for (int k = 0; k < 8; ++k) sc[8 * ch + k] = 0u;
        }
    }
#pragma unroll 1
  for (int tq = 0; tq < 2; ++tq) {
    if (tq == 1) {
#pragma unroll
        for (int kt = 0; kt < 64; ++kt) { if (kt < nkt) sc[kt] = scl[kt * 64]; }
    }
    unsigned pre_lo = 0u, pre_hi = 0u, cge_lo = (unsigned)nkt * 32u, cge_hi = cge_lo; bool done_lo = false, done_hi = false;
    for (int bit = 31; bit >= 0; --bit) {
        const unsigned bm = 1u << bit;
        const unsigned cand = hh ? (pre_hi | bm) : (pre_lo | bm);
        unsigned cnt = 0u;
#pragma unroll
        for (int blk = 0; blk < 8; ++blk) if (nkt > 8 * blk) {
            cnt4(cnt, sc[8 * blk + 0], sc[8 * blk + 1], sc[8 * blk + 2], sc[8 * blk + 3], cand);
            cnt4(cnt, sc[8 * blk + 4], sc[8 * blk + 5], sc[8 * blk + 6], sc[8 * blk + 7], cand); }
        int v = (int)cnt;
        v += __builtin_amdgcn_update_dpp(0, v, 0xB1, 0xf, 0xf, true);
        v += __builtin_amdgcn_update_dpp(0, v, 0x4E, 0xf, 0xf, true);
        v += __builtin_amdgcn_update_dpp(0, v, 0x141, 0xf, 0xf, true);
        v += __builtin_amdgcn_update_dpp(0, v, 0x140, 0xf, 0xf, true);
        const unsigned n_lo = (unsigned)(__builtin_amdgcn_readlane(v, 0) + __builtin_amdgcn_readlane(v, 16));
        const unsigned n_hi = (unsigned)(__builtin_amdgcn_readlane(v, 32) + __builtin_amdgcn_readlane(v, 48));
        if (!done_lo && n_lo >= 256u) { pre_lo |= bm; cge_lo = n_lo; done_lo = (n_lo == 256u); }
        if (!done_hi && n_hi >= 256u) { pre_hi |= bm; cge_hi = n_hi; done_hi = (n_hi == 256u); }
        if (done_lo && done_hi) break;
    }
    const unsigned pre = hh ? pre_hi : pre_lo, cge = hh ? cge_hi : cge_lo;
    int ktc = 64; bool le = true;
    if (__any(cge > 256u)) {
        unsigned cnt = 0u;
#pragma unroll
        for (int kt = 0; kt < 64; ++kt) cnt += (sc[kt] > pre) ? 1u : 0u;
        cnt = half_sum(cnt);
        const int need = 256 - (int)cnt;
        int run = 0;
#pragma unroll
        for (int kt = 0; kt < 64; ++kt) {
            const unsigned long long b0 = __ballot(sc[kt] == pre);
            unsigned h0 = hh ? (unsigned)(b0 >> 32) : (unsigned)b0;
            const int n0 = __popc(h0);
            if (cge > 256u && run < need && run + n0 >= need) { for (int i = run + 1; i < need; ++i) h0 &= h0 - 1u; ktc = kt; le = r32 <= (__ffs((int)h0) - 1); }
            run += n0;
        }
    }
    LAS unsigned* const mq = maskQ + (mrow0 + tq) * MP;
#pragma unroll
    for (int kt = 0; kt < 64; ++kt) {
        if (kt < nkt) {
            const bool e0 = (kt < ktc) || (kt == ktc && le);
            const unsigned long long b0 = __ballot(sc[kt] > pre || (sc[kt] == pre && e0));
            if (lane == 0) { mq[kt] = (unsigned)b0; mq[2 * MP + kt] = (unsigned)(b0 >> 32); }
        }
    }
  }
}
__device__ __forceinline__ void unit(LAS unsigned char* lds, const bf16* PA, const float* WI, bf16* OA, unsigned* scr_unit, int b, int qblk) {
    int tid_ = threadIdx.x; asm volatile("" : "+v"(tid_));
    const int tid = tid_, lane = tid & 63, r32 = lane & 31, hh = lane >> 5; const int wid = __builtin_amdgcn_readfirstlane(tid >> 6);
    const size_t row0 = (size_t)b * SEQ;
    const int nkt = 2 * (qblk + 1), nk64 = qblk + 1;
    LAS unsigned* maskQ = (LAS unsigned*)(lds + LDS_MASK);
    __syncthreads();
    if (qblk < 4) { for (int i = tid; i < 64 * MP; i += 512) maskQ[i] = 0xFFFFFFFFu; }
    else {
#pragma unroll 1
        for (int p = 0; p < 2; ++p) index_select(lds, maskQ, PA, WI, scr_unit + (size_t)(p * 8 + wid) * 4096, row0, qblk * 64 + 32 * p, 32 * p, nkt, tid, wid, lane);
    }
    const int qh = wid & 1, hp = (wid >> 1) & 1, gs = wid >> 2;
    const int qrow = qblk * 64 + 32 * qh + r32;
    const int skey = tid >> 3, sc8 = tid & 7;
    const unsigned kdst = LDS_KV + skey * KP + sc8 * 16, vdst = LDS_KV + KBYTES + (sc8 >> 2) * 4096 + (skey >> 3) * 512 + (skey & 7) * 64 + (sc8 & 3) * 16;
    const unsigned vb = (unsigned)(uintptr_t)(lds + LDS_KV + gs * KV1 + KBYTES) + ((lane >> 4) & 1) * 32 + (lane & 3) * 8 + (4 * hh + ((lane & 15) >> 2)) * 64;
    const LAS unsigned* mrow = maskQ + (32 * qh + r32) * MP;
#pragma unroll 1
    for (int gp = 0; gp < 2; ++gp) {
        const int hq0 = 4 * (2 * gp + gs) + 2 * hp;
        const bf16* qp = PA + (row0 + qrow) * A_INP + hq0 * 64 + 8 * hh;
        f16x8 qf[4];
        LAS unsigned char* const qpark = lds + LDS_Q + wid * 4096 + lane * 16;
        f16x8 q1t[4];
#pragma unroll
        for (int ks = 0; ks < 4; ++ks) { qf[ks] = *(const f16x8*)(qp + 16 * ks); q1t[ks] = *(const f16x8*)(qp + 64 + 16 * ks); }
        const bf16* kg = PA + (row0 + skey) * A_INP + 1024 + (2 * gp) * 64 + sc8 * 8;
        v4u kreg0 = *(const v4u*)kg, kreg1 = *(const v4u*)(kg + 64), vreg0 = *(const v4u*)(kg + 256), vreg1 = *(const v4u*)(kg + 320);
        f32x16 o00 = {}, o01 = {}, o10 = {}, o11 = {}; float mrun0 = -INFINITY, mrun1 = -INFINITY, lrun0 = 0.f, lrun1 = 0.f;
        __syncthreads();
#pragma unroll
        for (int ks = 0; ks < 4; ++ks) *(LAS f16x8*)(qpark + ks * 1024) = q1t[ks];
#pragma unroll 1
        for (int kt = 0; kt < nk64; ++kt) {
            const unsigned bo = (kt & 1) * KVBUF2;
            *(LAS v4u*)(lds + kdst + bo) = kreg0; *(LAS v4u*)(lds + kdst + bo + KV1) = kreg1; *(LAS v4u*)(lds + vdst + bo) = vreg0; *(LAS v4u*)(lds + vdst + bo + KV1) = vreg1;
            __syncthreads();
            const LAS unsigned char* kb = lds + LDS_KV + bo + gs * KV1;
            f32x16 p00 = {}, p01 = {}, p10 = {}, p11 = {};
#pragma unroll
            for (int ks = 0; ks < 4; ++ks) {
                const f16x8 k0 = *(const LAS f16x8*)(kb + r32 * KP + ks * 32 + hh * 16);
                const f16x8 k1 = *(const LAS f16x8*)(kb + (32 + r32) * KP + ks * 32 + hh * 16);
                const f16x8 q1 = *(const LAS f16x8*)(qpark + ks * 1024);
                p00 = __builtin_amdgcn_mfma_f32_32x32x16_f16(k0, qf[ks], p00, 0, 0, 0);
                p01 = __builtin_amdgcn_mfma_f32_32x32x16_f16(k1, qf[ks], p01, 0, 0, 0);
                p10 = __builtin_amdgcn_mfma_f32_32x32x16_f16(k0, q1, p10, 0, 0, 0);
                p11 = __builtin_amdgcn_mfma_f32_32x32x16_f16(k1, q1, p11, 0, 0, 0);
                if (ks == 1) __builtin_amdgcn_sched_barrier(0);
            }
            const int w0 = (int)(mrow[2 * kt] >> (4 * hh)), w1 = (int)(mrow[2 * kt + 1] >> (4 * hh));
            f16x8 pa0[4], pa1[4];
#define DSA_PKP(P, S, J) __builtin_bit_cast(unsigned, __builtin_amdgcn_cvt_pkrtz(P[8 * (S) + 2 * (J)], P[8 * (S) + 2 * (J) + 1]))
#define DSA_SOFTMAX(PA, PB, OA_, OB_, MRUN, LRUN, PAV) do { \
            float mx = fmaxf(PA[0], PB[0]); \
            _Pragma("unroll") for (int r = 1; r < 16; ++r) mx = fmaxf(fmaxf(mx, PA[r]), PB[r]); \
            mx = xmax32(mx); \
            float mn = MRUN;                                    \
            if (__any(mx > MRUN + SM_THR)) { mn = fmaxf(MRUN, mx); const float al = __builtin_amdgcn_exp2f(MRUN - mn); LRUN *= al; MRUN = mn; \
                _Pragma("unroll") for (int r = 0; r < 16; ++r) { OA_[r] *= al; OB_[r] *= al; } } \
            float ls = 0.f; \
            _Pragma("unroll") for (int r = 0; r < 16; ++r) { const int cr = (r & 3) + 8 * (r >> 2); \
                PA[r] = __builtin_bit_cast(float, __builtin_bit_cast(int, __builtin_amdgcn_exp2f(PA[r] - mn)) & __builtin_amdgcn_sbfe(w0, cr, 1)); \
                PB[r] = __builtin_bit_cast(float, __builtin_bit_cast(int, __builtin_amdgcn_exp2f(PB[r] - mn)) & __builtin_amdgcn_sbfe(w1, cr, 1)); \
                ls += PA[r] + PB[r]; } \
            LRUN += ls; \
            _Pragma("unroll") for (int s2 = 0; s2 < 2; ++s2) { u32x4 x; \
                x.x = DSA_PKP(PA, s2, 0); x.y = DSA_PKP(PA, s2, 1); x.z = DSA_PKP(PA, s2, 2); x.w = DSA_PKP(PA, s2, 3); PAV[s2] = __builtin_bit_cast(f16x8, x); \
                x.x = DSA_PKP(PB, s2, 0); x.y = DSA_PKP(PB, s2, 1); x.z = DSA_PKP(PB, s2, 2); x.w = DSA_PKP(PB, s2, 3); PAV[2 + s2] = __builtin_bit_cast(f16x8, x); } \
            __builtin_amdgcn_sched_barrier(0); } while (0)
            DSA_SOFTMAX(p00, p01, o00, o01, mrun0, lrun0, pa0);
            DSA_SOFTMAX(p10, p11, o10, o11, mrun1, lrun1, pa1);
#undef DSA_SOFTMAX
#undef DSA_PKP
            if (kt + 1 < nk64) { const bf16* kn = kg + (size_t)(kt + 1) * 64 * A_INP; kreg0 = *(const v4u*)kn; kreg1 = *(const v4u*)(kn + 64); vreg0 = *(const v4u*)(kn + 256); vreg1 = *(const v4u*)(kn + 320); }
            const unsigned vbt = vb + bo;
#pragma unroll
            for (int d0 = 0; d0 < 2; ++d0) {
                s16x4 lo[4], hi4[4];
#pragma unroll
                for (int ks = 0; ks < 4; ++ks) {
                    asm volatile("ds_read_b64_tr_b16 %0,%1 offset:%c2" : "=&v"(lo[ks]) : "v"(vbt), "i"(d0 * 4096 + ks * 1024) : "memory");
                    asm volatile("ds_read_b64_tr_b16 %0,%1 offset:%c2" : "=&v"(hi4[ks]) : "v"(vbt), "i"(d0 * 4096 + ks * 1024 + 512) : "memory"); }
                asm volatile("s_waitcnt lgkmcnt(0)" ::: "memory"); __builtin_amdgcn_sched_barrier(0);
#define DSA_PK(k) __builtin_bit_cast(f16x8, (bf16x8){lo[k][0], lo[k][1], lo[k][2], lo[k][3], hi4[k][0], hi4[k][1], hi4[k][2], hi4[k][3]})
                if (d0 == 0) {
#pragma unroll
                    for (int k = 0; k < 4; ++k) { o00 = __builtin_amdgcn_mfma_f32_32x32x16_f16(DSA_PK(k), pa0[k], o00, 0, 0, 0); o10 = __builtin_amdgcn_mfma_f32_32x32x16_f16(DSA_PK(k), pa1[k], o10, 0, 0, 0); }
                } else {
#pragma unroll
                    for (int k = 0; k < 4; ++k) { o01 = __builtin_amdgcn_mfma_f32_32x32x16_f16(DSA_PK(k), pa0[k], o01, 0, 0, 0); o11 = __builtin_amdgcn_mfma_f32_32x32x16_f16(DSA_PK(k), pa1[k], o11, 0, 0, 0); }
                }
#undef DSA_PK
            }
        }
        lrun0 += __shfl_xor(lrun0, 32); lrun1 += __shfl_xor(lrun1, 32);
        const float inv0 = 1.0f / lrun0, inv1 = 1.0f / lrun1;
        bf16* op = OA + (row0 + qrow) * DM + hq0 * 64 + 4 * hh;
#pragma unroll
        for (int gq = 0; gq < 4; ++gq) {
            u32x2 x;
            x.x = pg8::cvt_pk_bf16(o00[4 * gq] * inv0, o00[4 * gq + 1] * inv0); x.y = pg8::cvt_pk_bf16(o00[4 * gq + 2] * inv0, o00[4 * gq + 3] * inv0); *(u32x2*)(op + 8 * gq) = x;
            x.x = pg8::cvt_pk_bf16(o01[4 * gq] * inv0, o01[4 * gq + 1] * inv0); x.y = pg8::cvt_pk_bf16(o01[4 * gq + 2] * inv0, o01[4 * gq + 3] * inv0); *(u32x2*)(op + 32 + 8 * gq) = x;
            x.x = pg8::cvt_pk_bf16(o10[4 * gq] * inv1, o10[4 * gq + 1] * inv1); x.y = pg8::cvt_pk_bf16(o10[4 * gq + 2] * inv1, o10[4 * gq + 3] * inv1); *(u32x2*)(op + 64 + 8 * gq) = x;
            x.x = pg8::cvt_pk_bf16(o11[4 * gq] * inv1, o11[4 * gq + 1] * inv1); x.y = pg8::cvt_pk_bf16(o11[4 * gq + 2] * inv1, o11[4 * gq + 3] * inv1); *(u32x2*)(op + 96 + 8 * gq) = x;
        }
    }
}
__device__ __forceinline__ void phase(Frame& F, const Args& A) {
    const bf16* PA = (const bf16*)(A.ws + WS_PA); const float* WI = (const float*)(A.ws + WS_WI); bf16* OA = (bf16*)(A.ws + WS_OA);
    unsigned* scr = (unsigned*)(A.ws + WS_KVB);
    for (int u = blockIdx.x; u < 256; u += F.G) { const int b = u >> 4, j = u & 15; unit(F.lds, PA, WI, OA, scr + (size_t)(2 * u) * 65536, b, 31 - j); unit(F.lds, PA, WI, OA, scr + (size_t)(2 * u + 1) * 65536, b, j); }
}
}
namespace mla {
typedef float f32x16 __attribute__((ext_vector_type(16)));
typedef short s16x4 __attribute__((ext_vector_type(4)));
constexpr int KP = 208;
constexpr int LDS_K = 0, LDS_V = 64 * KP, BUFB = LDS_V + 8192, LDS_END = 2 * BUFB;
__device__ __forceinline__ float xmax32(float m) { auto rr = __builtin_amdgcn_permlane32_swap(__float_as_uint(m), __float_as_uint(m), false, false); return fmaxf(__uint_as_float(rr[0]), __uint_as_float(rr[1])); }
__device__ __forceinline__ void attn_unit(LAS unsigned char* lds, const bf16* QB, const bf16* KVB, const bf16* CB, bf16* OB, int b, int h, int qb) {
    const int tid = threadIdx.x, lane = tid & 63, r32 = lane & 31, hi = lane >> 5; const int wid = __builtin_amdgcn_readfirstlane(tid >> 6);
    const int c0 = qb * 4, cw = c0 + (wid >> 1), ntile = c0 + 4;
    const size_t row0 = (size_t)b * SEQ;
    const bf16* qp = QB + (row0 + (size_t)qb * 256 + wid * 32 + r32) * QUP + h * 96 + hi * 8;
    bf16x8 qf[6];
#pragma unroll
    for (int ks = 0; ks < 6; ++ks) qf[ks] = *(const bf16x8*)(qp + ks * 16);
    f32x16 o0 = {}, o1 = {}; float mrun = -INFINITY, lrun = 0.f;
    const unsigned vb = (unsigned)(uintptr_t)(lds + LDS_V) + ((lane >> 4) & 1) * 32 + (lane & 3) * 8 + (4 * hi + ((lane & 15) >> 2)) * 64;
    const int ka = tid / 12, kca = tid % 12, kb_ = (tid + 512) / 12, kcb = (tid + 512) % 12; const bool has2 = tid < 256;
    const bf16* ksa = (kca < 8) ? (KVB + (row0 + ka) * KVUP + h * 128 + kca * 8) : (CB + (row0 + ka) * B_INP + 640 + (kca - 8) * 8);
    const bf16* ksb = (kcb < 8) ? (KVB + (row0 + kb_) * KVUP + h * 128 + kcb * 8) : (CB + (row0 + kb_) * B_INP + 640 + (kcb - 8) * 8);
    const size_t stepa = (size_t)64 * ((kca < 8) ? KVUP : B_INP), stepb = (size_t)64 * ((kcb < 8) ? KVUP : B_INP);
    const bf16* vs = KVB + (row0 + (tid >> 3)) * KVUP + h * 128 + 64 + (tid & 7) * 8;
    const unsigned kda = LDS_K + ka * KP + kca * 16, kdb = LDS_K + kb_ * KP + kcb * 16;
    const unsigned vd = LDS_V + ((tid & 7) >> 2) * 4096 + ((tid >> 3) >> 3) * 512 + ((tid >> 3) & 7) * 64 + (tid & 3) * 16;
    v4u ra = *(const v4u*)ksa, rb = has2 ? *(const v4u*)ksb : (v4u){0u, 0u, 0u, 0u}, rv = *(const v4u*)vs;
    __syncthreads();
    for (int kt = 0; kt < ntile; ++kt) {
        const unsigned bo = (kt & 1) * BUFB;
        *(LAS v4u*)(lds + kda + bo) = ra; if (has2) *(LAS v4u*)(lds + kdb + bo) = rb; *(LAS v4u*)(lds + vd + bo) = rv;
        if (kt + 1 < ntile) { ra = *(const v4u*)(ksa + (size_t)(kt + 1) * stepa); if (has2) rb = *(const v4u*)(ksb + (size_t)(kt + 1) * stepb); rv = *(const v4u*)(vs + (size_t)(kt + 1) * 64 * KVUP); }
        __syncthreads();
        if (kt <= cw) {
            f32x16 p0 = {}, p1 = {};
#pragma unroll
            for (int ks = 0; ks < 6; ++ks) {
                const bf16x8 k0 = *(const LAS bf16x8*)(lds + bo + LDS_K + r32 * KP + ks * 32 + hi * 16);
                const bf16x8 k1 = *(const LAS bf16x8*)(lds + bo + LDS_K + (32 + r32) * KP + ks * 32 + hi * 16);
                p0 = __builtin_amdgcn_mfma_f32_32x32x16_bf16(k0, qf[ks], p0, 0, 0, 0);
                p1 = __builtin_amdgcn_mfma_f32_32x32x16_bf16(k1, qf[ks], p1, 0, 0, 0);
            }
            float mx = fmaxf(p0[0], p1[0]);
#pragma unroll
            for (int r = 1; r < 16; ++r) mx = fmaxf(mx, fmaxf(p0[r], p1[r]));
            mx = xmax32(mx);
            float mn = mrun;
            if (__any(mx > mrun + SM_THR)) { mn = fmaxf(mrun, mx); const float alpha = __builtin_amdgcn_exp2f(mrun - mn); lrun *= alpha; mrun = mn;
#pragma unroll
                for (int r = 0; r < 16; ++r) { o0[r] *= alpha; o1[r] *= alpha; } }
            float ls = 0.f;
#pragma unroll
            for (int r = 0; r < 16; ++r) { p0[r] = __builtin_amdgcn_exp2f(p0[r] - mn); p1[r] = __builtin_amdgcn_exp2f(p1[r] - mn); ls += p0[r] + p1[r]; }
            lrun += ls;
            const unsigned vbt = vb + bo;
            bf16x8 pa[4];
#pragma unroll
            for (int s = 0; s < 2; ++s) {
                u32x4 w0, w1;
                w0.x = pg8::cvt_pk_bf16(p0[8 * s + 0], p0[8 * s + 1]); w0.y = pg8::cvt_pk_bf16(p0[8 * s + 2], p0[8 * s + 3]); w0.z = pg8::cvt_pk_bf16(p0[8 * s + 4], p0[8 * s + 5]); w0.w = pg8::cvt_pk_bf16(p0[8 * s + 6], p0[8 * s + 7]);
                w1.x = pg8::cvt_pk_bf16(p1[8 * s + 0], p1[8 * s + 1]); w1.y = pg8::cvt_pk_bf16(p1[8 * s + 2], p1[8 * s + 3]); w1.z = pg8::cvt_pk_bf16(p1[8 * s + 4], p1[8 * s + 5]); w1.w = pg8::cvt_pk_bf16(p1[8 * s + 6], p1[8 * s + 7]);
                pa[s] = __builtin_bit_cast(bf16x8, w0); pa[2 + s] = __builtin_bit_cast(bf16x8, w1);
            }
#pragma unroll
            for (int d0 = 0; d0 < 2; ++d0) {
                s16x4 lo[4], hi4[4];
#pragma unroll
                for (int ks = 0; ks < 4; ++ks) {
                    asm volatile("ds_read_b64_tr_b16 %0,%1 offset:%c2" : "=&v"(lo[ks]) : "v"(vbt), "i"(d0 * 4096 + ks * 1024) : "memory");
                    asm volatile("ds_read_b64_tr_b16 %0,%1 offset:%c2" : "=&v"(hi4[ks]) : "v"(vbt), "i"(d0 * 4096 + ks * 1024 + 512) : "memory"); }
                asm volatile("s_waitcnt lgkmcnt(0)" ::: "memory"); __builtin_amdgcn_sched_barrier(0);
#define MLA_PK(k) (bf16x8){lo[k][0], lo[k][1], lo[k][2], lo[k][3], hi4[k][0], hi4[k][1], hi4[k][2], hi4[k][3]}
                if (d0 == 0) { o0 = __builtin_amdgcn_mfma_f32_32x32x16_bf16(MLA_PK(0), pa[0], o0, 0, 0, 0); o0 = __builtin_amdgcn_mfma_f32_32x32x16_bf16(MLA_PK(1), pa[1], o0, 0, 0, 0);
                               o0 = __builtin_amdgcn_mfma_f32_32x32x16_bf16(MLA_PK(2), pa[2], o0, 0, 0, 0); o0 = __builtin_amdgcn_mfma_f32_32x32x16_bf16(MLA_PK(3), pa[3], o0, 0, 0, 0); }
                else         { o1 = __builtin_amdgcn_mfma_f32_32x32x16_bf16(MLA_PK(0), pa[0], o1, 0, 0, 0); o1 = __builtin_amdgcn_mfma_f32_32x32x16_bf16(MLA_PK(1), pa[1], o1, 0, 0, 0);
                               o1 = __builtin_amdgcn_mfma_f32_32x32x16_bf16(MLA_PK(2), pa[2], o1, 0, 0, 0); o1 = __builtin_amdgcn_mfma_f32_32x32x16_bf16(MLA_PK(3), pa[3], o1, 0, 0, 0); }
#undef MLA_PK
            }
        }
    }
    lrun += __shfl_xor(lrun, 32);
    const float inv = 1.0f / lrun;
    bf16* op = OB + (row0 + (size_t)qb * 256 + wid * 32 + r32) * DM + h * 64 + 4 * hi;
#pragma unroll
    for (int g = 0; g < 4; ++g) {
        u32x2 w; w.x = pg8::cvt_pk_bf16(o0[4 * g] * inv, o0[4 * g + 1] * inv); w.y = pg8::cvt_pk_bf16(o0[4 * g + 2] * inv, o0[4 * g + 3] * inv); *(u32x2*)(op + 8 * g) = w;
        u32x2 z; z.x = pg8::cvt_pk_bf16(o1[4 * g] * inv, o1[4 * g + 1] * inv); z.y = pg8::cvt_pk_bf16(o1[4 * g + 2] * inv, o1[4 * g + 3] * inv); *(u32x2*)(op + 32 + 8 * g) = z;
    }
}
__device__ __forceinline__ void attn_phase(Frame& F, const Args& A) {
    const bf16* QB = (const bf16*)(A.ws + WS_QB); const bf16* KVB = (const bf16*)(A.ws + WS_KVB); const bf16* CB = (const bf16*)(A.ws + WS_CB); bf16* OB = (bf16*)(A.ws + WS_OB);
    for (int u = blockIdx.x; u < BATCH * 16 * 8; u += F.G) { const int bh = u & 255, qb = u >> 8; attn_unit(F.lds, QB, KVB, CB, OB, bh >> 4, bh & 15, qb); }
}
}
__global__ void __launch_bounds__(NWAVES * 64, 2) mk_fwd(Args args) {
    extern __shared__ __attribute__((aligned(16))) unsigned char lds_raw[];
    Frame F;
    F.lds = (LAS unsigned char*)lds_raw;
    F.MISC = (volatile LAS unsigned*)(F.lds + MISC_OFF);
    F.tid = threadIdx.x; F.lane = F.tid & 63; F.wave = __builtin_amdgcn_readfirstlane(F.tid >> 6);
    F.G = gridDim.x;
    unsigned char* ws = args.ws;
    F.ctl = (gu32*)(ws + WS_CTL);
    for (int u = F.tid; u < (LDS_BYTES - LDSCTL_OFF) / 4; u += NWAVES * 64) ((LAS unsigned*)(F.lds + LDSCTL_OFF))[u] = 0u;
    __syncthreads();
    XcdBarrier bar; bar.bar = (unsigned*)(F.ctl + CW_BAR); bar.x = 0; bar.st = nullptr;
    if (N_LAUNCHES == 1) bar = xcd_barrier_post((unsigned*)(F.ctl + CW_BAR), F.MISC + 8);
#define GRID_BAR() do { if (N_LAUNCHES == 1) xcd_barrier(bar); } while (0)
    const int lo = args.ph_lo, hi = args.ph_hi;
#ifndef PHMASK
#define PHMASK 0x1fff
#endif
#define IN(k) (((PHMASK >> (k)) & 1) && lo <= (k) && (k) < hi)
    bf16* const XB = (bf16*)(ws + WS_XB); float* const SS = (float*)(ws + WS_SS); float* const SSB = (float*)(ws + WS_SSB);
    const float* const cosA = (const float*)(ws + WS_COSA); const float* const sinA = (const float*)(ws + WS_SINA);
    const float* const cosB = (const float*)(ws + WS_COSB); const float* const sinB = (const float*)(ws + WS_SINB);
    const int bid = (int)blockIdx.x;

    if (IN(0)) { p0_prologue(F, args); GRID_BAR(); }
    if (IN(1)) {
        pg8::Gemm g{XB, (const bf16*)(ws + WS_WAIN), M, A_INP, DM, DM, DM}; pg8::StaticOrder S; S.init(M, A_INP, F.G, bid);
        pg8::EpiDsaIn E{(bf16*)(ws + WS_PA), (float*)(ws + WS_WI), SS, cosA, sinA, IDX_WSCALE, QSCALE_A};
        pg8::gemm_phase<pg8::EpiDsaIn, pg8::StaticOrder, true, true, true>(F.lds, g, S, E);
        GRID_BAR();
    }
    if (IN(2)) { if (F.wave >= 4) __builtin_amdgcn_s_setprio(1); dsa::phase(F, args); __builtin_amdgcn_s_setprio(0); GRID_BAR(); }
#if defined(PROBE_DUP) && PROBE_DUP == 2
    if (IN(2)) { if (F.wave >= 4) __builtin_amdgcn_s_setprio(1); dsa::phase(F, args); __builtin_amdgcn_s_setprio(0); GRID_BAR(); }
#endif
    if (IN(3)) {
        pg8::Gemm g{(const bf16*)(ws + WS_OA), (const bf16*)(ws + WS_WAOUT), M, DM, DM, DM, DM}; pg8::StaticOrder S; S.init(M, DM, F.G, bid);
        pg8::EpiResid E{(const float*)args.in[0], args.out, XB, SS};
        pg8::gemm_phase<pg8::EpiResid, pg8::StaticOrder, true, true, false>(F.lds, g, S, E);
        GRID_BAR();
    }
    if (IN(4)) {
        pg8::Gemm g{XB, (const bf16*)(ws + WS_WUP0), M, FF, DM, DM, DM}; pg8::StaticOrder S; S.init(M, FF, F.G, bid);
        pg8::EpiMlpUp E{(bf16*)(ws + WS_H), SS};
        pg8::gemm_phase<pg8::EpiMlpUp, pg8::StaticOrder, true, true, false>(F.lds, g, S, E);
        GRID_BAR();
    }
    if (IN(5)) {
        pg8::Gemm g{(const bf16*)(ws + WS_H), (const bf16*)(ws + WS_WDN0), M, DM, FF, FF, FF}; pg8::StaticOrder S; S.init(M, DM, F.G, bid);
        pg8::EpiResid E{args.out, args.out, XB, SS};
        pg8::gemm_phase<pg8::EpiResid, pg8::StaticOrder, true, true, false>(F.lds, g, S, E);
        GRID_BAR();
    }
    if (IN(6)) {
        pg8::Gemm g{XB, (const bf16*)(ws + WS_WBIN), M, B_INP, DM, DM, DM}; pg8::StaticOrder S; S.init(M, B_INP, F.G, bid);
        pg8::EpiMlaIn E{(bf16*)(ws + WS_CB), SSB, SS, cosB, sinB};
        pg8::gemm_phase<pg8::EpiMlaIn, pg8::StaticOrder, true, true, false>(F.lds, g, S, E);
        GRID_BAR();
    }
    if (IN(7)) {
#ifndef NO_QUP
        { pg8::Gemm g{(const bf16*)(ws + WS_CB), (const bf16*)(ws + WS_WQUP), M, QUP, QLORA, B_INP, QLORA}; pg8::StaticOrder S; S.init(M, QUP, F.G, bid);
          pg8::EpiQUp E{(bf16*)(ws + WS_QB), SSB, cosB, sinB, QSCALE_B};
          pg8::gemm_phase<pg8::EpiQUp, pg8::StaticOrder, true, true, false>(F.lds, g, S, E); }
#endif
#ifndef NO_KVUP
        { pg8::Gemm g{(const bf16*)(ws + WS_CB) + QLORA, (const bf16*)(ws + WS_WKVUP), M, KVUP, KVLORA, B_INP, KVLORA}; pg8::StaticOrder S; S.init(M, KVUP, F.G, bid);
          pg8::EpiKvUp E{(bf16*)(ws + WS_KVB), SSB};
          pg8::gemm_phase<pg8::EpiKvUp, pg8::StaticOrder, true, true, false>(F.lds, g, S, E); }
#endif
        GRID_BAR();
    }
    if (IN(8)) { if (F.wave >= 4) __builtin_amdgcn_s_setprio(1); mla::attn_phase(F, args); __builtin_amdgcn_s_setprio(0); GRID_BAR(); }
#if defined(PROBE_DUP) && PROBE_DUP == 8
    if (IN(8)) { if (F.wave >= 4) __builtin_amdgcn_s_setprio(1); mla::attn_phase(F, args); __builtin_amdgcn_s_setprio(0); GRID_BAR(); }
#endif
    if (IN(9)) {
        pg8::Gemm g{(const bf16*)(ws + WS_OB), (const bf16*)(ws + WS_WBOUT), M, DM, DM, DM, DM}; pg8::StaticOrder S; S.init(M, DM, F.G, bid);
        pg8::EpiResid E{args.out, args.out, XB, SS};
        pg8::gemm_phase<pg8::EpiResid, pg8::StaticOrder, true, true, false>(F.lds, g, S, E);
        GRID_BAR();
    }
    if (IN(10)) {
        pg8::Gemm g{XB, (const bf16*)(ws + WS_WUP1), M, FF, DM, DM, DM}; pg8::StaticOrder S; S.init(M, FF, F.G, bid);
        pg8::EpiMlpUp E{(bf16*)(ws + WS_H), SS};
        pg8::gemm_phase<pg8::EpiMlpUp, pg8::StaticOrder, true, true, false>(F.lds, g, S, E);
        GRID_BAR();
    }
    if (IN(11)) {
        pg8::Gemm g{(const bf16*)(ws + WS_H), (const bf16*)(ws + WS_WDN1), M, DM, FF, FF, FF}; pg8::StaticOrder S; S.init(M, DM, F.G, bid);
        pg8::EpiResid E{args.out, args.out, nullptr, SS};
        pg8::gemm_phase<pg8::EpiResid, pg8::StaticOrder, true, true, false>(F.lds, g, S, E);
        GRID_BAR();
    }
    if (IN(12)) { p12_final_norm(F, args); }
#undef IN
#undef GRID_BAR
}

extern "C" void kernel_launch(void* const* d_in, const int* in_sizes, int n_in, void* d_out, int out_size, void* d_ws, size_t ws_size, hipStream_t stream) {
    static int grid = 0;
    if (grid == 0) {
        if (n_in != 15 || in_sizes[0] != M * DM || out_size != M * DM || ws_size < WS_END) { fprintf(stderr, "kernel_launch: unexpected shapes / workspace (n_in %d, in0 %d, out %d, ws %zu); nothing launched\n", n_in, n_in > 0 ? in_sizes[0] : -1, out_size, ws_size); grid = -1; return; }
        int dev = 0, cus = 0, per_cu = 0;
        if (hipGetDevice(&dev) != hipSuccess || hipDeviceGetAttribute(&cus, hipDeviceAttributeMultiprocessorCount, dev) != hipSuccess) { grid = -1; return; }
        if (hipFuncSetAttribute((const void*)mk_fwd, hipFuncAttributeMaxDynamicSharedMemorySize, LDS_BYTES) != hipSuccess) { fprintf(stderr, "kernel_launch: hipFuncSetAttribute failed\n"); grid = -1; return; }
        if (hipOccupancyMaxActiveBlocksPerMultiprocessor(&per_cu, (const void*)mk_fwd, NWAVES * 64, LDS_BYTES) != hipSuccess || per_cu < 1) { fprintf(stderr, "kernel_launch: occupancy query reports %d blocks per CU\n", per_cu); }
        (void)hipGetLastError();
        grid = cus;
    }
    if (grid < 0) return;
    if (hipMemsetAsync((char*)d_ws + WS_CTL, 0, CTL_ZERO_BYTES, stream) != hipSuccess) return;
    Args a{};
    for (int i = 0; i < 15; ++i) a.in[i] = d_in[i];
    a.out = (float*)d_out; a.ws = (unsigned char*)d_ws;
    for (int i = 0; i < 8; ++i) a.inv_a[i] = (float)pow(500000.0, -(double)i / 8.0);
    for (int i = 0; i < 16; ++i) a.inv_b[i] = (float)pow(500000.0, -(double)i / 16.0);
    if (N_LAUNCHES == 1) { a.ph_lo = 0; a.ph_hi = N_PHASES; hipLaunchKernelGGL(mk_fwd, dim3(grid), dim3(NWAVES * 64), LDS_BYTES, stream, a); }
    else for (int li = 0; li < N_PHASES; ++li) { a.ph_lo = li; a.ph_hi = li + 1; hipLaunchKernelGGL(mk_fwd, dim3(grid), dim3(NWAVES * 64), LDS_BYTES, stream, a); }
    const hipError_t le = hipPeekAtLastError();
    if (le != hipSuccess) fprintf(stderr, "kernel_launch: launch failed: %s\n", hipGetErrorName(le));
}
```

```cpp
#include <hip/hip_runtime.h>
#include <cstdio>
#include <cstdint>
#include <cmath>
namespace pg8 {
#define PG8_LAS __attribute__((address_space(3)))
typedef unsigned short bf16_t;
typedef short bf16x8 __attribute__((ext_vector_type(8)));
typedef float f32x4 __attribute__((ext_vector_type(4)));
typedef unsigned u32x4 __attribute__((ext_vector_type(4)));
constexpr int BM = 256, BK = 64, HALF = 128, HTB = HALF * BK * 2  , STAGE_BYTES = 8 * HTB, NXCD = 8, WGM = 8;

__host__ __device__ __forceinline__ int lds_byte(int r, int c) { const int st = (r >> 4) * 2 + (c >> 5), rr = r & 15, cc = c & 31, ob = rr * 64 + cc * 2; return st * 1024 + (ob ^ (((ob >> 9) & 1) << 5)); }
__host__ __device__ __forceinline__ void stage_rc(int b, int& R, int& C) { const int st = b / 1024, sb = b % 1024, swz = sb ^ (((sb >> 9) & 1) << 5); R = (st >> 1) * 16 + swz / 64; C = (st & 1) * 32 + (swz % 64) / 2; }
__host__ __device__ __forceinline__ int perm32(int rho) { const int n = rho >> 4, i = rho & 15; return 8 * (i >> 2) + 4 * n + (i & 3); }

struct Unit { int pm, pn; };
struct Gemm { const bf16_t* A; const bf16_t* Bt; int M, N, K, lda, ldb; };

struct StaticOrder {
    int nM, nN, nwg, G, c;
    __host__ __device__ void init(int M, int N, int G_, int c_) { nM = M / BM; nN = N / BM; nwg = nM * nN; G = G_; c = c_; }
    __host__ __device__ bool next(int i, Unit& u) const {
        const long L = (long)i * G + c; if (L >= nwg) return false;
        int wgid = (int)L; { const int q = nwg / NXCD, r = nwg % NXCD, xcd = wgid % NXCD, off = wgid / NXCD; wgid = (xcd < r ? xcd * (q + 1) : r * (q + 1) + (xcd - r) * q) + off; }
        const int nig = WGM * nN, gid = wgid / nig, fm = gid * WGM, gsz = (nM - fm) < WGM ? (nM - fm) : WGM;
        u.pm = fm + ((wgid % nig) % gsz); u.pn = (wgid % nig) / gsz; return true;
    }
    __device__ __forceinline__ void a_ready(const Unit&) const {}
    __device__ __forceinline__ void done(const Unit&) const {}
};

__device__ __forceinline__ unsigned cvt_pk_bf16(float lo, float hi) { unsigned r; asm volatile("v_cvt_pk_bf16_f32 %0, %1, %2" : "=v"(r) : "v"(lo), "v"(hi)); return r; }
typedef _Float16 f16x8_t __attribute__((ext_vector_type(8)));
typedef _Float16 f16x2_t __attribute__((ext_vector_type(2)));
template <bool F16> __device__ __forceinline__ f32x4 mma16(bf16x8 a, bf16x8 b, f32x4 c) {
    if constexpr (F16) return __builtin_amdgcn_mfma_f32_16x16x32_f16(__builtin_bit_cast(f16x8_t, a), __builtin_bit_cast(f16x8_t, b), c, 0, 0, 0);
    else return __builtin_amdgcn_mfma_f32_16x16x32_bf16(a, b, c, 0, 0, 0);
}
__device__ __forceinline__ unsigned cvt_pk_f16(float lo, float hi) { f16x2_t t = {(_Float16)lo, (_Float16)hi}; return __builtin_bit_cast(unsigned, t); }
__device__ __forceinline__ u32x4 pack8_bf16(f32x4 a, f32x4 b) { u32x4 w; w.x = cvt_pk_bf16(a[0], a[1]); w.y = cvt_pk_bf16(a[2], a[3]); w.z = cvt_pk_bf16(b[0], b[1]); w.w = cvt_pk_bf16(b[2], b[3]); return w; }
__device__ __forceinline__ u32x4 pack8_f16(f32x4 a, f32x4 b) { u32x4 w; w.x = cvt_pk_f16(a[0], a[1]); w.y = cvt_pk_f16(a[2], a[3]); w.z = cvt_pk_f16(b[0], b[1]); w.w = cvt_pk_f16(b[2], b[3]); return w; }
typedef unsigned u32x2 __attribute__((ext_vector_type(2)));
__device__ __forceinline__ u32x2 pack4_bf16(f32x4 a) { u32x2 w; w.x = cvt_pk_bf16(a[0], a[1]); w.y = cvt_pk_bf16(a[2], a[3]); return w; }
__device__ __forceinline__ f32x4 shfl4(f32x4 v, int x) { f32x4 r; r[0] = __shfl_xor(v[0], x); r[1] = __shfl_xor(v[1], x); r[2] = __shfl_xor(v[2], x); r[3] = __shfl_xor(v[3], x); return r; }
__device__ __forceinline__ float sum4(f32x4 v) { return (v[0] + v[1]) + (v[2] + v[3]); }
__device__ __forceinline__ float dot4(f32x4 v) { return (v[0] * v[0] + v[1] * v[1]) + (v[2] * v[2] + v[3] * v[3]); }
constexpr float RMS_EPS = 1e-6f;
__device__ __forceinline__ float rstd_from(const float* p, int n4, float inv_cnt) {
    float s = 0.f;
#pragma unroll 4
    for (int i = 0; i < n4; ++i) s += sum4(((const f32x4*)p)[i]);
    return __builtin_amdgcn_rsqf(s * inv_cnt + RMS_EPS);
}

__device__ __forceinline__ void rstd8(float (&rs)[2][4], const float* p, int stride, int n4, float inv_cnt, int rowbase) {
#pragma unroll
    for (int ai = 0; ai < 2; ++ai)
#pragma unroll
        for (int m = 0; m < 4; ++m) rs[ai][m] = rstd_from(p + (size_t)(rowbase + ai * HALF + m * 16) * stride, n4, inv_cnt);
}
struct EpiDsaIn {
    static constexpr bool PERM = true, AFTER_DRAIN = false;
    bf16_t* PA; float* WI; const float* SS; const float* cosA; const float* sinA; float wscale, qscale;
    __device__ __forceinline__ void operator()(const f32x4 (&acc)[2][2][4][2], const Unit& u, int wr, int wc, int fr, int fq) const {
        const bool ropew = (wc & 1) == 0;
#pragma unroll
        for (int ai = 0; ai < 2; ++ai) {
#pragma unroll
          for (int mh = 0; mh < 2; ++mh) {
            f32x4 c0v[4], c1v[4], s0v[4], s1v[4]; float rsv[4];
#pragma unroll
            for (int m = 2 * mh; m < 2 * mh + 2; ++m) { const int row = u.pm * BM + ai * HALF + wr * 64 + m * 16 + fr; rsv[m] = rstd_from(SS + (size_t)row * 16, 4, 1.0f / 1024.0f);
                if (ropew) { c0v[m] = *(const f32x4*)(cosA + (size_t)row * 8); c1v[m] = *(const f32x4*)(cosA + (size_t)row * 8 + 4); s0v[m] = *(const f32x4*)(sinA + (size_t)row * 8); s1v[m] = *(const f32x4*)(sinA + (size_t)row * 8 + 4); } }
#pragma unroll
            for (int m = 2 * mh; m < 2 * mh + 2; ++m) {
                const int row = u.pm * BM + ai * HALF + wr * 64 + m * 16 + fr;
                const float rs = rsv[m];
                f32x4 c0 = {}, c1 = {}, s0 = {}, s1 = {}; if (ropew) { c0 = c0v[m]; c1 = c1v[m]; s0 = s0v[m]; s1 = s1v[m]; }
#pragma unroll
                for (int bj = 0; bj < 2; ++bj) {
                    const int cb = u.pn * BM + bj * HALF + wc * 32;
                    const int col8 = cb + 8 * fq;
                    f32x4 v0 = acc[ai][bj][m][0] * rs, v1 = acc[ai][bj][m][1] * rs;
                    const bool ropeg = ((cb & 63) == 0) && (cb < 1280 || (cb >= 1536 && cb < 2112));
                    if (ropeg) {
                        const f32x4 p0 = shfl4(v0, 16), p1 = shfl4(v1, 16);
                        if (fq == 0) { v0 = v0 * c0 - p0 * s0; v1 = v1 * c1 - p1 * s1; }
                        else if (fq == 1) { v0 = v0 * c0 + p0 * s0; v1 = v1 * c1 + p1 * s1; }
                    }
                    if (cb < 1024) { v0 = v0 * qscale; v1 = v1 * qscale; }
                    if (cb < 2112) *(u32x4*)(PA + (size_t)row * 2304 + col8) = pack8_f16(v0, v1);
                    else if (cb == 2112 && fq == 0) { *(f32x4*)(WI + (size_t)row * 8) = v0 * wscale; *(f32x4*)(WI + (size_t)row * 8 + 4) = v1 * wscale; }
                }
            }
          }
        }
    }
};
__device__ __forceinline__ void unpack8(u32x4 w, bool f16, f32x4& a, f32x4& b) {
    if (f16) {
#define H2F_LO(U) ((float)__builtin_bit_cast(_Float16, (unsigned short)((U) & 0xffffu)))
#define H2F_HI(U) ((float)__builtin_bit_cast(_Float16, (unsigned short)((U) >> 16)))
        a[0] = H2F_LO(w.x); a[1] = H2F_HI(w.x); a[2] = H2F_LO(w.y); a[3] = H2F_HI(w.y); b[0] = H2F_LO(w.z); b[1] = H2F_HI(w.z); b[2] = H2F_LO(w.w); b[3] = H2F_HI(w.w);
#undef H2F_LO
#undef H2F_HI
    }
    else { a[0] = __builtin_bit_cast(float, w.x << 16); a[1] = __builtin_bit_cast(float, w.x & 0xffff0000u); a[2] = __builtin_bit_cast(float, w.y << 16); a[3] = __builtin_bit_cast(float, w.y & 0xffff0000u);
           b[0] = __builtin_bit_cast(float, w.z << 16); b[1] = __builtin_bit_cast(float, w.z & 0xffff0000u); b[2] = __builtin_bit_cast(float, w.w << 16); b[3] = __builtin_bit_cast(float, w.w & 0xffff0000u); }
}
template <bool BASE_F16> struct EpiResid {
    static constexpr bool PERM = true, AFTER_DRAIN = false;
    bf16_t* XB; float* SS;
    __device__ __forceinline__ void operator()(const f32x4 (&acc)[2][2][4][2], const Unit& u, int wr, int wc, int fr, int fq) const {
#pragma unroll
        for (int ai = 0; ai < 2; ++ai) {
            u32x4 bw[4][2];
#pragma unroll
            for (int m = 0; m < 4; ++m) { const int row = u.pm * BM + ai * HALF + wr * 64 + m * 16 + fr;
#pragma unroll
                for (int bj = 0; bj < 2; ++bj) bw[m][bj] = *(const u32x4*)(XB + (size_t)row * 1024 + u.pn * BM + bj * HALF + wc * 32 + 8 * fq); }
#pragma unroll
            for (int m = 0; m < 4; ++m) {
                const int row = u.pm * BM + ai * HALF + wr * 64 + m * 16 + fr;
                float ssq = 0.f;
#pragma unroll
                for (int bj = 0; bj < 2; ++bj) {
                    const int col8 = u.pn * BM + bj * HALF + wc * 32 + 8 * fq;
                    f32x4 b0, b1; unpack8(bw[m][bj], BASE_F16, b0, b1);
                    const f32x4 v0 = acc[ai][bj][m][0] + b0, v1 = acc[ai][bj][m][1] + b1;
                    *(u32x4*)(XB + (size_t)row * 1024 + col8) = pack8_bf16(v0, v1);
                    ssq += dot4(v0) + dot4(v1);
                }
                ssq += __shfl_xor(ssq, 16); ssq += __shfl_xor(ssq, 32);
                if (fq == 0) SS[(size_t)row * 16 + u.pn * 4 + wc] = ssq;
            }
        }
    }
};
struct EpiMlpUp {
    static constexpr bool PERM = true, AFTER_DRAIN = false;
    bf16_t* H; const float* SS;
    __device__ __forceinline__ void operator()(const f32x4 (&acc)[2][2][4][2], const Unit& u, int wr, int wc, int fr, int fq) const {
        float rsv[2][4]; rstd8(rsv, SS, 16, 4, 1.0f / 1024.0f, u.pm * BM + wr * 64 + fr);
#pragma unroll
        for (int ai = 0; ai < 2; ++ai)
#pragma unroll
            for (int m = 0; m < 4; ++m) {
                const int row = u.pm * BM + ai * HALF + wr * 64 + m * 16 + fr;
                const float rs = rsv[ai][m];
#pragma unroll
                for (int bj = 0; bj < 2; ++bj) {
                    const int col8 = u.pn * BM + bj * HALF + wc * 32 + 8 * fq;
                    f32x4 v0 = acc[ai][bj][m][0] * rs, v1 = acc[ai][bj][m][1] * rs;
                    const f32x4 z = {0.f, 0.f, 0.f, 0.f};
                    v0 = __builtin_elementwise_max(v0, z); v1 = __builtin_elementwise_max(v1, z);
                    *(u32x4*)(H + (size_t)row * 4096 + col8) = pack8_bf16(v0 * v0, v1 * v1);
                }
            }
    }
};
struct EpiMlaIn {
    static constexpr bool PERM = false, AFTER_DRAIN = false;
    bf16_t* CB; float* SSB; const float* SS; const float* cosB; const float* sinB;
    __device__ __forceinline__ void operator()(const f32x4 (&acc)[2][2][4][2], const Unit& u, int wr, int wc, int fr, int fq) const {
#pragma unroll
        for (int ai = 0; ai < 2; ++ai) {
#pragma unroll
          for (int mh = 0; mh < 2; ++mh) {
            float rsv[4];
#pragma unroll
            for (int m = 2 * mh; m < 2 * mh + 2; ++m) rsv[m] = rstd_from(SS + (size_t)(u.pm * BM + ai * HALF + wr * 64 + m * 16 + fr) * 16, 4, 1.0f / 1024.0f);
#pragma unroll
            for (int m = 2 * mh; m < 2 * mh + 2; ++m) {
                const int row = u.pm * BM + ai * HALF + wr * 64 + m * 16 + fr;
                const float rs = rsv[m];
#pragma unroll
                for (int bj = 0; bj < 2; ++bj) {
                    const int cb = u.pn * BM + bj * HALF + wc * 32;
                    f32x4 v0 = acc[ai][bj][m][0] * rs, v1 = acc[ai][bj][m][1] * rs;
                    if (cb == 640) { const f32x4 c = *(const f32x4*)(cosB + (size_t)row * 16 + 4 * fq), sn = *(const f32x4*)(sinB + (size_t)row * 16 + 4 * fq);
                        const f32x4 o0 = v0 * c - v1 * sn, o1 = v1 * c + v0 * sn; v0 = o0; v1 = o1; }
                    if (cb < 672) { bf16_t* p = CB + (size_t)row * 768 + cb + 4 * fq; *(u32x2*)p = pack4_bf16(v0); *(u32x2*)(p + 16) = pack4_bf16(v1); }
                    if (cb < 640) {
                        float ssq = dot4(v0) + dot4(v1);
                        ssq += __shfl_xor(ssq, 16); ssq += __shfl_xor(ssq, 32);
                        if (fq == 0) SSB[(size_t)row * 24 + (cb >> 5)] = ssq;
                    }
                }
            }
          }
        }
    }
};
struct EpiQUp {
    static constexpr bool PERM = false, AFTER_DRAIN = false;
    bf16_t* QB; const float* SSB; const float* cosB; const float* sinB; float qscale;
    __device__ __forceinline__ void operator()(const f32x4 (&acc)[2][2][4][2], const Unit& u, int wr, int wc, int fr, int fq) const {
        float rsv[2][4]; rstd8(rsv, SSB, 24, 3, 1.0f / 384.0f, u.pm * BM + wr * 64 + fr);
#pragma unroll
        for (int ai = 0; ai < 2; ++ai) {
            f32x4 cv[4], sv[4];
#pragma unroll
            for (int m = 0; m < 4; ++m) { const int row = u.pm * BM + ai * HALF + wr * 64 + m * 16 + fr; cv[m] = *(const f32x4*)(cosB + (size_t)row * 16 + 4 * fq); sv[m] = *(const f32x4*)(sinB + (size_t)row * 16 + 4 * fq); }
#pragma unroll
            for (int m = 0; m < 4; ++m) {
                const int row = u.pm * BM + ai * HALF + wr * 64 + m * 16 + fr;
                const float rs = rsv[ai][m] * qscale;
                const f32x4 c = cv[m], s = sv[m];
#pragma unroll
                for (int bj = 0; bj < 2; ++bj) {
                    const int cb = u.pn * BM + bj * HALF + wc * 32;
                    f32x4 v0 = acc[ai][bj][m][0] * rs, v1 = acc[ai][bj][m][1] * rs;
                    if (((cb >> 5) % 3) == 2) { const f32x4 o0 = v0 * c - v1 * s, o1 = v1 * c + v0 * s; v0 = o0; v1 = o1; }
                    bf16_t* p = QB + (size_t)row * 1536 + cb + 4 * fq; *(u32x2*)p = pack4_bf16(v0); *(u32x2*)(p + 16) = pack4_bf16(v1);
                }
            }
        }
    }
};
struct EpiKvUp {
    static constexpr bool PERM = true, AFTER_DRAIN = false;
    bf16_t* KVB; const float* SSB;
    __device__ __forceinline__ void operator()(const f32x4 (&acc)[2][2][4][2], const Unit& u, int wr, int wc, int fr, int fq) const {
        float rsv[2][4]; rstd8(rsv, SSB + 12, 24, 2, 1.0f / 256.0f, u.pm * BM + wr * 64 + fr);
#pragma unroll
        for (int ai = 0; ai < 2; ++ai)
#pragma unroll
            for (int m = 0; m < 4; ++m) {
                const int row = u.pm * BM + ai * HALF + wr * 64 + m * 16 + fr;
                const float rs = rsv[ai][m];
#pragma unroll
                for (int bj = 0; bj < 2; ++bj) {
                    const int col8 = u.pn * BM + bj * HALF + wc * 32 + 8 * fq;
                    *(u32x4*)(KVB + (size_t)row * 2048 + col8) = pack8_bf16(acc[ai][bj][m][0] * rs, acc[ai][bj][m][1] * rs);
                }
            }
    }
};
template <class Epi, class Sched, bool ALIGN_EPI = false, bool SP2 = false, bool F16 = false>
__device__ __forceinline__ void gemm_phase(PG8_LAS unsigned char* lds, const Gemm g, const Sched& S, const Epi& E) {
    const int tid = threadIdx.x, wid = __builtin_amdgcn_readfirstlane(tid >> 6), lane = tid & 63, wr = wid >> 2, wc = wid & 3, fr = lane & 15, fq = lane >> 4;
    const int K = g.K, nt = K / BK;
    unsigned voffA[2], voffB[2];
#pragma unroll
    for (int i = 0; i < 2; ++i) { int R, C; stage_rc(tid * 16 + i * 8192, R, C); const int Rb = Epi::PERM ? ((R & ~31) + perm32(R & 31)) : R;
        voffA[i] = (unsigned)(R * g.lda + C) * 2u; voffB[i] = (unsigned)(Rb * g.ldb + C) * 2u; }
    const size_t kstep = (size_t)(BK * 2);
    const size_t hstepA = (size_t)HALF * g.lda * 2, hstepB = (size_t)HALF * g.ldb * 2;
    const size_t tstepA = 2 * hstepA, tstepB = 2 * hstepB;
    const unsigned ldsw = (unsigned)wid * 1024u;
    const int aoff = lds_byte(wr * 64 + fr, fq * 8), boff = lds_byte(wc * 32 + fr, fq * 8);
#define PG8_SA(b, h) (((b) * 2 + (h)) * HTB)
#define PG8_SB(b, h) ((4 + (b) * 2 + (h)) * HTB)
#define PG8_STAGE(bufoff, gbase, voff) do { _Pragma("unroll") for (int _i = 0; _i < 2; ++_i) \
        __builtin_amdgcn_global_load_lds((const unsigned*)((const char*)(gbase) + (voff)[_i]), (PG8_LAS unsigned*)(lds + (bufoff) + ldsw + _i * 8192), 16, 0, 0); } while (0)
#define PG8_LDA(dst, b, h) do { _Pragma("unroll") for (int m = 0; m < 4; ++m) _Pragma("unroll") for (int k = 0; k < 2; ++k) dst[m][k] = *(const PG8_LAS bf16x8*)(lds + PG8_SA(b, h) + aoff + m * 2048 + k * 1024); } while (0)
#define PG8_LDB(dst, b, h) do { _Pragma("unroll") for (int n = 0; n < 2; ++n) _Pragma("unroll") for (int k = 0; k < 2; ++k) dst[n][k] = *(const PG8_LAS bf16x8*)(lds + PG8_SB(b, h) + boff + n * 2048 + k * 1024); } while (0)
#define PG8_MMA(ai, bj, At, Bt) do { __builtin_amdgcn_s_setprio(1); _Pragma("unroll") for (int m = 0; m < 4; ++m) _Pragma("unroll") for (int n = 0; n < 2; ++n) _Pragma("unroll") for (int k = 0; k < 2; ++k) \
        acc[ai][bj][m][n] = mma16<F16>(Bt[n][k], At[m][k], acc[ai][bj][m][n]); __builtin_amdgcn_s_setprio(0); } while (0)
#define PG8_WAIT_V(n) asm volatile("s_waitcnt vmcnt(" #n ")" ::: "memory")
#define PG8_WAIT_L(n) asm volatile("s_waitcnt lgkmcnt(" #n ")" ::: "memory")
#define PG8_BAR __builtin_amdgcn_s_barrier()
#define PG8_SCHED __builtin_amdgcn_sched_barrier(0)
    Unit cur, nxt; int ui = 0;
    if (!S.next(0, cur)) return;
    f32x4 acc[2][2][4][2];
#pragma unroll
    for (int a = 0; a < 2; ++a)
#pragma unroll
        for (int b = 0; b < 2; ++b)
#pragma unroll
            for (int m = 0; m < 4; ++m)
#pragma unroll
                for (int n = 0; n < 2; ++n) acc[a][b][m][n] = (f32x4){0.f, 0.f, 0.f, 0.f};
    bf16x8 At[4][2], B0[2][2], B1[2][2];
    const char* cA = (const char*)g.A + (size_t)cur.pm * tstepA; const char* cB = (const char*)g.Bt + (size_t)cur.pn * tstepB;
    S.a_ready(cur);
    if constexpr (SP2) {
        PG8_STAGE(PG8_SB(0, 0), cB, voffB); PG8_STAGE(PG8_SB(0, 1), cB + hstepB, voffB); PG8_STAGE(PG8_SA(0, 0), cA, voffA); PG8_STAGE(PG8_SA(0, 1), cA + hstepA, voffA);
        if (wr == 1) PG8_BAR;
        PG8_WAIT_V(2); PG8_BAR;
        PG8_STAGE(PG8_SB(1, 0), cB + kstep, voffB); PG8_STAGE(PG8_SA(1, 0), cA + kstep, voffA); PG8_STAGE(PG8_SB(1, 1), cB + hstepB + kstep, voffB);
        PG8_WAIT_V(6); PG8_BAR;
    } else {
        PG8_STAGE(PG8_SB(0, 0), cB, voffB); PG8_STAGE(PG8_SA(0, 0), cA, voffA); PG8_STAGE(PG8_SB(0, 1), cB + hstepB, voffB); PG8_STAGE(PG8_SA(0, 1), cA + hstepA, voffA);
        if (wr == 1) PG8_BAR;
        PG8_WAIT_V(4); PG8_BAR;
        PG8_STAGE(PG8_SB(1, 0), cB + kstep, voffB); PG8_STAGE(PG8_SA(1, 0), cA + kstep, voffA); PG8_STAGE(PG8_SB(1, 1), cB + hstepB + kstep, voffB);
        PG8_WAIT_V(6); PG8_BAR;
    }
    for (;;) {
        const bool has_next = S.next(ui + 1, nxt);
        const char* nA = has_next ? (const char*)g.A + (size_t)nxt.pm * tstepA : cA; const char* nB = has_next ? (const char*)g.Bt + (size_t)nxt.pn * tstepB : cB;
#pragma nounroll
        for (int t = 0; t < nt; t += 2) {
            const bool last = (t == nt - 2);
            const char* a1 = cA + (size_t)(t + 1) * kstep;
            const char* a2 = last ? nA : cA + (size_t)(t + 2) * kstep; const char* b2 = last ? nB : cB + (size_t)(t + 2) * kstep;
            const char* a3 = a2 + kstep; const char* b3 = b2 + kstep;
            if (last && has_next) S.a_ready(nxt);
            if constexpr (SP2) {
            PG8_LDB(B0, 0, 0); PG8_LDB(B1, 0, 1); PG8_SCHED; PG8_LDA(At, 0, 0); PG8_STAGE(PG8_SA(1, 1), a1 + hstepA, voffA);
            PG8_WAIT_V(8); PG8_WAIT_L(0); PG8_BAR; PG8_MMA(0, 0, At, B0); PG8_MMA(0, 1, At, B1); PG8_BAR; PG8_SCHED;
            PG8_LDA(At, 0, 1); PG8_STAGE(PG8_SB(0, 0), b2, voffB); PG8_STAGE(PG8_SB(0, 1), b2 + hstepB, voffB); PG8_STAGE(PG8_SA(0, 0), a2, voffA);
            PG8_WAIT_V(8); PG8_WAIT_L(0); PG8_BAR; PG8_MMA(1, 0, At, B0); PG8_MMA(1, 1, At, B1); PG8_BAR; PG8_SCHED;
            PG8_LDB(B0, 1, 0); PG8_LDB(B1, 1, 1); PG8_SCHED; PG8_LDA(At, 1, 0); PG8_STAGE(PG8_SA(0, 1), a2 + hstepA, voffA);
            PG8_WAIT_V(8); PG8_WAIT_L(0); PG8_BAR; PG8_MMA(0, 0, At, B0); PG8_MMA(0, 1, At, B1); PG8_BAR; PG8_SCHED;
            PG8_LDA(At, 1, 1); PG8_STAGE(PG8_SB(1, 0), b3, voffB); PG8_STAGE(PG8_SB(1, 1), b3 + hstepB, voffB); PG8_STAGE(PG8_SA(1, 0), a3, voffA);
            PG8_WAIT_V(8); PG8_WAIT_L(0); PG8_BAR; PG8_MMA(1, 0, At, B0); PG8_MMA(1, 1, At, B1); PG8_BAR; PG8_SCHED;
            } else {
            PG8_LDB(B0, 0, 0); PG8_SCHED; PG8_LDA(At, 0, 0); PG8_STAGE(PG8_SA(1, 1), a1 + hstepA, voffA);
            PG8_WAIT_L(8); PG8_BAR; PG8_WAIT_L(0); PG8_MMA(0, 0, At, B0); PG8_BAR; PG8_SCHED;
            PG8_LDB(B1, 0, 1); PG8_STAGE(PG8_SB(0, 0), b2, voffB);
            PG8_BAR; PG8_WAIT_L(0); PG8_MMA(0, 1, At, B1); PG8_BAR;
            PG8_LDA(At, 0, 1); PG8_STAGE(PG8_SA(0, 0), a2, voffA);
            PG8_BAR; PG8_WAIT_L(0); PG8_MMA(1, 0, At, B0); PG8_BAR; PG8_SCHED;
            PG8_STAGE(PG8_SB(0, 1), b2 + hstepB, voffB);
            PG8_WAIT_V(6); PG8_BAR; PG8_MMA(1, 1, At, B1); PG8_BAR;
            PG8_LDB(B0, 1, 0); PG8_SCHED; PG8_LDA(At, 1, 0); PG8_STAGE(PG8_SA(0, 1), a2 + hstepA, voffA);
            PG8_WAIT_L(8); PG8_BAR; PG8_WAIT_L(0); PG8_MMA(0, 0, At, B0); PG8_BAR; PG8_SCHED;
            PG8_LDB(B1, 1, 1); PG8_STAGE(PG8_SB(1, 0), b3, voffB);
            PG8_BAR; PG8_WAIT_L(0); PG8_MMA(0, 1, At, B1); PG8_BAR;
            PG8_LDA(At, 1, 1); PG8_STAGE(PG8_SA(1, 0), a3, voffA);
            PG8_BAR; PG8_WAIT_L(0); PG8_MMA(1, 0, At, B0); PG8_BAR; PG8_SCHED;
            PG8_STAGE(PG8_SB(1, 1), b3 + hstepB, voffB);
            PG8_WAIT_V(6); PG8_BAR; PG8_MMA(1, 1, At, B1); PG8_BAR;
            }
        }
        if constexpr (ALIGN_EPI) { if (wr == 0) PG8_BAR; }
        if constexpr (!Epi::AFTER_DRAIN) { E(acc, cur, wr, wc, fr, fq); S.done(cur); }
        if (!has_next) break;
#pragma unroll
        for (int a = 0; a < 2; ++a)
#pragma unroll
            for (int b = 0; b < 2; ++b)
#pragma unroll
                for (int m = 0; m < 4; ++m)
#pragma unroll
                    for (int n = 0; n < 2; ++n) acc[a][b][m][n] = (f32x4){0.f, 0.f, 0.f, 0.f};
        cur = nxt; cA = nA; cB = nB; ++ui;
        if constexpr (ALIGN_EPI) { if (wr == 1) PG8_BAR; }
    }
    PG8_WAIT_V(0);
    if constexpr (!ALIGN_EPI) { if (wr == 0) PG8_BAR; }
    PG8_BAR;
    if constexpr (Epi::AFTER_DRAIN) { E.fused(acc, cur, wr, wc, fr, fq, lds, wid, lane); S.done(cur); }
#undef PG8_SA
#undef PG8_SB
#undef PG8_STAGE
#undef PG8_LDA
#undef PG8_LDB
#undef PG8_MMA
#undef PG8_WAIT_V
#undef PG8_WAIT_L
#undef PG8_BAR
#undef PG8_SCHED
}
}
constexpr int NWAVES = 8;
#ifndef MK_N_LAUNCHES
#define MK_N_LAUNCHES 1
#endif
constexpr int N_PHASES = 13;
constexpr int N_LAUNCHES = MK_N_LAUNCHES;
constexpr int BATCH = 16, SEQ = 2048, DM = 1024, M = BATCH * SEQ, FF = 4096;
constexpr int A_IN = 2120, A_INP = 2304, B_IN = 672, B_INP = 768, QUP = 1536, KVUP = 2048, QLORA = 384, KVLORA = 256;
constexpr size_t MiB = 1u << 20;
constexpr size_t WS_CTL = 0, CTL_ZERO_BYTES = 64 * 1024;
constexpr size_t WS_WAIN = 1 * MiB, WS_WAOUT = 6 * MiB, WS_WUP0 = 8 * MiB, WS_WUP1 = 16 * MiB, WS_WDN0 = 24 * MiB, WS_WDN1 = 32 * MiB;
constexpr size_t WS_WBIN = 40 * MiB, WS_WQUP = 42 * MiB, WS_WKVUP = 44 * MiB, WS_WBOUT = 46 * MiB;
constexpr size_t WS_COSA = 48 * MiB, WS_SINA = 49 * MiB, WS_COSB = 50 * MiB, WS_SINB = 52 * MiB;
constexpr size_t WS_SS = 54 * MiB, WS_SSB = 56 * MiB, WS_WI = 59 * MiB;
constexpr size_t WS_XB = 64 * MiB;
constexpr size_t WS_BIG = 128 * MiB;
constexpr size_t WS_PA = WS_BIG, WS_OA = WS_BIG + 144 * MiB;
constexpr size_t WS_H = WS_BIG;
constexpr size_t WS_CB = WS_BIG, WS_QB = WS_BIG + 48 * MiB, WS_OB = WS_BIG + 144 * MiB;
constexpr size_t WS_KVB = 384 * MiB, WS_END = 512 * MiB;
static_assert(WS_WAIN + (size_t)A_INP * DM * 2 <= WS_WAOUT && WS_WBIN + (size_t)B_INP * DM * 2 <= WS_WQUP && WS_WQUP + (size_t)QUP * QLORA * 2 <= WS_WKVUP && WS_WKVUP + (size_t)KVUP * KVLORA * 2 <= WS_WBOUT, "weights map");
static_assert(WS_SSB + (size_t)M * 24 * 4 <= WS_WI && WS_WI + (size_t)M * 8 * 4 <= WS_XB && WS_PA + (size_t)M * A_INP * 2 <= WS_OA && WS_OA + (size_t)M * DM * 2 <= WS_KVB && WS_QB + (size_t)M * QUP * 2 <= WS_OB, "activation map");
constexpr int CW_BAR = 1024;
constexpr int RING_BYTES = 131072, LDSCTL_OFF = RING_BYTES, MISC_OFF = LDSCTL_OFF + 320, LDS_BYTES = 147456;
constexpr float IDX_WSCALE = 0.044194173824159216f;
constexpr float SM_THR = 4.0f;
constexpr float QSCALE_A = 0.125f * 1.4426950408889634f;
constexpr float QSCALE_B = 0.10206207261596577f * 1.4426950408889634f;

#define GAS __attribute__((address_space(1)))
#define LAS __attribute__((address_space(3)))
typedef unsigned short bf16;
typedef unsigned v4u __attribute__((ext_vector_type(4)));
typedef float f32x4 __attribute__((ext_vector_type(4)));
typedef short bf16x8 __attribute__((ext_vector_type(8)));
typedef GAS unsigned gu32;
typedef GAS unsigned long long gu64;
#define RLX_AGENT __ATOMIC_RELAXED, __HIP_MEMORY_SCOPE_AGENT
#define LDS_WAIT() asm volatile("s_waitcnt lgkmcnt(0)" ::: "memory")
#define VM_WAIT() asm volatile("s_waitcnt vmcnt(0)" ::: "memory")
__device__ __forceinline__ unsigned long long rt() { return __builtin_amdgcn_s_memrealtime(); }
__device__ __forceinline__ unsigned f2bf(float f) { unsigned u = __builtin_bit_cast(unsigned, f); return (u + 0x7fffu + ((u >> 16) & 1u)) >> 16; }
__device__ __forceinline__ unsigned pk2(float lo, float hi) { return f2bf(lo) | (f2bf(hi) << 16); }

#define XB_TMO      128
#define XB_XCNT(j)  (256  + 64 * (j))
#define XB_XSUB(j)  (1280 + 64 * (j))
#define XB_XGEN(j)  (2304 + 64 * (j))
#define XB_TOP      3328
#define XB_TOPGEN   3392
#define XCD_BAR_WORDS 3456
#define XB_SPIN_CAP (1u << 18)

__device__ __forceinline__ unsigned xb_ld(unsigned* p)              { return __hip_atomic_load(p, __ATOMIC_RELAXED, __HIP_MEMORY_SCOPE_AGENT); }
__device__ __forceinline__ unsigned xb_add(unsigned* p, unsigned v) { return __hip_atomic_fetch_add(p, v, __ATOMIC_RELAXED, __HIP_MEMORY_SCOPE_AGENT); }
__device__ __forceinline__ unsigned xb_xcc_id() { return (unsigned)__builtin_amdgcn_s_getreg((3 << 11) | 20) & 0xFu; }
#define XB_SPIN(cond, bar) do { unsigned _sp = 0; while (cond) { __builtin_amdgcn_s_sleep(1); \
    if ((++_sp & 255u) == 0u) { if (xb_ld(&(bar)[XB_TMO])) break; if (_sp > XB_SPIN_CAP) { atomicAdd(&(bar)[XB_TMO], 1u); break; } } } } while (0)

struct XcdBarrier {
    unsigned* bar; unsigned x;
    volatile LAS unsigned* st;
};

__device__ __forceinline__ XcdBarrier xcd_barrier_post(unsigned* bar, volatile LAS unsigned* st) {
    XcdBarrier b; b.bar = bar; b.x = xb_xcc_id(); b.st = st;
    if (threadIdx.x == 0) (void)xb_add(&bar[XB_XCNT(b.x)], 1u);
    return b;
}
__device__ __forceinline__ void xcd_barrier_complete(unsigned* bar, unsigned x, unsigned& nloc, unsigned& nx) {
    const unsigned G = gridDim.x * gridDim.y * gridDim.z;
    unsigned sum, cnt, mine, sp = 0u;
    for (;;) {
        sum = 0u; cnt = 0u; mine = 0u;
#pragma unroll
        for (unsigned j = 0; j < 16; ++j) { const unsigned c = xb_ld(&bar[XB_XCNT(j)]); sum += c; cnt += (c > 0u) ? 1u : 0u; mine = (j == x) ? c : mine; }
        if (sum == G) break;
        __builtin_amdgcn_s_sleep(1);
        if ((++sp & 255u) == 0u) { if (xb_ld(&bar[XB_TMO])) break; if (sp > XB_SPIN_CAP) { atomicAdd(&bar[XB_TMO], 1u); break; } }
    }
    nloc = mine > 0u ? mine : 1u; nx = cnt > 0u ? cnt : 1u;
}

__device__ __forceinline__ void xcd_barrier(const XcdBarrier& b) {
    asm volatile("s_waitcnt vmcnt(0)" ::: "memory");
    __syncthreads();
    if (threadIdx.x == 0) {
        unsigned* bar = b.bar;
        __builtin_amdgcn_s_waitcnt(0);
        unsigned nloc = b.st[0], nx = b.st[1];
        if (nloc == 0u) { xcd_barrier_complete(bar, b.x, nloc, nx); b.st[0] = nloc; b.st[1] = nx; }
        const unsigned old = xb_add(&bar[XB_XSUB(b.x)], 1u);
        const unsigned gen = old / nloc;
        if (old + 1u == (gen + 1u) * nloc) {
            __builtin_amdgcn_fence(__ATOMIC_RELEASE, "agent");
            asm volatile("s_waitcnt vmcnt(0)" ::: "memory");
            const unsigned og = xb_add(&bar[XB_TOP], 1u);
            const unsigned tg = og / nx;
            if (og + 1u == (tg + 1u) * nx) xb_add(&bar[XB_TOPGEN], 1u);
            else XB_SPIN(xb_ld(&bar[XB_TOPGEN]) == tg, bar);
            __builtin_amdgcn_fence(__ATOMIC_ACQUIRE, "agent");
            xb_add(&bar[XB_XGEN(b.x)], 1u);
            asm volatile("s_waitcnt vmcnt(0)" ::: "memory");
        } else {
            XB_SPIN(xb_ld(&bar[XB_XGEN(b.x)]) == gen, bar);
            __builtin_amdgcn_fence(__ATOMIC_ACQUIRE, "agent");
            asm volatile("s_waitcnt vmcnt(0)" ::: "memory");
        }
    }
    __syncthreads();
}
using pg8::u32x4; using pg8::u32x2;
struct Frame {
    LAS unsigned char* lds;
    volatile LAS unsigned* MISC;
    gu32* ctl;
    int tid, lane, wave, G;
};
__device__ __forceinline__ float wave_sum(float v) {
#pragma unroll
    for (int o = 1; o < 64; o <<= 1) v += __shfl_xor(v, o);
    return v;
}
typedef _Float16 half_t;
__device__ __forceinline__ unsigned short f2h(float f) { half_t h = (half_t)f; return __builtin_bit_cast(unsigned short, h); }
__device__ __forceinline__ float h2f(unsigned short u) { return (float)__builtin_bit_cast(half_t, u); }
__device__ __forceinline__ float bf2f(unsigned short u) { return __builtin_bit_cast(float, (unsigned)u << 16); }

template <bool F16>
__device__ __forceinline__ void p0_transpose_item(const float* W, int K, int N, const float* gain, bf16* WT, LAS float* scr, int item, int lane) {
    const int nblk = (N + 31) / 32, kb = item / nblk, nb = item % nblk, k0 = 64 * kb, n0 = 32 * nb;
#pragma unroll 8
    for (int i = 0; i < 32; ++i) { const int kk = 2 * i + (lane >> 5); const int n = n0 + (lane & 31);
        float v = (n < N) ? W[(size_t)(k0 + kk) * N + n] : 0.f; if (gain) v *= gain[k0 + kk]; scr[kk * 33 + (lane & 31)] = v; }
    LDS_WAIT(); asm volatile("" ::: "memory");
    const int c = lane & 7;
#pragma unroll
    for (int j = 0; j < 4; ++j) { const int n = (lane >> 3) + 8 * j; const LAS float* s = scr + (8 * c) * 33 + n;
        v4u o;
        if (F16) { o.x = (unsigned)f2h(s[0 * 33]) | ((unsigned)f2h(s[1 * 33]) << 16); o.y = (unsigned)f2h(s[2 * 33]) | ((unsigned)f2h(s[3 * 33]) << 16);
                   o.z = (unsigned)f2h(s[4 * 33]) | ((unsigned)f2h(s[5 * 33]) << 16); o.w = (unsigned)f2h(s[6 * 33]) | ((unsigned)f2h(s[7 * 33]) << 16); }
        else { o.x = pk2(s[0 * 33], s[1 * 33]); o.y = pk2(s[2 * 33], s[3 * 33]); o.z = pk2(s[4 * 33], s[5 * 33]); o.w = pk2(s[6 * 33], s[7 * 33]); }
        *(GAS v4u*)(WT + (size_t)(n0 + n) * K + k0 + 8 * c) = o; }
    LDS_WAIT(); asm volatile("" ::: "memory");
}
struct Args { const void* in[15]; float* out; unsigned char* ws; float inv_a[8]; float inv_b[16]; int ph_lo, ph_hi; };

__device__ __forceinline__ void p0_prologue(Frame& F, const Args& A) {
    unsigned char* ws = A.ws;
    LAS float* scr = (LAS float*)(F.lds + F.wave * 16384);
    const int gw = blockIdx.x * NWAVES + F.wave, NGW = F.G * NWAVES, lane = F.lane;
    const float* attn_norm = (const float*)A.in[2]; const float* mlp_norm = (const float*)A.in[3];
    constexpr int I_AIN = 16 * 67, I_AOUT = 16 * 32, I_UP = 16 * 128, I_DN = 64 * 32, I_BIN = 16 * 21, I_QUP = 6 * 48, I_KVUP = 4 * 64, I_BOUT = 16 * 32;
    constexpr int NITEMS = I_AIN + I_AOUT + 2 * I_UP + 2 * I_DN + I_BIN + I_QUP + I_KVUP + I_BOUT;
    for (int it = gw; it < NITEMS; it += NGW) {
        int r = it;
        if (r < I_AIN) { p0_transpose_item<true>((const float*)A.in[4], 1024, A_IN, attn_norm, (bf16*)(ws + WS_WAIN), scr, r, lane); continue; } r -= I_AIN;
        if (r < I_AOUT) { p0_transpose_item<false>((const float*)A.in[5], 1024, 1024, nullptr, (bf16*)(ws + WS_WAOUT), scr, r, lane); continue; } r -= I_AOUT;
        if (r < I_UP) { p0_transpose_item<false>((const float*)A.in[12], 1024, 4096, mlp_norm, (bf16*)(ws + WS_WUP0), scr, r, lane); continue; } r -= I_UP;
        if (r < I_UP) { p0_transpose_item<false>((const float*)A.in[12] + (size_t)1024 * 4096, 1024, 4096, mlp_norm + 1024, (bf16*)(ws + WS_WUP1), scr, r, lane); continue; } r -= I_UP;
        if (r < I_DN) { p0_transpose_item<false>((const float*)A.in[13], 4096, 1024, nullptr, (bf16*)(ws + WS_WDN0), scr, r, lane); continue; } r -= I_DN;
        if (r < I_DN) { p0_transpose_item<false>((const float*)A.in[13] + (size_t)4096 * 1024, 4096, 1024, nullptr, (bf16*)(ws + WS_WDN1), scr, r, lane); continue; } r -= I_DN;
        if (r < I_BIN) { p0_transpose_item<false>((const float*)A.in[6], 1024, B_IN, attn_norm + 1024, (bf16*)(ws + WS_WBIN), scr, r, lane); continue; } r -= I_BIN;
        if (r < I_QUP) { p0_transpose_item<false>((const float*)A.in[9], QLORA, QUP, (const float*)A.in[7], (bf16*)(ws + WS_WQUP), scr, r, lane); continue; } r -= I_QUP;
        if (r < I_KVUP) { p0_transpose_item<false>((const float*)A.in[10], KVLORA, KVUP, (const float*)A.in[8], (bf16*)(ws + WS_WKVUP), scr, r, lane); continue; } r -= I_KVUP;
        p0_transpose_item<false>((const float*)A.in[11], 1024, 1024, nullptr, (bf16*)(ws + WS_WBOUT), scr, r, lane);
    }
    {   const int gt = gw * 64 + lane, NT = NGW * 64;
        GAS v4u* z1 = (GAS v4u*)(ws + WS_WAIN + (size_t)2144 * 1024 * 2); const int n1 = (A_INP - 2144) * 1024 * 2 / 16;
        for (int i = gt; i < n1; i += NT) z1[i] = (v4u){0u, 0u, 0u, 0u};
        GAS v4u* z2 = (GAS v4u*)(ws + WS_WBIN + (size_t)B_IN * 1024 * 2); const int n2 = (B_INP - B_IN) * 1024 * 2 / 16;
        for (int i = gt; i < n2; i += NT) z2[i] = (v4u){0u, 0u, 0u, 0u};
        const int* pos = (const int*)A.in[1];
        float* cA = (float*)(ws + WS_COSA); float* sA = (float*)(ws + WS_SINA); float* cB = (float*)(ws + WS_COSB); float* sB = (float*)(ws + WS_SINB);
        for (int i = gt; i < M * 8; i += NT) { const float ang = (float)pos[i >> 3] * A.inv_a[i & 7]; double rev = (double)ang * 0.15915494309189535; rev -= __builtin_rint(rev); const float fr = (float)rev;
            cA[i] = __builtin_amdgcn_cosf(fr); sA[i] = __builtin_amdgcn_sinf(fr); }
        for (int i = gt; i < M * 16; i += NT) { const float ang = (float)pos[i >> 4] * A.inv_b[i & 15]; double rev = (double)ang * 0.15915494309189535; rev -= __builtin_rint(rev); const float fr = (float)rev;
            cB[i] = __builtin_amdgcn_cosf(fr); sB[i] = __builtin_amdgcn_sinf(fr); }
    }
    const float* x = (const float*)A.in[0]; bf16* XB = (bf16*)(ws + WS_XB); float* SS = (float*)(ws + WS_SS);
    for (int m0 = gw; m0 < M; m0 += 2 * NGW) {
        f32x4 v[2][4]; float sq[2];
#pragma unroll
        for (int e = 0; e < 2; ++e) { const int m = (m0 + e * NGW < M) ? m0 + e * NGW : m0; const GAS f32x4* xr = (const GAS f32x4*)(x + (size_t)m * DM) + lane;
#pragma unroll
            for (int j = 0; j < 4; ++j) v[e][j] = xr[64 * j]; }
#pragma unroll
        for (int e = 0; e < 2; ++e) { float s = 0.f;
#pragma unroll
            for (int j = 0; j < 4; ++j) s += (v[e][j].x * v[e][j].x + v[e][j].y * v[e][j].y) + (v[e][j].z * v[e][j].z + v[e][j].w * v[e][j].w);
            sq[e] = wave_sum(s); }
#pragma unroll
        for (int e = 0; e < 2; ++e) { const int m = m0 + e * NGW; if (m < M) {
            GAS unsigned long long* o8 = (GAS unsigned long long*)(XB + (size_t)m * DM) + lane;
#pragma unroll
            for (int j = 0; j < 4; ++j) o8[64 * j] = (unsigned long long)((unsigned)f2h(v[e][j].x) | ((unsigned)f2h(v[e][j].y) << 16)) | ((unsigned long long)((unsigned)f2h(v[e][j].z) | ((unsigned)f2h(v[e][j].w) << 16)) << 32);
            if (lane < 16) SS[(size_t)m * 16 + lane] = (lane == 0) ? sq[e] : 0.f; } }
    }
}
__device__ __forceinline__ void p12_final_norm(Frame& F, const Args& A) {
    const int gw = blockIdx.x * NWAVES + F.wave, NGW = F.G * NWAVES, lane = F.lane;
    const float* g = (const float*)A.in[14]; const float* SS = (const float*)(A.ws + WS_SS); const bf16* XB = (const bf16*)(A.ws + WS_XB);
    f32x4 gv[4];
#pragma unroll
    for (int j = 0; j < 2; ++j) { gv[2 * j] = *(const GAS f32x4*)(g + 512 * j + 8 * lane); gv[2 * j + 1] = *(const GAS f32x4*)(g + 512 * j + 8 * lane + 4); }
    for (int m0 = gw; m0 < M; m0 += 2 * NGW) {
        v4u w[2][2];
#pragma unroll
        for (int e = 0; e < 2; ++e) { const int m = (m0 + e * NGW < M) ? m0 + e * NGW : m0;
#pragma unroll
            for (int j = 0; j < 2; ++j) w[e][j] = *(const GAS v4u*)(XB + (size_t)m * DM + 512 * j + 8 * lane); }
#pragma unroll
        for (int e = 0; e < 2; ++e) { const int m = m0 + e * NGW; if (m < M) {
            const float rs = pg8::rstd_from(SS + (size_t)m * 16, 4, 1.0f / 1024.0f);
#pragma unroll
            for (int j = 0; j < 2; ++j) { f32x4 a, b; pg8::unpack8(w[e][j], false, a, b);
                GAS f32x4* o = (GAS f32x4*)(A.out + (size_t)m * DM + 512 * j + 8 * lane); o[0] = a * rs * gv[2 * j]; o[1] = b * rs * gv[2 * j + 1]; } } }
    }
}
namespace dsa {
typedef float f32x16 __attribute__((ext_vector_type(16)));
typedef _Float16 f16x8 __attribute__((ext_vector_type(8)));
typedef short s16x4 __attribute__((ext_vector_type(4)));
constexpr int KP = 144;
constexpr int MP = 65;
constexpr int LDS_MASK = 0, LDS_KV = 16896, KBYTES = 64 * KP, KV1 = KBYTES + 8192, KVBUF2 = 2 * KV1, LDS_Q = LDS_KV + 2 * KVBUF2, LDS_KI = LDS_KV, KIBUF = 256 * KP;
static_assert(64 * MP * 4 <= LDS_KV && LDS_Q + 8 * 4096 <= RING_BYTES && LDS_KI + 2 * KIBUF <= RING_BYTES, "dsa LDS map");
__device__ __forceinline__ unsigned sortable(float f) { const unsigned u = __builtin_bit_cast(unsigned, f); return (u & 0x80000000u) ? ~u : (u | 0x80000000u); }
__device__ __forceinline__ float xmax32(float m) { auto rr = __builtin_amdgcn_permlane32_swap(__float_as_uint(m), __float_as_uint(m), false, false); return fmaxf(__uint_as_float(rr[0]), __uint_as_float(rr[1])); }
__device__ __forceinline__ unsigned half_sum(unsigned v) {
#pragma unroll
    for (int o = 16; o >= 1; o >>= 1) v += (unsigned)__shfl_xor((int)v, o);
    return v;
}
__device__ __forceinline__ void cnt4(unsigned& cnt, unsigned a, unsigned b, unsigned c, unsigned d, unsigned cand) {
    unsigned long long m0, m1, m2, m3, co;
    asm volatile("v_cmp_ge_u32_e64 %1, %6, %10\n\tv_cmp_ge_u32_e64 %2, %7, %10\n\tv_cmp_ge_u32_e64 %3, %8, %10\n\tv_cmp_ge_u32_e64 %4, %9, %10\n\t"
                 "v_addc_co_u32_e64 %0, %5, 0, %0, %1\n\tv_addc_co_u32_e64 %0, %5, 0, %0, %2\n\tv_addc_co_u32_e64 %0, %5, 0, %0, %3\n\tv_addc_co_u32_e64 %0, %5, 0, %0, %4\n\ts_nop 1"
                 : "+v"(cnt), "=&s"(m0), "=&s"(m1), "=&s"(m2), "=&s"(m3), "=&s"(co) : "v"(a), "v"(b), "v"(c), "v"(d), "v"(cand));
}
__device__ __forceinline__ void index_select(LAS unsigned char* lds, LAS unsigned* maskQ, const bf16* PA, const float* WI, unsigned* scr, size_t row0, int qp0, int mp0, int nkt, int tid, int wid, int lane) {
    const int r32 = lane & 31, hh = lane >> 5;
    const int q0 = qp0 + 4 * wid, mrow0 = mp0 + 4 * wid;
    const int a_ = r32 & 3, hic = (r32 >> 2) & 1, bq = r32 >> 3; const int headA = a_ + 4 * (bq & 1), tlocA = 2 * hic + (bq >> 1);
    const bf16* ap = PA + (row0 + q0 + tlocA) * A_INP + 1536 + headA * 64 + 8 * hh;
    f16x8 qa[4];
#pragma unroll
    for (int ks = 0; ks < 4; ++ks) qa[ks] = *(const f16x8*)(ap + 16 * ks);
    float w[2][8];
#pragma unroll
    for (int tq = 0; tq < 2; ++tq) { const float* wq = WI + (row0 + q0 + 2 * hh + tq) * 8; const f32x4 wa = *(const f32x4*)wq, wb = *(const f32x4*)(wq + 4);
      w[tq][0] = wa[0]; w[tq][1] = wa[1]; w[tq][2] = wa[2]; w[tq][3] = wa[3]; w[tq][4] = wb[0]; w[tq][5] = wb[1]; w[tq][6] = wb[2]; w[tq][7] = wb[3]; }
    const int nch = (nkt + 7) >> 3;
    const int skey = tid >> 3, sc8 = tid & 7;
    const bf16* spc = PA + (row0 + skey) * A_INP + 2048 + sc8 * 8;
    v4u st[4];
#pragma unroll
    for (int i = 0; i < 4; ++i) st[i] = *(const v4u*)(spc + (size_t)(64 * i) * A_INP);
    LAS unsigned char* const stw = lds + LDS_KI + skey * KP + sc8 * 16;
    const LAS unsigned char* const krd = lds + LDS_KI + r32 * KP + hh * 16;
    unsigned* const scl = scr + lane;
    unsigned sc[64];
    __syncthreads();
#pragma unroll
    for (int ch = 0; ch < 8; ++ch) {
        if (ch < nch) {
#pragma unroll
            for (int i = 0; i < 4; ++i) *(LAS v4u*)(stw + (ch & 1) * KIBUF + 64 * i * KP) = st[i];
            if (ch + 1 < nch) {
                spc += (size_t)256 * A_INP; asm volatile("" : "+v"(spc));
#pragma unroll
                for (int i = 0; i < 4; ++i) st[i] = *(const v4u*)(spc + (size_t)(64 * i) * A_INP); }
            __syncthreads();
#pragma unroll
            for (int k = 0; k < 8; ++k) {
                const int kt = 8 * ch + k;
                if (kt < nkt) {
                    const LAS unsigned char* kq = krd + (ch & 1) * KIBUF + 32 * k * KP;
                    f32x16 c = {};
#pragma unroll
                    for (int ks = 0; ks < 4; ++ks) c = __builtin_amdgcn_mfma_f32_32x32x16_f16(qa[ks], *(const LAS f16x8*)(kq + 32 * ks), c, 0, 0, 0);
                    float acc0 = 0.f, acc1 = 0.f;
#pragma unroll
                    for (int hd = 0; hd < 8; ++hd) { acc0 = fmaf(w[0][hd], fmaxf(c[hd], 0.f), acc0); acc1 = fmaf(w[1][hd], fmaxf(c[hd + 8], 0.f), acc1); }
                    unsigned key = sortable(acc0); asm volatile("" : "+v"(key)); sc[kt] = key;
                    scl[kt * 64] = sortable(acc1);
                } else { sc[kt] = 0u; }
                __builtin_amdgcn_sched_barrier(0);
            }
        } else {
#pragma unroll
            for (int k = 0; k < 8; ++k) sc[8 * ch + k] = 0u;
        }
    }
#pragma unroll 1
  for (int tq = 0; tq < 2; ++tq) {
    if (tq == 1) {
#pragma unroll
        for (int kt = 0; kt < 64; ++kt) { if (kt < nkt) sc[kt] = scl[kt * 64]; }
    }
    unsigned pre_lo = 0u, pre_hi = 0u, cge_lo = (unsigned)nkt * 32u, cge_hi = cge_lo; bool done_lo = false, done_hi = false;
    for (int bit = 31; bit >= 0; --bit) {
        const unsigned bm = 1u << bit;
        const unsigned cand = hh ? (pre_hi | bm) : (pre_lo | bm);
        unsigned cnt = 0u;
#pragma unroll
        for (int blk = 0; blk < 8; ++blk) if (nkt > 8 * blk) {
            cnt4(cnt, sc[8 * blk + 0], sc[8 * blk + 1], sc[8 * blk + 2], sc[8 * blk + 3], cand);
            cnt4(cnt, sc[8 * blk + 4], sc[8 * blk + 5], sc[8 * blk + 6], sc[8 * blk + 7], cand); }
        int v = (int)cnt;
        v += __builtin_amdgcn_update_dpp(0, v, 0xB1, 0xf, 0xf, true);
        v += __builtin_amdgcn_update_dpp(0, v, 0x4E, 0xf, 0xf, true);
        v += __builtin_amdgcn_update_dpp(0, v, 0x141, 0xf, 0xf, true);
        v += __builtin_amdgcn_update_dpp(0, v, 0x140, 0xf, 0xf, true);
        const unsigned n_lo = (unsigned)(__builtin_amdgcn_readlane(v, 0) + __builtin_amdgcn_readlane(v, 16));
        const unsigned n_hi = (unsigned)(__builtin_amdgcn_readlane(v, 32) + __builtin_amdgcn_readlane(v, 48));
        if (!done_lo && n_lo >= 256u) { pre_lo |= bm; cge_lo = n_lo; done_lo = (n_lo == 256u); }
        if (!done_hi && n_hi >= 256u) { pre_hi |= bm; cge_hi = n_hi; done_hi = (n_hi == 256u); }
        if (done_lo && done_hi) break;
    }
    const unsigned pre = hh ? pre_hi : pre_lo, cge = hh ? cge_hi : cge_lo;
    int ktc = 64; bool le = true;
    if (__any(cge > 256u)) {
        unsigned cnt = 0u;
#pragma unroll
        for (int kt = 0; kt < 64; ++kt) cnt += (sc[kt] > pre) ? 1u : 0u;
        cnt = half_sum(cnt);
        const int need = 256 - (int)cnt;
        int run = 0;
#pragma unroll
        for (int kt = 0; kt < 64; ++kt) {
            const unsigned long long b0 = __ballot(sc[kt] == pre);
            unsigned h0 = hh ? (unsigned)(b0 >> 32) : (unsigned)b0;
            const int n0 = __popc(h0);
            if (cge > 256u && run < need && run + n0 >= need) { for (int i = run + 1; i < need; ++i) h0 &= h0 - 1u; ktc = kt; le = r32 <= (__ffs((int)h0) - 1); }
            run += n0;
        }
    }
    LAS unsigned* const mq = maskQ + (mrow0 + tq) * MP;
#pragma unroll
    for (int kt = 0; kt < 64; ++kt) {
        if (kt < nkt) {
            const bool e0 = (kt < ktc) || (kt == ktc && le);
            const unsigned long long b0 = __ballot(sc[kt] > pre || (sc[kt] == pre && e0));
            if (lane == 0) { mq[kt] = (unsigned)b0; mq[2 * MP + kt] = (unsigned)(b0 >> 32); }
        }
    }
  }
}
__device__ __forceinline__ void unit(LAS unsigned char* lds, const bf16* PA, const float* WI, bf16* OA, unsigned* scr_unit, int b, int qblk) {
    int tid_ = threadIdx.x; asm volatile("" : "+v"(tid_));
    const int tid = tid_, lane = tid & 63, r32 = lane & 31, hh = lane >> 5; const int wid = __builtin_amdgcn_readfirstlane(tid >> 6);
    const size_t row0 = (size_t)b * SEQ;
    const int nkt = 2 * (qblk + 1), nk64 = qblk + 1;
    LAS unsigned* maskQ = (LAS unsigned*)(lds + LDS_MASK);
    __syncthreads();
    if (qblk < 4) { for (int i = tid; i < 64 * MP; i += 512) maskQ[i] = 0xFFFFFFFFu; }
    else {
#pragma unroll 1
        for (int p = 0; p < 2; ++p) index_select(lds, maskQ, PA, WI, scr_unit + (size_t)(p * 8 + wid) * 4096, row0, qblk * 64 + 32 * p, 32 * p, nkt, tid, wid, lane);
    }
    const int qh = wid & 1, hp = (wid >> 1) & 1, gs = wid >> 2;
    const int qrow = qblk * 64 + 32 * qh + r32;
    const int skey = tid >> 3, sc8 = tid & 7;
    const unsigned kdst = LDS_KV + skey * KP + sc8 * 16, vdst = LDS_KV + KBYTES + (sc8 >> 2) * 4096 + (skey >> 3) * 512 + (skey & 7) * 64 + (sc8 & 3) * 16;
    const unsigned vb = (unsigned)(uintptr_t)(lds + LDS_KV + gs * KV1 + KBYTES) + ((lane >> 4) & 1) * 32 + (lane & 3) * 8 + (4 * hh + ((lane & 15) >> 2)) * 64;
    const LAS unsigned* mrow = maskQ + (32 * qh + r32) * MP;
#pragma unroll 1
    for (int gp = 0; gp < 2; ++gp) {
        const int hq0 = 4 * (2 * gp + gs) + 2 * hp;
        const bf16* qp = PA + (row0 + qrow) * A_INP + hq0 * 64 + 8 * hh;
        f16x8 qf[4];
        LAS unsigned char* const qpark = lds + LDS_Q + wid * 4096 + lane * 16;
        f16x8 q1t[4];
#pragma unroll
        for (int ks = 0; ks < 4; ++ks) { qf[ks] = *(const f16x8*)(qp + 16 * ks); q1t[ks] = *(const f16x8*)(qp + 64 + 16 * ks); }
        const bf16* kg = PA + (row0 + skey) * A_INP + 1024 + (2 * gp) * 64 + sc8 * 8;
        v4u kreg0 = *(const v4u*)kg, kreg1 = *(const v4u*)(kg + 64), vreg0 = *(const v4u*)(kg + 256), vreg1 = *(const v4u*)(kg + 320);
        f32x16 o00 = {}, o01 = {}, o10 = {}, o11 = {}; float mrun0 = -INFINITY, mrun1 = -INFINITY, lrun0 = 0.f, lrun1 = 0.f;
        __syncthreads();
#pragma unroll
        for (int ks = 0; ks < 4; ++ks) *(LAS f16x8*)(qpark + ks * 1024) = q1t[ks];
#pragma unroll 1
        for (int kt = 0; kt < nk64; ++kt) {
            const unsigned bo = (kt & 1) * KVBUF2;
            *(LAS v4u*)(lds + kdst + bo) = kreg0; *(LAS v4u*)(lds + kdst + bo + KV1) = kreg1; *(LAS v4u*)(lds + vdst + bo) = vreg0; *(LAS v4u*)(lds + vdst + bo + KV1) = vreg1;
            __syncthreads();
            const LAS unsigned char* kb = lds + LDS_KV + bo + gs * KV1;
            f32x16 p00 = {}, p01 = {}, p10 = {}, p11 = {};
#pragma unroll
            for (int ks = 0; ks < 4; ++ks) {
                const f16x8 k0 = *(const LAS f16x8*)(kb + r32 * KP + ks * 32 + hh * 16);
                const f16x8 k1 = *(const LAS f16x8*)(kb + (32 + r32) * KP + ks * 32 + hh * 16);
                const f16x8 q1 = *(const LAS f16x8*)(qpark + ks * 1024);
                p00 = __builtin_amdgcn_mfma_f32_32x32x16_f16(k0, qf[ks], p00, 0, 0, 0);
                p01 = __builtin_amdgcn_mfma_f32_32x32x16_f16(k1, qf[ks], p01, 0, 0, 0);
                p10 = __builtin_amdgcn_mfma_f32_32x32x16_f16(k0, q1, p10, 0, 0, 0);
                p11 = __builtin_amdgcn_mfma_f32_32x32x16_f16(k1, q1, p11, 0, 0, 0);
                if (ks == 1) __builtin_amdgcn_sched_barrier(0);
            }
            const int w0 = (int)(mrow[2 * kt] >> (4 * hh)), w1 = (int)(mrow[2 * kt + 1] >> (4 * hh));
            f16x8 pa0[4], pa1[4];
#define DSA_PKP(P, S, J) __builtin_bit_cast(unsigned, __builtin_amdgcn_cvt_pkrtz(P[8 * (S) + 2 * (J)], P[8 * (S) + 2 * (J) + 1]))
#define DSA_SOFTMAX(PA, PB, OA_, OB_, MRUN, LRUN, PAV) do { \
            float mx = fmaxf(PA[0], PB[0]); \
            _Pragma("unroll") for (int r = 1; r < 16; ++r) mx = fmaxf(fmaxf(mx, PA[r]), PB[r]); \
            mx = xmax32(mx); \
            float mn = MRUN;                                    \
            if (__any(mx > MRUN + SM_THR)) { mn = fmaxf(MRUN, mx); const float al = __builtin_amdgcn_exp2f(MRUN - mn); LRUN *= al; MRUN = mn; \
                _Pragma("unroll") for (int r = 0; r < 16; ++r) { OA_[r] *= al; OB_[r] *= al; } } \
            float ls = 0.f; \
            _Pragma("unroll") for (int r = 0; r < 16; ++r) { const int cr = (r & 3) + 8 * (r >> 2); \
                PA[r] = __builtin_bit_cast(float, __builtin_bit_cast(int, __builtin_amdgcn_exp2f(PA[r] - mn)) & __builtin_amdgcn_sbfe(w0, cr, 1)); \
                PB[r] = __builtin_bit_cast(float, __builtin_bit_cast(int, __builtin_amdgcn_exp2f(PB[r] - mn)) & __builtin_amdgcn_sbfe(w1, cr, 1)); \
                ls += PA[r] + PB[r]; } \
            LRUN += ls; \
            _Pragma("unroll") for (int s2 = 0; s2 < 2; ++s2) { u32x4 x; \
                x.x = DSA_PKP(PA, s2, 0); x.y = DSA_PKP(PA, s2, 1); x.z = DSA_PKP(PA, s2, 2); x.w = DSA_PKP(PA, s2, 3); PAV[s2] = __builtin_bit_cast(f16x8, x); \
                x.x = DSA_PKP(PB, s2, 0); x.y = DSA_PKP(PB, s2, 1); x.z = DSA_PKP(PB, s2, 2); x.w = DSA_PKP(PB, s2, 3); PAV[2 + s2] = __builtin_bit_cast(f16x8, x); } \
            __builtin_amdgcn_sched_barrier(0); } while (0)
            DSA_SOFTMAX(p00, p01, o00, o01, mrun0, lrun0, pa0);
            DSA_SOFTMAX(p10, p11, o10, o11, mrun1, lrun1, pa1);
#undef DSA_SOFTMAX
#undef DSA_PKP
            if (kt + 1 < nk64) { const bf16* kn = kg + (size_t)(kt + 1) * 64 * A_INP; kreg0 = *(const v4u*)kn; kreg1 = *(const v4u*)(kn + 64); vreg0 = *(const v4u*)(kn + 256); vreg1 = *(const v4u*)(kn + 320); }
            const unsigned vbt = vb + bo;
#pragma unroll
            for (int d0 = 0; d0 < 2; ++d0) {
                s16x4 lo[4], hi4[4];
#pragma unroll
                for (int ks = 0; ks < 4; ++ks) {
                    asm volatile("ds_read_b64_tr_b16 %0,%1 offset:%c2" : "=&v"(lo[ks]) : "v"(vbt), "i"(d0 * 4096 + ks * 1024) : "memory");
                    asm volatile("ds_read_b64_tr_b16 %0,%1 offset:%c2" : "=&v"(hi4[ks]) : "v"(vbt), "i"(d0 * 4096 + ks * 1024 + 512) : "memory"); }
                asm volatile("s_waitcnt lgkmcnt(0)" ::: "memory"); __builtin_amdgcn_sched_barrier(0);
#define DSA_PK(k) __builtin_bit_cast(f16x8, (bf16x8){lo[k][0], lo[k][1], lo[k][2], lo[k][3], hi4[k][0], hi4[k][1], hi4[k][2], hi4[k][3]})
                if (d0 == 0) {
#pragma unroll
                    for (int k = 0; k < 4; ++k) { o00 = __builtin_amdgcn_mfma_f32_32x32x16_f16(DSA_PK(k), pa0[k], o00, 0, 0, 0); o10 = __builtin_amdgcn_mfma_f32_32x32x16_f16(DSA_PK(k), pa1[k], o10, 0, 0, 0); }
                } else {
#pragma unroll
                    for (int k = 0; k < 4; ++k) { o01 = __builtin_amdgcn_mfma_f32_32x32x16_f16(DSA_PK(k), pa0[k], o01, 0, 0, 0); o11 = __builtin_amdgcn_mfma_f32_32x32x16_f16(DSA_PK(k), pa1[k], o11, 0, 0, 0); }
                }
#undef DSA_PK
            }
        }
        lrun0 += __shfl_xor(lrun0, 32); lrun1 += __shfl_xor(lrun1, 32);
        const float inv0 = 1.0f / lrun0, inv1 = 1.0f / lrun1;
        bf16* op = OA + (row0 + qrow) * DM + hq0 * 64 + 4 * hh;
#pragma unroll
        for (int gq = 0; gq < 4; ++gq) {
            u32x2 x;
            x.x = pg8::cvt_pk_bf16(o00[4 * gq] * inv0, o00[4 * gq + 1] * inv0); x.y = pg8::cvt_pk_bf16(o00[4 * gq + 2] * inv0, o00[4 * gq + 3] * inv0); *(u32x2*)(op + 8 * gq) = x;
            x.x = pg8::cvt_pk_bf16(o01[4 * gq] * inv0, o01[4 * gq + 1] * inv0); x.y = pg8::cvt_pk_bf16(o01[4 * gq + 2] * inv0, o01[4 * gq + 3] * inv0); *(u32x2*)(op + 32 + 8 * gq) = x;
            x.x = pg8::cvt_pk_bf16(o10[4 * gq] * inv1, o10[4 * gq + 1] * inv1); x.y = pg8::cvt_pk_bf16(o10[4 * gq + 2] * inv1, o10[4 * gq + 3] * inv1); *(u32x2*)(op + 64 + 8 * gq) = x;
            x.x = pg8::cvt_pk_bf16(o11[4 * gq] * inv1, o11[4 * gq + 1] * inv1); x.y = pg8::cvt_pk_bf16(o11[4 * gq + 2] * inv1, o11[4 * gq + 3] * inv1); *(u32x2*)(op + 96 + 8 * gq) = x;
        }
    }
}
__device__ __forceinline__ void phase(Frame& F, const Args& A) {
    const bf16* PA = (const bf16*)(A.ws + WS_PA); const float* WI = (const float*)(A.ws + WS_WI); bf16* OA = (bf16*)(A.ws + WS_OA);
    unsigned* scr = (unsigned*)(A.ws + WS_KVB);
    for (int u = blockIdx.x; u < 256; u += F.G) { const int b = u >> 4, j = u & 15; unit(F.lds, PA, WI, OA, scr + (size_t)(2 * u) * 65536, b, 31 - j); unit(F.lds, PA, WI, OA, scr + (size_t)(2 * u + 1) * 65536, b, j); }
}
}
namespace mla {
typedef float f32x16 __attribute__((ext_vector_type(16)));
typedef short s16x4 __attribute__((ext_vector_type(4)));
constexpr int KP = 208;
constexpr int LDS_K = 0, LDS_V = 64 * KP, BUFB = LDS_V + 8192, LDS_END = 2 * BUFB;
__device__ __forceinline__ float xmax32(float m) { auto rr = __builtin_amdgcn_permlane32_swap(__float_as_uint(m), __float_as_uint(m), false, false); return fmaxf(__uint_as_float(rr[0]), __uint_as_float(rr[1])); }
__device__ __forceinline__ void attn_unit(LAS unsigned char* lds, const bf16* QB, const bf16* KVB, const bf16* CB, bf16* OB, int b, int h, int qb) {
    const int tid = threadIdx.x, lane = tid & 63, r32 = lane & 31, hi = lane >> 5; const int wid = __builtin_amdgcn_readfirstlane(tid >> 6);
    const int c0 = qb * 4, cw = c0 + (wid >> 1), ntile = c0 + 4;
    const size_t row0 = (size_t)b * SEQ;
    const bf16* qp = QB + (row0 + (size_t)qb * 256 + wid * 32 + r32) * QUP + h * 96 + hi * 8;
    bf16x8 qf[6];
#pragma unroll
    for (int ks = 0; ks < 6; ++ks) qf[ks] = *(const bf16x8*)(qp + ks * 16);
    f32x16 o0 = {}, o1 = {}; float mrun = -INFINITY, lrun = 0.f;
    const unsigned vb = (unsigned)(uintptr_t)(lds + LDS_V) + ((lane >> 4) & 1) * 32 + (lane & 3) * 8 + (4 * hi + ((lane & 15) >> 2)) * 64;
    const int ka = tid / 12, kca = tid % 12, kb_ = (tid + 512) / 12, kcb = (tid + 512) % 12; const bool has2 = tid < 256;
    const bf16* ksa = (kca < 8) ? (KVB + (row0 + ka) * KVUP + h * 128 + kca * 8) : (CB + (row0 + ka) * B_INP + 640 + (kca - 8) * 8);
    const bf16* ksb = (kcb < 8) ? (KVB + (row0 + kb_) * KVUP + h * 128 + kcb * 8) : (CB + (row0 + kb_) * B_INP + 640 + (kcb - 8) * 8);
    const size_t stepa = (size_t)64 * ((kca < 8) ? KVUP : B_INP), stepb = (size_t)64 * ((kcb < 8) ? KVUP : B_INP);
    const bf16* vs = KVB + (row0 + (tid >> 3)) * KVUP + h * 128 + 64 + (tid & 7) * 8;
    const unsigned kda = LDS_K + ka * KP + kca * 16, kdb = LDS_K + kb_ * KP + kcb * 16;
    const unsigned vd = LDS_V + ((tid & 7) >> 2) * 4096 + ((tid >> 3) >> 3) * 512 + ((tid >> 3) & 7) * 64 + (tid & 3) * 16;
    v4u ra = *(const v4u*)ksa, rb = has2 ? *(const v4u*)ksb : (v4u){0u, 0u, 0u, 0u}, rv = *(const v4u*)vs;
    __syncthreads();
    for (int kt = 0; kt < ntile; ++kt) {
        const unsigned bo = (kt & 1) * BUFB;
        *(LAS v4u*)(lds + kda + bo) = ra; if (has2) *(LAS v4u*)(lds + kdb + bo) = rb; *(LAS v4u*)(lds + vd + bo) = rv;
        if (kt + 1 < ntile) { ra = *(const v4u*)(ksa + (size_t)(kt + 1) * stepa); if (has2) rb = *(const v4u*)(ksb + (size_t)(kt + 1) * stepb); rv = *(const v4u*)(vs + (size_t)(kt + 1) * 64 * KVUP); }
        __syncthreads();
        if (kt <= cw) {
            f32x16 p0 = {}, p1 = {};
#pragma unroll
            for (int ks = 0; ks < 6; ++ks) {
                const bf16x8 k0 = *(const LAS bf16x8*)(lds + bo + LDS_K + r32 * KP + ks * 32 + hi * 16);
                const bf16x8 k1 = *(const LAS bf16x8*)(lds + bo + LDS_K + (32 + r32) * KP + ks * 32 + hi * 16);
                p0 = __builtin_amdgcn_mfma_f32_32x32x16_bf16(k0, qf[ks], p0, 0, 0, 0);
                p1 = __builtin_amdgcn_mfma_f32_32x32x16_bf16(k1, qf[ks], p1, 0, 0, 0);
            }
            float mx = fmaxf(p0[0], p1[0]);
#pragma unroll
            for (int r = 1; r < 16; ++r) mx = fmaxf(mx, fmaxf(p0[r], p1[r]));
            mx = xmax32(mx);
            float mn = mrun;
            if (__any(mx > mrun + SM_THR)) { mn = fmaxf(mrun, mx); const float alpha = __builtin_amdgcn_exp2f(mrun - mn); lrun *= alpha; mrun = mn;
#pragma unroll
                for (int r = 0; r < 16; ++r) { o0[r] *= alpha; o1[r] *= alpha; } }
            float ls = 0.f;
#pragma unroll
            for (int r = 0; r < 16; ++r) { p0[r] = __builtin_amdgcn_exp2f(p0[r] - mn); p1[r] = __builtin_amdgcn_exp2f(p1[r] - mn); ls += p0[r] + p1[r]; }
            lrun += ls;
            const unsigned vbt = vb + bo;
            bf16x8 pa[4];
#pragma unroll
            for (int s = 0; s < 2; ++s) {
                u32x4 w0, w1;
                w0.x = pg8::cvt_pk_bf16(p0[8 * s + 0], p0[8 * s + 1]); w0.y = pg8::cvt_pk_bf16(p0[8 * s + 2], p0[8 * s + 3]); w0.z = pg8::cvt_pk_bf16(p0[8 * s + 4], p0[8 * s + 5]); w0.w = pg8::cvt_pk_bf16(p0[8 * s + 6], p0[8 * s + 7]);
                w1.x = pg8::cvt_pk_bf16(p1[8 * s + 0], p1[8 * s + 1]); w1.y = pg8::cvt_pk_bf16(p1[8 * s + 2], p1[8 * s + 3]); w1.z = pg8::cvt_pk_bf16(p1[8 * s + 4], p1[8 * s + 5]); w1.w = pg8::cvt_pk_bf16(p1[8 * s + 6], p1[8 * s + 7]);
                pa[s] = __builtin_bit_cast(bf16x8, w0); pa[2 + s] = __builtin_bit_cast(bf16x8, w1);
            }
#pragma unroll
            for (int d0 = 0; d0 < 2; ++d0) {
                s16x4 lo[4], hi4[4];
#pragma unroll
                for (int ks = 0; ks < 4; ++ks) {
                    asm volatile("ds_read_b64_tr_b16 %0,%1 offset:%c2" : "=&v"(lo[ks]) : "v"(vbt), "i"(d0 * 4096 + ks * 1024) : "memory");
                    asm volatile("ds_read_b64_tr_b16 %0,%1 offset:%c2" : "=&v"(hi4[ks]) : "v"(vbt), "i"(d0 * 4096 + ks * 1024 + 512) : "memory"); }
                asm volatile("s_waitcnt lgkmcnt(0)" ::: "memory"); __builtin_amdgcn_sched_barrier(0);
#define MLA_PK(k) (bf16x8){lo[k][0], lo[k][1], lo[k][2], lo[k][3], hi4[k][0], hi4[k][1], hi4[k][2], hi4[k][3]}
                if (d0 == 0) { o0 = __builtin_amdgcn_mfma_f32_32x32x16_bf16(MLA_PK(0), pa[0], o0, 0, 0, 0); o0 = __builtin_amdgcn_mfma_f32_32x32x16_bf16(MLA_PK(1), pa[1], o0, 0, 0, 0);
                               o0 = __builtin_amdgcn_mfma_f32_32x32x16_bf16(MLA_PK(2), pa[2], o0, 0, 0, 0); o0 = __builtin_amdgcn_mfma_f32_32x32x16_bf16(MLA_PK(3), pa[3], o0, 0, 0, 0); }
                else         { o1 = __builtin_amdgcn_mfma_f32_32x32x16_bf16(MLA_PK(0), pa[0], o1, 0, 0, 0); o1 = __builtin_amdgcn_mfma_f32_32x32x16_bf16(MLA_PK(1), pa[1], o1, 0, 0, 0);
                               o1 = __builtin_amdgcn_mfma_f32_32x32x16_bf16(MLA_PK(2), pa[2], o1, 0, 0, 0); o1 = __builtin_amdgcn_mfma_f32_32x32x16_bf16(MLA_PK(3), pa[3], o1, 0, 0, 0); }
#undef MLA_PK
            }
        }
    }
    lrun += __shfl_xor(lrun, 32);
    const float inv = 1.0f / lrun;
    bf16* op = OB + (row0 + (size_t)qb * 256 + wid * 32 + r32) * DM + h * 64 + 4 * hi;
#pragma unroll
    for (int g = 0; g < 4; ++g) {
        u32x2 w; w.x = pg8::cvt_pk_bf16(o0[4 * g] * inv, o0[4 * g + 1] * inv); w.y = pg8::cvt_pk_bf16(o0[4 * g + 2] * inv, o0[4 * g + 3] * inv); *(u32x2*)(op + 8 * g) = w;
        u32x2 z; z.x = pg8::cvt_pk_bf16(o1[4 * g] * inv, o1[4 * g + 1] * inv); z.y = pg8::cvt_pk_bf16(o1[4 * g + 2] * inv, o1[4 * g + 3] * inv); *(u32x2*)(op + 32 + 8 * g) = z;
    }
}
__device__ __forceinline__ void attn_phase(Frame& F, const Args& A) {
    const bf16* QB = (const bf16*)(A.ws + WS_QB); const bf16* KVB = (const bf16*)(A.ws + WS_KVB); const bf16* CB = (const bf16*)(A.ws + WS_CB); bf16* OB = (bf16*)(A.ws + WS_OB);
    for (int u = blockIdx.x; u < BATCH * 16 * 8; u += F.G) { const int bh = u & 255, qb = u >> 8; attn_unit(F.lds, QB, KVB, CB, OB, bh >> 4, bh & 15, qb); }
}
}
__global__ void __launch_bounds__(NWAVES * 64, 2) mk_fwd(Args args) {
    extern __shared__ __attribute__((aligned(16))) unsigned char lds_raw[];
    Frame F;
    F.lds = (LAS unsigned char*)lds_raw;
    F.MISC = (volatile LAS unsigned*)(F.lds + MISC_OFF);
    F.tid = threadIdx.x; F.lane = F.tid & 63; F.wave = __builtin_amdgcn_readfirstlane(F.tid >> 6);
    F.G = gridDim.x;
    unsigned char* ws = args.ws;
    F.ctl = (gu32*)(ws + WS_CTL);
    for (int u = F.tid; u < (LDS_BYTES - LDSCTL_OFF) / 4; u += NWAVES * 64) ((LAS unsigned*)(F.lds + LDSCTL_OFF))[u] = 0u;
    __syncthreads();
    XcdBarrier bar; bar.bar = (unsigned*)(F.ctl + CW_BAR); bar.x = 0; bar.st = nullptr;
    if (N_LAUNCHES == 1) bar = xcd_barrier_post((unsigned*)(F.ctl + CW_BAR), F.MISC + 8);
#define GRID_BAR() do { if (N_LAUNCHES == 1) xcd_barrier(bar); } while (0)
    const int lo = args.ph_lo, hi = args.ph_hi;
#ifndef PHMASK
#define PHMASK 0x1fff
#endif
#define IN(k) (((PHMASK >> (k)) & 1) && lo <= (k) && (k) < hi)
    bf16* const XB = (bf16*)(ws + WS_XB); float* const SS = (float*)(ws + WS_SS); float* const SSB = (float*)(ws + WS_SSB);
    const float* const cosA = (const float*)(ws + WS_COSA); const float* const sinA = (const float*)(ws + WS_SINA);
    const float* const cosB = (const float*)(ws + WS_COSB); const float* const sinB = (const float*)(ws + WS_SINB);
    const int bid = (int)blockIdx.x;

    if (IN(0)) { p0_prologue(F, args); GRID_BAR(); }
    if (IN(1)) {
        pg8::Gemm g{XB, (const bf16*)(ws + WS_WAIN), M, A_INP, DM, DM, DM}; pg8::StaticOrder S; S.init(M, A_INP, F.G, bid);
        pg8::EpiDsaIn E{(bf16*)(ws + WS_PA), (float*)(ws + WS_WI), SS, cosA, sinA, IDX_WSCALE, QSCALE_A};
        pg8::gemm_phase<pg8::EpiDsaIn, pg8::StaticOrder, true, true, true>(F.lds, g, S, E);
        GRID_BAR();
    }
    if (IN(2)) { if (F.wave >= 4) __builtin_amdgcn_s_setprio(1); dsa::phase(F, args); __builtin_amdgcn_s_setprio(0); GRID_BAR(); }
#if defined(PROBE_DUP) && PROBE_DUP == 2
    if (IN(2)) { if (F.wave >= 4) __builtin_amdgcn_s_setprio(1); dsa::phase(F, args); __builtin_amdgcn_s_setprio(0); GRID_BAR(); }
#endif
    if (IN(3)) {
        pg8::Gemm g{(const bf16*)(ws + WS_OA), (const bf16*)(ws + WS_WAOUT), M, DM, DM, DM, DM}; pg8::StaticOrder S; S.init(M, DM, F.G, bid);
        pg8::EpiResid<true> E{XB, SS};
        pg8::gemm_phase<pg8::EpiResid<true>, pg8::StaticOrder, true, true, false>(F.lds, g, S, E);
        GRID_BAR();
    }
    if (IN(4)) {
        pg8::Gemm g{XB, (const bf16*)(ws + WS_WUP0), M, FF, DM, DM, DM}; pg8::StaticOrder S; S.init(M, FF, F.G, bid);
        pg8::EpiMlpUp E{(bf16*)(ws + WS_H), SS};
        pg8::gemm_phase<pg8::EpiMlpUp, pg8::StaticOrder, true, true, false>(F.lds, g, S, E);
        GRID_BAR();
    }
    if (IN(5)) {
        pg8::Gemm g{(const bf16*)(ws + WS_H), (const bf16*)(ws + WS_WDN0), M, DM, FF, FF, FF}; pg8::StaticOrder S; S.init(M, DM, F.G, bid);
        pg8::EpiResid<false> E{XB, SS};
        pg8::gemm_phase<pg8::EpiResid<false>, pg8::StaticOrder, true, true, false>(F.lds, g, S, E);
        GRID_BAR();
    }
    if (IN(6)) {
        pg8::Gemm g{XB, (const bf16*)(ws + WS_WBIN), M, B_INP, DM, DM, DM}; pg8::StaticOrder S; S.init(M, B_INP, F.G, bid);
        pg8::EpiMlaIn E{(bf16*)(ws + WS_CB), SSB, SS, cosB, sinB};
        pg8::gemm_phase<pg8::EpiMlaIn, pg8::StaticOrder, true, true, false>(F.lds, g, S, E);
        GRID_BAR();
    }
    if (IN(7)) {
#ifndef NO_QUP
        { pg8::Gemm g{(const bf16*)(ws + WS_CB), (const bf16*)(ws + WS_WQUP), M, QUP, QLORA, B_INP, QLORA}; pg8::StaticOrder S; S.init(M, QUP, F.G, bid);
          pg8::EpiQUp E{(bf16*)(ws + WS_QB), SSB, cosB, sinB, QSCALE_B};
          pg8::gemm_phase<pg8::EpiQUp, pg8::StaticOrder, true, true, false>(F.lds, g, S, E); }
#endif
#ifndef NO_KVUP
        { pg8::Gemm g{(const bf16*)(ws + WS_CB) + QLORA, (const bf16*)(ws + WS_WKVUP), M, KVUP, KVLORA, B_INP, KVLORA}; pg8::StaticOrder S; S.init(M, KVUP, F.G, bid);
          pg8::EpiKvUp E{(bf16*)(ws + WS_KVB), SSB};
          pg8::gemm_phase<pg8::EpiKvUp, pg8::StaticOrder, true, true, false>(F.lds, g, S, E); }
#endif
        GRID_BAR();
    }
    if (IN(8)) { if (F.wave >= 4) __builtin_amdgcn_s_setprio(1); mla::attn_phase(F, args); __builtin_amdgcn_s_setprio(0); GRID_BAR(); }
#if defined(PROBE_DUP) && PROBE_DUP == 8
    if (IN(8)) { if (F.wave >= 4) __builtin_amdgcn_s_setprio(1); mla::attn_phase(F, args); __builtin_amdgcn_s_setprio(0); GRID_BAR(); }
#endif
    if (IN(9)) {
        pg8::Gemm g{(const bf16*)(ws + WS_OB), (const bf16*)(ws + WS_WBOUT), M, DM, DM, DM, DM}; pg8::StaticOrder S; S.init(M, DM, F.G, bid);
        pg8::EpiResid<false> E{XB, SS};
        pg8::gemm_phase<pg8::EpiResid<false>, pg8::StaticOrder, true, true, false>(F.lds, g, S, E);
        GRID_BAR();
    }
    if (IN(10)) {
        pg8::Gemm g{XB, (const bf16*)(ws + WS_WUP1), M, FF, DM, DM, DM}; pg8::StaticOrder S; S.init(M, FF, F.G, bid);
        pg8::EpiMlpUp E{(bf16*)(ws + WS_H), SS};
        pg8::gemm_phase<pg8::EpiMlpUp, pg8::StaticOrder, true, true, false>(F.lds, g, S, E);
        GRID_BAR();
    }
    if (IN(11)) {
        pg8::Gemm g{(const bf16*)(ws + WS_H), (const bf16*)(ws + WS_WDN1), M, DM, FF, FF, FF}; pg8::StaticOrder S; S.init(M, DM, F.G, bid);
        pg8::EpiResid<false> E{XB, SS};
        pg8::gemm_phase<pg8::EpiResid<false>, pg8::StaticOrder, true, true, false>(F.lds, g, S, E);
        GRID_BAR();
    }
    if (IN(12)) { p12_final_norm(F, args); }
#undef IN
#undef GRID_BAR
}

extern "C" void kernel_launch(void* const* d_in, const int* in_sizes, int n_in, void* d_out, int out_size, void* d_ws, size_t ws_size, hipStream_t stream) {
    static int grid = 0;
    if (grid == 0) {
        if (n_in != 15 || in_sizes[0] != M * DM || out_size != M * DM || ws_size < WS_END) { fprintf(stderr, "kernel_launch: unexpected shapes / workspace (n_in %d, in0 %d, out %d, ws %zu); nothing launched\n", n_in, n_in > 0 ? in_sizes[0] : -1, out_size, ws_size); grid = -1; return; }
        int dev = 0, cus = 0, per_cu = 0;
        if (hipGetDevice(&dev) != hipSuccess || hipDeviceGetAttribute(&cus, hipDeviceAttributeMultiprocessorCount, dev) != hipSuccess) { grid = -1; return; }
        if (hipFuncSetAttribute((const void*)mk_fwd, hipFuncAttributeMaxDynamicSharedMemorySize, LDS_BYTES) != hipSuccess) { fprintf(stderr, "kernel_launch: hipFuncSetAttribute failed\n"); grid = -1; return; }
        if (hipOccupancyMaxActiveBlocksPerMultiprocessor(&per_cu, (const void*)mk_fwd, NWAVES * 64, LDS_BYTES) != hipSuccess || per_cu < 1) { fprintf(stderr, "kernel_launch: occupancy query reports %d blocks per CU\n", per_cu); }
        (void)hipGetLastError();
        grid = cus;
    }
    if (grid < 0) return;
    if (hipMemsetAsync((char*)d_ws + WS_CTL, 0, CTL_ZERO_BYTES, stream) != hipSuccess) return;
    Args a{};
    for (int i = 0; i < 15; ++i) a.in[i] = d_in[i];
    a.out = (float*)d_out; a.ws = (unsigned char*)d_ws;
    for (int i = 0; i < 8; ++i) a.inv_a[i] = (float)pow(500000.0, -(double)i / 8.0);
    for (int i = 0; i < 16; ++i) a.inv_b[i] = (float)pow(500000.0, -(double)i / 16.0);
    if (N_LAUNCHES == 1) { a.ph_lo = 0; a.ph_hi = N_PHASES; hipLaunchKernelGGL(mk_fwd, dim3(grid), dim3(NWAVES * 64), LDS_BYTES, stream, a); }
    else for (int li = 0; li < N_PHASES; ++li) { a.ph_lo = li; a.ph_hi = li + 1; hipLaunchKernelGGL(mk_fwd, dim3(grid), dim3(NWAVES * 64), LDS_BYTES, stream, a); }
    const hipError_t le = hipPeekAtLastError();
    if (le != hipSuccess) fprintf(stderr, "kernel_launch: launch failed: %s\n", hipGetErrorName(le));
}
```
